# Optimizing an MI355X kernel written in HIP

```python
import math
import jax
import jax.numpy as jnp
from jax import lax
import numpy as np


D_MODEL = 4096
BATCH = 4
SEQ = 2048
DEPTH = 1

CHUNK = 64
EPS = 1e-6
N_MOD = 6
A_HEADS = 16
A_HEAD_DIM = 128
A_Q_RANK = 1024
A_KV_RANK = 512
A_WIDTH = A_HEADS * A_HEAD_DIM
IDX_HEADS = 64
IDX_DIM = 128
TOPK_MAX = 256
Q_BLOCK = 128
T5_BUCKETS = 32
T5_MAX_DIST = 128
R_HEADS = 8
R_QK_DIM = 128
R_V_DIM = 256
R_QK_WIDTH = R_HEADS * R_QK_DIM
R_WIDTH = R_HEADS * R_V_DIM
ROT_BASE = 10000.0
P_HEADS = 8
P_QUERY_DIM = 256
P_NKEYS = 128
P_TOPK = 16
P_EXPERTS = P_NKEYS * P_NKEYS
P_TOKEN_BLOCK = 128
IN_SPLITS = (A_Q_RANK, A_KV_RANK, IDX_DIM, IDX_HEADS, R_QK_WIDTH, R_QK_WIDTH, R_WIDTH, R_WIDTH)
IN_WIDTH = A_Q_RANK + A_KV_RANK + IDX_DIM + IDX_HEADS + 2 * R_QK_WIDTH + 2 * R_WIDTH
N_BRANCH = 2

kernel_name = 'hybrid_dsa_retention_peer_block'


def rms_norm(x, g):
    xf = x.astype(jnp.float32)
    y = xf * lax.rsqrt(jnp.mean(xf * xf, axis=-1, keepdims=True) + EPS)
    return (y * g).astype(x.dtype)


def layer_norm(x, g, b):
    xf = x.astype(jnp.float32)
    mu = jnp.mean(xf, axis=-1, keepdims=True)
    var = jnp.mean(jnp.square(xf - mu), axis=-1, keepdims=True)
    y = (xf - mu) * lax.rsqrt(var + EPS)
    return (y * g + b).astype(x.dtype)


def modulate(h, shift, scale):
    return h * (1.0 + scale[:, None, :]) + shift[:, None, :]


def t5_bucket(rel):
    half = T5_BUCKETS // 2
    exact = half // 2
    n = jnp.abs(rel)
    log_ratio = jnp.log(jnp.maximum(n, 1).astype(jnp.float32) / exact) / math.log(T5_MAX_DIST / exact)
    large = jnp.minimum(exact + (log_ratio * (half - exact)).astype(jnp.int32), half - 1)
    return jnp.where(rel > 0, half, 0) + jnp.where(n < exact, n, large)


def dsa_branch(c_q, c_kv, k_i, w_i, g_cq, g_ckv, w_uq, w_uk, w_uv, w_qi, g_ki, b_ki, t5_bias, top_k):
    B, S, _ = c_q.shape
    c_q = rms_norm(c_q, g_cq)
    c_kv = rms_norm(c_kv, g_ckv)
    q = jnp.einsum('bsr,rhd->bshd', c_q, w_uq)
    q_lat = jnp.einsum('bshd,chd->bshc', q, w_uk)
    q_idx = jnp.einsum('bsr,rhd->bshd', c_q, w_qi)
    k_idx = layer_norm(k_i, g_ki, b_ki)
    w_idx = w_i * (IDX_HEADS ** -0.5 * IDX_DIM ** -0.5)
    kchunk = jnp.arange(S, dtype=jnp.int32) // CHUNK

    def block(i):
        q0 = i * Q_BLOCK
        qi = lax.dynamic_slice_in_dim(q_idx, q0, Q_BLOCK, axis=1)
        wi = lax.dynamic_slice_in_dim(w_idx, q0, Q_BLOCK, axis=1)
        ql = lax.dynamic_slice_in_dim(q_lat, q0, Q_BLOCK, axis=1)
        qpos = q0 + jnp.arange(Q_BLOCK, dtype=jnp.int32)
        qchunk = qpos // CHUNK
        rel = jax.nn.relu(jnp.einsum('bthd,bsd->bths', qi, k_idx))
        score = jnp.einsum('bths,bth->bts', rel, wi).astype(jnp.float32)
        adm = kchunk[None, :] <= qchunk[:, None]
        score = jnp.where(adm[None], score, -jnp.inf)
        _, sel = lax.top_k(score, top_k)
        valid = (sel // CHUNK) <= qchunk[None, :, None]
        kv_sel = jax.vmap(lambda kv, ix: kv[ix])(c_kv, sel)
        logits = jnp.einsum('bthc,btkc->bthk', ql, kv_sel).astype(jnp.float32) * (A_HEAD_DIM ** -0.5)
        bias = t5_bias[t5_bucket(sel - qpos[None, :, None])]
        logits = logits + jnp.moveaxis(bias, -1, 2).astype(jnp.float32)
        logits = jnp.where(valid[:, :, None, :], logits, -jnp.inf)
        p = jax.nn.softmax(logits, axis=-1).astype(kv_sel.dtype)
        o_lat = jnp.einsum('bthk,btkc->bthc', p, kv_sel)
        o = jnp.einsum('bthc,chd->bthd', o_lat, w_uv)
        return o.reshape(B, Q_BLOCK, A_WIDTH)

    out = lax.map(block, jnp.arange(S // Q_BLOCK))
    return jnp.moveaxis(out, 0, 1).reshape(B, S, A_WIDTH)


def retention_branch(r_q, r_k, r_v, r_g, g_ret):
    B, S, _ = r_q.shape
    f32 = jnp.float32
    NC = S // CHUNK
    half = R_QK_DIM // 2
    q = r_q.astype(f32).reshape(B, S, R_HEADS, R_QK_DIM)
    k = r_k.astype(f32).reshape(B, S, R_HEADS, R_QK_DIM) * (R_QK_DIM ** -0.5)
    v = r_v.astype(f32).reshape(B, S, R_HEADS, R_V_DIM)
    inv = 1.0 / (ROT_BASE ** jnp.linspace(0.0, 1.0, half, dtype=f32))
    ang = jnp.arange(S, dtype=f32)[:, None] * inv[None, :]
    cos = jnp.cos(ang)[None, :, None, :]
    sin = jnp.sin(ang)[None, :, None, :]

    def rot(t):
        t1, t2 = t[..., :half], t[..., half:]
        return jnp.concatenate([t1 * cos - t2 * sin, t1 * sin + t2 * cos], axis=-1)

    q = rot(q).reshape(B, NC, CHUNK, R_HEADS, R_QK_DIM)
    k = rot(k).reshape(B, NC, CHUNK, R_HEADS, R_QK_DIM)
    v = v.reshape(B, NC, CHUNK, R_HEADS, R_V_DIM)
    log_g = jnp.log(1.0 - jnp.power(2.0, -5.0 - jnp.arange(R_HEADS, dtype=f32)))
    j = jnp.arange(CHUNK, dtype=f32)
    diff = j[:, None] - j[None, :]
    dmask = jnp.where(diff[None] >= 0, jnp.exp(jnp.maximum(diff, 0.0)[None] * log_g[:, None, None]), 0.0)
    att = jnp.einsum('bnjhk,bnlhk->bnhjl', q, k) * dmask[None, None]
    y_intra = jnp.einsum('bnhjl,bnlhv->bnjhv', att, v)
    k_dec = k * jnp.exp((CHUNK - 1.0 - j)[:, None] * log_g[None, :])[None, None, :, :, None]
    kv = jnp.einsum('bnlhk,bnlhv->nbhkv', k_dec, v)
    chunk_dec = jnp.exp(CHUNK * log_g)[None, :, None, None]

    def step(state, kv_n):
        return state * chunk_dec + kv_n, state

    _, s_prev = lax.scan(step, jnp.zeros((B, R_HEADS, R_QK_DIM, R_V_DIM), f32), kv)
    q_dec = q * jnp.exp((j + 1.0)[:, None] * log_g[None, :])[None, None, :, :, None]
    y_cross = jnp.einsum('bnjhk,nbhkv->bnjhv', q_dec, s_prev)
    y = (y_intra + y_cross).reshape(B, S, R_HEADS, R_V_DIM)
    y = y * lax.rsqrt(jnp.mean(y * y, axis=-1, keepdims=True) + EPS) * g_ret
    y = jax.nn.silu(r_g.astype(f32)) * y.reshape(B, S, R_WIDTH)
    return y.astype(r_q.dtype)


def mixer_block(h, w_in, g_cq, g_ckv, w_uq, w_uk, w_uv, w_qi, g_ki, b_ki, t5_bias, g_ret,
                w_up, w_gate, b_gate, w_out, top_k):
    proj = jnp.einsum('bsd,de->bse', h, w_in)
    offs = np.cumsum(IN_SPLITS)[:-1].tolist()
    c_q, c_kv, k_i, w_i, r_q, r_k, r_v, r_g = jnp.split(proj, offs, axis=-1)
    y_a = dsa_branch(c_q, c_kv, k_i, w_i, g_cq, g_ckv, w_uq, w_uk, w_uv, w_qi, g_ki, b_ki, t5_bias, top_k)
    y_r = retention_branch(r_q, r_k, r_v, r_g, g_ret)
    p_a = jnp.einsum('bse,ed->bsd', y_a, w_up[:A_WIDTH])
    p_r = jnp.einsum('bse,ed->bsd', y_r, w_up[A_WIDTH:])
    gates = jax.nn.sigmoid(jnp.einsum('bsd,de->bse', h, w_gate) + b_gate)
    g_a, g_r = jnp.split(gates, N_BRANCH, axis=-1)
    merged = g_a * p_a + g_r * p_r
    return jnp.einsum('bsd,de->bse', merged, w_out)


def peer_ffn(h, w_pq, sub_keys, u_exp, v_exp):
    B, S, D = h.shape
    hb = h.reshape(B * S // P_TOKEN_BLOCK, P_TOKEN_BLOCK, D)
    hq = P_QUERY_DIM // 2

    def block(t):
        q = jnp.einsum('td,de->te', t, w_pq).reshape(P_TOKEN_BLOCK, P_HEADS, P_QUERY_DIM)
        s1 = jnp.einsum('thd,kd->thk', q[..., :hq], sub_keys[0]).astype(jnp.float32)
        s2 = jnp.einsum('thd,kd->thk', q[..., hq:], sub_keys[1]).astype(jnp.float32)
        v1, i1 = lax.top_k(s1, P_TOPK)
        v2, i2 = lax.top_k(s2, P_TOPK)
        cand = (v1[..., :, None] + v2[..., None, :]).reshape(P_TOKEN_BLOCK, P_HEADS, P_TOPK * P_TOPK)
        cid = (i1[..., :, None] * P_NKEYS + i2[..., None, :]).reshape(P_TOKEN_BLOCK, P_HEADS, P_TOPK * P_TOPK)
        top, pidx = lax.top_k(cand, P_TOPK)
        eid = jnp.take_along_axis(cid, pidx, axis=-1)
        gate = jax.nn.softmax(top, axis=-1)
        u = u_exp[eid]
        act = jax.nn.gelu(jnp.einsum('thed,td->the', u, t).astype(jnp.float32), approximate=False)
        coef = (gate * act).astype(t.dtype)
        return jnp.einsum('the,thed->td', coef, v_exp[eid])

    return lax.map(block, hb).reshape(B, S, D)


def setup_inputs(seed: int = 0) -> dict:
    key = jax.random.key(seed)
    ks = jax.random.split(key, 32)
    f32 = jnp.float32
    L = DEPTH
    D = D_MODEL

    def nrm(k, shape, scale):
        return jax.random.normal(k, shape, f32) * scale

    return {
        'x': nrm(ks[0], (BATCH, SEQ, D), 1.0),
        'c': nrm(ks[1], (BATCH, D), 1.0),
        'w_ada': nrm(ks[2], (L, D, N_MOD * D), 0.5 * D ** -0.5),
        'b_ada': nrm(ks[3], (L, N_MOD * D), 0.02),
        'g_mix': 1.0 + nrm(ks[4], (L, D), 0.02),
        'w_in': nrm(ks[5], (L, D, IN_WIDTH), D ** -0.5),
        'g_cq': 1.0 + nrm(ks[6], (L, A_Q_RANK), 0.02),
        'g_ckv': 1.0 + nrm(ks[7], (L, A_KV_RANK), 0.02),
        'w_uq': nrm(ks[8], (L, A_Q_RANK, A_HEADS, A_HEAD_DIM), A_Q_RANK ** -0.5),
        'w_uk': nrm(ks[9], (L, A_KV_RANK, A_HEADS, A_HEAD_DIM), A_HEAD_DIM ** -0.5),
        'w_uv': nrm(ks[10], (L, A_KV_RANK, A_HEADS, A_HEAD_DIM), A_KV_RANK ** -0.5),
        'w_qi': nrm(ks[11], (L, A_Q_RANK, IDX_HEADS, IDX_DIM), A_Q_RANK ** -0.5),
        'g_ki': 1.0 + nrm(ks[12], (L, IDX_DIM), 0.02),
        'b_ki': nrm(ks[13], (L, IDX_DIM), 0.02),
        't5_bias': nrm(ks[14], (T5_BUCKETS, A_HEADS), 0.3),
        'g_ret': 1.0 + nrm(ks[15], (L, R_HEADS, R_V_DIM), 0.02),
        'w_up': nrm(ks[16], (L, A_WIDTH + R_WIDTH, D), A_WIDTH ** -0.5),
        'w_gate': nrm(ks[17], (L, D, N_BRANCH * D), D ** -0.5),
        'b_gate': nrm(ks[18], (L, N_BRANCH * D), 0.02),
        'w_out': nrm(ks[19], (L, D, D), D ** -0.5),
        'g_ffn': 1.0 + nrm(ks[20], (L, D), 0.02),
        'w_pq': nrm(ks[21], (L, D, P_HEADS * P_QUERY_DIM), D ** -0.5),
        'sub_keys': nrm(ks[22], (L, 2, P_NKEYS, P_QUERY_DIM // 2), (P_QUERY_DIM // 2) ** -0.5),
        'u_exp': nrm(ks[23], (L, P_EXPERTS, D), D ** -0.5),
        'v_exp': nrm(ks[24], (L, P_EXPERTS, D), P_HEADS ** -0.5),
        'g_final': 1.0 + nrm(ks[25], (D,), 0.02),
    }


def reference(x, c, w_ada, b_ada, g_mix, w_in, g_cq, g_ckv, w_uq, w_uk, w_uv, w_qi, g_ki, b_ki,
              t5_bias, g_ret, w_up, w_gate, b_gate, w_out, g_ffn, w_pq, sub_keys, u_exp, v_exp, g_final):
    S = x.shape[1]
    top_k = min(TOPK_MAX, S // 4)
    c_act = jax.nn.silu(c)
    for l in range(DEPTH):
        mod = jnp.einsum('bd,de->be', c_act, w_ada[l]) + b_ada[l]
        sh_m, sc_m, gt_m, sh_f, sc_f, gt_f = jnp.split(mod, N_MOD, axis=-1)
        h = modulate(rms_norm(x, g_mix[l]), sh_m, sc_m)
        y = mixer_block(h, w_in[l], g_cq[l], g_ckv[l], w_uq[l], w_uk[l], w_uv[l], w_qi[l], g_ki[l],
                        b_ki[l], t5_bias, g_ret[l], w_up[l], w_gate[l], b_gate[l], w_out[l], top_k)
        x = x + gt_m[:, None, :] * y
        h = modulate(rms_norm(x, g_ffn[l]), sh_f, sc_f)
        x = x + gt_f[:, None, :] * peer_ffn(h, w_pq[l], sub_keys[l], u_exp[l], v_exp[l])
    return rms_norm(x, g_final)
```

```cpp
#include <hip/hip_runtime.h>
#include <cstdio>
#include <cstdint>

#define GAS __attribute__((address_space(1)))
#define LAS __attribute__((address_space(3)))
typedef unsigned short bf16;
typedef unsigned v4u __attribute__((ext_vector_type(4)));
typedef unsigned v2u __attribute__((ext_vector_type(2)));
typedef float f32x4 __attribute__((ext_vector_type(4)));
typedef float f32x2 __attribute__((ext_vector_type(2)));
typedef short bf16x8 __attribute__((ext_vector_type(8)));
typedef short bf16x4 __attribute__((ext_vector_type(4)));

constexpr int D = 4096, NB = 4, SEQ = 2048, T = NB * SEQ;
constexpr int CHUNK = 64;
constexpr float EPS = 1e-6f;
constexpr int A_HEADS = 16, A_HD = 128, A_QR = 1024, A_KVR = 512, A_WIDTH = 2048;
constexpr int IDX_H = 64, IDX_D = 128, TOPK = 256;
constexpr int R_HEADS = 8, R_QK = 128, R_V = 256, R_QKW = 1024, R_W = 2048;
constexpr int P_HEADS = 8, P_QD = 256, P_NK = 128, P_TOPK = 16, P_EXP = 16384;
constexpr int IN_WIDTH = 7872, IN_PAD = 7936, IN_BF = 1792;
constexpr int N1 = IN_PAD + 2 * D;
constexpr int N2 = A_WIDTH + IDX_H * IDX_D;
constexpr int C_CQ = 0, C_CKV = 1024, C_KI = 1536, C_WI = 1664, C_RQ = 1728, C_RK = 2752, C_RV = 3776, C_RG = 5824, C_GA = IN_PAD, C_GR = IN_PAD + D;

__device__ __forceinline__ float bf2f(bf16 h) { return __uint_as_float(((unsigned)h) << 16); }
__device__ __forceinline__ float bflo(unsigned w) { return __uint_as_float(w << 16); }
__device__ __forceinline__ float bfhi(unsigned w) { return __uint_as_float(w & 0xffff0000u); }
typedef __bf16 bf16v2_t __attribute__((ext_vector_type(2)));
__device__ __forceinline__ unsigned cvt_pk_bf16(float lo, float hi) { const bf16v2_t v = __builtin_convertvector((f32x2){lo, hi}, bf16v2_t); return __builtin_bit_cast(unsigned, v); }
__device__ __forceinline__ bf16 f2bf(float f) { return (bf16)(cvt_pk_bf16(f, 0.f) & 0xffffu); }
__device__ __forceinline__ float wave_sum(float v) {
#pragma unroll
    for (int o = 1; o < 64; o <<= 1) v += __shfl_xor(v, o);
    return v;
}
#define PK_FP8(a, b, old, hi) __builtin_amdgcn_cvt_pk_fp8_f32(__builtin_amdgcn_fmed3f((a), -448.0f, 448.0f), __builtin_amdgcn_fmed3f((b), -448.0f, 448.0f), (old), (hi))
__device__ __forceinline__ float sigmoidf_(float v) { return 1.0f / (1.0f + __expf(-v)); }

namespace pg8 {
#define PG8_LAS __attribute__((address_space(3)))
typedef unsigned short bf16_t;
typedef unsigned u32x4 __attribute__((ext_vector_type(4)));
constexpr int BM = 256, BK = 64, HALF = 128, HTB = HALF * BK * 2  , STAGE_BYTES = 8 * HTB, NXCD = 8, WGM = 8;

__host__ __device__ __forceinline__ int lds_byte(int r, int c) { const int st = (r >> 4) * 2 + (c >> 5), rr = r & 15, cc = c & 31, ob = rr * 64 + cc * 2; return st * 1024 + (ob ^ (((ob >> 9) & 1) << 5)); }
__host__ __device__ __forceinline__ void stage_rc(int b, int& R, int& C) { const int st = b / 1024, sb = b % 1024, swz = sb ^ (((sb >> 9) & 1) << 5); R = (st >> 1) * 16 + swz / 64; C = (st & 1) * 32 + (swz % 64) / 2; }
__host__ __device__ __forceinline__ int perm32(int rho) { const int n = rho >> 4, i = rho & 15; return 8 * (i >> 2) + 4 * n + (i & 3); }

struct Unit { int pm, pn; };
struct Gemm { const bf16_t* A; const bf16_t* Bt; int M, N, K, lda, ldb; };

struct StaticOrder {
    int nM, nN, nwg, G, c;
    __host__ __device__ void init(int M, int N, int G_, int c_) { nM = M / BM; nN = N / BM; nwg = nM * nN; G = G_; c = c_; }
    __host__ __device__ bool next(int i, Unit& u) const {
        const long L = (long)i * G + c; if (L >= nwg) return false;
        int wgid = (int)L; { const int q = nwg / NXCD, r = nwg % NXCD, xcd = wgid % NXCD, off = wgid / NXCD; wgid = (xcd < r ? xcd * (q + 1) : r * (q + 1) + (xcd - r) * q) + off; }
        const int nig = WGM * nN, gid = wgid / nig, fm = gid * WGM, gsz = (nM - fm) < WGM ? (nM - fm) : WGM;
        u.pm = fm + ((wgid % nig) % gsz); u.pn = (wgid % nig) / gsz; return true;
    }
    __device__ __forceinline__ void a_ready(const Unit&) const {}
    __device__ __forceinline__ void done(const Unit&) const {}
};

template <int MODE> struct EpiB {
    static constexpr bool PERM = true, AFTER_DRAIN = false;
    bf16_t* O; unsigned char* O8; const float* bias; const bf16_t* gate; int ldc, ldg; float scale, scale8;
    __device__ __forceinline__ void operator()(const f32x4 (&acc)[2][2][4][2], const Unit& u, int wr, int wc, int fr, int fq) const {
        const int row0 = u.pm * BM + wr * 64 + fr; const int col0 = u.pn * BM + wc * 32 + 8 * fq;
        const bool gates = (MODE == 1) && (u.pn >= 31);
        f32x4 bv[2][2];
#pragma unroll
        for (int bj = 0; bj < 2; ++bj)
#pragma unroll
            for (int n = 0; n < 2; ++n) bv[bj][n] = gates ? *(const f32x4*)(bias + (col0 - 31 * BM) + bj * HALF + 4 * n) : (f32x4){0.f, 0.f, 0.f, 0.f};
#pragma unroll
        for (int ai = 0; ai < 2; ++ai)
#pragma unroll
            for (int m = 0; m < 4; ++m) { const size_t r = (size_t)(row0 + ai * HALF + m * 16); bf16_t* rowp = O + r * ldc + col0;
#pragma unroll
                for (int bj = 0; bj < 2; ++bj) { f32x4 v0 = acc[ai][bj][m][0] * scale, v1 = acc[ai][bj][m][1] * scale;
                    if (MODE == 1) { if (gates) { v0 = v0 + bv[bj][0]; v1 = v1 + bv[bj][1];
#pragma unroll
                            for (int j = 0; j < 4; ++j) { v0[j] = sigmoidf_(v0[j]); v1[j] = sigmoidf_(v1[j]); } } }
                    if (MODE == 2 || MODE == 3) { const u32x4 gw = *(const u32x4*)(gate + r * ldg + col0 + bj * HALF);
                        v0[0] *= bflo(gw.x); v0[1] *= bfhi(gw.x); v0[2] *= bflo(gw.y); v0[3] *= bfhi(gw.y); v1[0] *= bflo(gw.z); v1[1] *= bfhi(gw.z); v1[2] *= bflo(gw.w); v1[3] *= bfhi(gw.w); }
                    if (MODE == 3) { const u32x4 pw = *(const u32x4*)(rowp + bj * HALF);
                        v0[0] += bflo(pw.x); v0[1] += bfhi(pw.x); v0[2] += bflo(pw.y); v0[3] += bfhi(pw.y); v1[0] += bflo(pw.z); v1[1] += bfhi(pw.z); v1[2] += bflo(pw.w); v1[3] += bfhi(pw.w); }
                    u32x4 w; w.x = cvt_pk_bf16(v0[0], v0[1]); w.y = cvt_pk_bf16(v0[2], v0[3]); w.z = cvt_pk_bf16(v1[0], v1[1]); w.w = cvt_pk_bf16(v1[2], v1[3]);
                    *(u32x4*)(rowp + bj * HALF) = w;
                    if (MODE == 3) { int q0 = 0, q1 = 0; q0 = PK_FP8(v0[0] * scale8, v0[1] * scale8, q0, false); q0 = PK_FP8(v0[2] * scale8, v0[3] * scale8, q0, true);
                        q1 = PK_FP8(v1[0] * scale8, v1[1] * scale8, q1, false); q1 = PK_FP8(v1[2] * scale8, v1[3] * scale8, q1, true);
                        *(v2u*)(O8 + r * ldc + col0 + bj * HALF) = (v2u){(unsigned)q0, (unsigned)q1}; } } }
    }
};
typedef int v8i_t __attribute__((ext_vector_type(8)));
typedef int v4i_t __attribute__((ext_vector_type(4)));
__device__ __forceinline__ v8i_t f8cat(const bf16x8 lo, const bf16x8 hi) { const v4i_t a = __builtin_bit_cast(v4i_t, lo), b = __builtin_bit_cast(v4i_t, hi); return __builtin_shufflevector(a, b, 0, 1, 2, 3, 4, 5, 6, 7); }
struct EpiGate {
    static constexpr bool PERM = true, AFTER_DRAIN = false;
    bf16_t* O; int ldc; const float* bias; float scale;
    __device__ __forceinline__ void operator()(const f32x4 (&acc)[2][2][4][2], const Unit& u, int wr, int wc, int fr, int fq) const {
        const int row0 = u.pm * BM + wr * 64 + fr; const int col0 = u.pn * BM + wc * 32 + 8 * fq;
        f32x4 bv[2][2];
#pragma unroll
        for (int bj = 0; bj < 2; ++bj)
#pragma unroll
            for (int n = 0; n < 2; ++n) bv[bj][n] = *(const f32x4*)(bias + col0 + bj * HALF + 4 * n);
#pragma unroll
        for (int ai = 0; ai < 2; ++ai)
#pragma unroll
            for (int m = 0; m < 4; ++m) { bf16_t* rowp = O + (size_t)(row0 + ai * HALF + m * 16) * ldc + col0;
#pragma unroll
                for (int bj = 0; bj < 2; ++bj) { f32x4 v0 = acc[ai][bj][m][0] * scale + bv[bj][0], v1 = acc[ai][bj][m][1] * scale + bv[bj][1];
#pragma unroll
                    for (int j = 0; j < 4; ++j) { v0[j] = sigmoidf_(v0[j]); v1[j] = sigmoidf_(v1[j]); }
                    u32x4 w; w.x = cvt_pk_bf16(v0[0], v0[1]); w.y = cvt_pk_bf16(v0[2], v0[3]); w.z = cvt_pk_bf16(v1[0], v1[1]); w.w = cvt_pk_bf16(v1[2], v1[3]);
                    *(u32x4*)(rowp + bj * HALF) = w; } }
    }
};
struct EpiRes {
    static constexpr bool PERM = false, AFTER_DRAIN = false;
    const float* X; float* O; int ldc; const float* gt; int ldgt; float scale;
    __device__ __forceinline__ void operator()(const f32x4 (&acc)[2][2][4][2], const Unit& u, int wr, int wc, int fr, int fq) const {
        const int row0 = u.pm * BM + wr * 64 + fr, col0 = u.pn * BM + wc * 32 + 4 * fq;
        const float* g = gt + (size_t)(u.pm / (SEQ / BM)) * ldgt;
        f32x4 gv[2][2];
#pragma unroll
        for (int bj = 0; bj < 2; ++bj)
#pragma unroll
            for (int n = 0; n < 2; ++n) gv[bj][n] = *(const f32x4*)(g + col0 + bj * HALF + n * 16);
#pragma unroll
        for (int ai = 0; ai < 2; ++ai)
#pragma unroll
            for (int m = 0; m < 4; ++m) { const size_t off = (size_t)(row0 + ai * HALF + m * 16) * ldc + col0;
#pragma unroll
                for (int bj = 0; bj < 2; ++bj)
#pragma unroll
                    for (int n = 0; n < 2; ++n) { const f32x4 xv = *(const f32x4*)(X + off + bj * HALF + n * 16); *(f32x4*)(O + off + bj * HALF + n * 16) = xv + gv[bj][n] * (acc[ai][bj][m][n] * scale); } }
    }
};

template <class Epi, class Sched, bool ALIGN_EPI = false, bool SP2 = false, bool F8 = false>
__device__ __forceinline__ void gemm_phase(PG8_LAS unsigned char* lds, const Gemm g, const Sched& S, const Epi& E) {
    const int tid = threadIdx.x, wid = __builtin_amdgcn_readfirstlane(tid >> 6), lane = tid & 63, wr = wid >> 2, wc = wid & 3, fr = lane & 15, fq = lane >> 4;
    const int K = g.K, nt = K / BK;
    unsigned voffA[2], voffB[2];
#pragma unroll
    for (int i = 0; i < 2; ++i) { int R, C; stage_rc(tid * 16 + i * 8192, R, C); const int Rb = Epi::PERM ? ((R & ~31) + perm32(R & 31)) : R;
        voffA[i] = (unsigned)(R * g.lda + C) * 2u; voffB[i] = (unsigned)(Rb * g.ldb + C) * 2u; }
    const size_t kstep = (size_t)(BK * 2);
    const size_t hstepA = (size_t)HALF * g.lda * 2, hstepB = (size_t)HALF * g.ldb * 2;
    const size_t tstepA = 2 * hstepA, tstepB = 2 * hstepB;
    const unsigned ldsw = (unsigned)wid * 1024u;
    const int aoff = lds_byte(wr * 64 + fr, fq * 8), boff = lds_byte(wc * 32 + fr, fq * 8);
#define PG8_SA(b, h) (((b) * 2 + (h)) * HTB)
#define PG8_SB(b, h) ((4 + (b) * 2 + (h)) * HTB)
#define PG8_STAGE(bufoff, gbase, voff) do { _Pragma("unroll") for (int _i = 0; _i < 2; ++_i) \
        __builtin_amdgcn_global_load_lds((const unsigned*)((const char*)(gbase) + (voff)[_i]), (PG8_LAS unsigned*)(lds + (bufoff) + ldsw + _i * 8192), 16, 0, 0); } while (0)
#define PG8_LDA(dst, b, h) do { if constexpr (F8) { _Pragma("unroll") for (int m = 0; m < 4; ++m) dst##8[m] = f8cat(*(const PG8_LAS bf16x8*)(lds + PG8_SA(b, h) + aoff + m * 2048), *(const PG8_LAS bf16x8*)(lds + PG8_SA(b, h) + aoff + m * 2048 + 1024)); } \
        else { _Pragma("unroll") for (int m = 0; m < 4; ++m) _Pragma("unroll") for (int k = 0; k < 2; ++k) dst[m][k] = *(const PG8_LAS bf16x8*)(lds + PG8_SA(b, h) + aoff + m * 2048 + k * 1024); } } while (0)
#define PG8_LDB(dst, b, h) do { if constexpr (F8) { _Pragma("unroll") for (int n = 0; n < 2; ++n) dst##8[n] = f8cat(*(const PG8_LAS bf16x8*)(lds + PG8_SB(b, h) + boff + n * 2048), *(const PG8_LAS bf16x8*)(lds + PG8_SB(b, h) + boff + n * 2048 + 1024)); } \
        else { _Pragma("unroll") for (int n = 0; n < 2; ++n) _Pragma("unroll") for (int k = 0; k < 2; ++k) dst[n][k] = *(const PG8_LAS bf16x8*)(lds + PG8_SB(b, h) + boff + n * 2048 + k * 1024); } } while (0)
#define PG8_MMA(ai, bj, At, Bt) do { __builtin_amdgcn_s_setprio(1); _Pragma("unroll") for (int m = 0; m < 4; ++m) _Pragma("unroll") for (int n = 0; n < 2; ++n) { \
        if constexpr (F8) { asm volatile("v_mfma_scale_f32_16x16x128_f8f6f4 %0, %1, %2, %0, %3, %3 op_sel_hi:[0,0,0]" : "+v"(acc[ai][bj][m][n]) : "v"(Bt##8[n]), "v"(At##8[m]), "v"(f8scale)); } \
        else { _Pragma("unroll") for (int k = 0; k < 2; ++k) acc[ai][bj][m][n] = __builtin_amdgcn_mfma_f32_16x16x32_bf16(Bt[n][k], At[m][k], acc[ai][bj][m][n], 0, 0, 0); } } __builtin_amdgcn_s_setprio(0); } while (0)
#define PG8_WAIT_V(n) asm volatile("s_waitcnt vmcnt(" #n ")" ::: "memory")
#define PG8_WAIT_L(n) asm volatile("s_waitcnt lgkmcnt(" #n ")" ::: "memory")
#define PG8_BAR __builtin_amdgcn_s_barrier()
#define PG8_SCHED __builtin_amdgcn_sched_barrier(0)
    Unit cur, nxt; int ui = 0;
    if (!S.next(0, cur)) return;
    f32x4 acc[2][2][4][2];
#pragma unroll
    for (int a = 0; a < 2; ++a)
#pragma unroll
        for (int b = 0; b < 2; ++b)
#pragma unroll
            for (int m = 0; m < 4; ++m)
#pragma unroll
                for (int n = 0; n < 2; ++n) acc[a][b][m][n] = (f32x4){0.f, 0.f, 0.f, 0.f};
    bf16x8 At[4][2], B0[2][2], B1[2][2]; v8i_t At8[4], B08[2], B18[2];
    const int f8scale = 0x7f7f7f7f;
    const char* cA = (const char*)g.A + (size_t)cur.pm * tstepA; const char* cB = (const char*)g.Bt + (size_t)cur.pn * tstepB;
    S.a_ready(cur);
    if constexpr (SP2) {
        PG8_STAGE(PG8_SB(0, 0), cB, voffB); PG8_STAGE(PG8_SB(0, 1), cB + hstepB, voffB); PG8_STAGE(PG8_SA(0, 0), cA, voffA); PG8_STAGE(PG8_SA(0, 1), cA + hstepA, voffA);
        if (wr == 1) PG8_BAR;
        PG8_WAIT_V(2); PG8_BAR;
        PG8_STAGE(PG8_SB(1, 0), cB + kstep, voffB); PG8_STAGE(PG8_SA(1, 0), cA + kstep, voffA); PG8_STAGE(PG8_SB(1, 1), cB + hstepB + kstep, voffB);
        PG8_WAIT_V(6); PG8_BAR;
    } else {
        PG8_STAGE(PG8_SB(0, 0), cB, voffB); PG8_STAGE(PG8_SA(0, 0), cA, voffA); PG8_STAGE(PG8_SB(0, 1), cB + hstepB, voffB); PG8_STAGE(PG8_SA(0, 1), cA + hstepA, voffA);
        if (wr == 1) PG8_BAR;
        PG8_WAIT_V(4); PG8_BAR;
        PG8_STAGE(PG8_SB(1, 0), cB + kstep, voffB); PG8_STAGE(PG8_SA(1, 0), cA + kstep, voffA); PG8_STAGE(PG8_SB(1, 1), cB + hstepB + kstep, voffB);
        PG8_WAIT_V(6); PG8_BAR;
    }
    for (;;) {
        const bool has_next = S.next(ui + 1, nxt);
        const char* nA = has_next ? (const char*)g.A + (size_t)nxt.pm * tstepA : cA; const char* nB = has_next ? (const char*)g.Bt + (size_t)nxt.pn * tstepB : cB;
        for (int t = 0; t < nt; t += 2) {
            const bool last = (t == nt - 2);
            const char* a1 = cA + (size_t)(t + 1) * kstep;
            const char* a2 = last ? nA : cA + (size_t)(t + 2) * kstep; const char* b2 = last ? nB : cB + (size_t)(t + 2) * kstep;
            const char* a3 = a2 + kstep; const char* b3 = b2 + kstep;
            if (last && has_next) S.a_ready(nxt);
            if constexpr (SP2) {
            PG8_LDB(B0, 0, 0); PG8_LDB(B1, 0, 1); PG8_SCHED; PG8_LDA(At, 0, 0); PG8_STAGE(PG8_SA(1, 1), a1 + hstepA, voffA);
            PG8_WAIT_V(8); PG8_WAIT_L(0); PG8_BAR; PG8_MMA(0, 0, At, B0); PG8_MMA(0, 1, At, B1); PG8_BAR; PG8_SCHED;
            PG8_LDA(At, 0, 1); PG8_STAGE(PG8_SB(0, 0), b2, voffB); PG8_STAGE(PG8_SB(0, 1), b2 + hstepB, voffB); PG8_STAGE(PG8_SA(0, 0), a2, voffA);
            PG8_WAIT_V(8); PG8_WAIT_L(0); PG8_BAR; PG8_MMA(1, 0, At, B0); PG8_MMA(1, 1, At, B1); PG8_BAR; PG8_SCHED;
            PG8_LDB(B0, 1, 0); PG8_LDB(B1, 1, 1); PG8_SCHED; PG8_LDA(At, 1, 0); PG8_STAGE(PG8_SA(0, 1), a2 + hstepA, voffA);
            PG8_WAIT_V(8); PG8_WAIT_L(0); PG8_BAR; PG8_MMA(0, 0, At, B0); PG8_MMA(0, 1, At, B1); PG8_BAR; PG8_SCHED;
            PG8_LDA(At, 1, 1); PG8_STAGE(PG8_SB(1, 0), b3, voffB); PG8_STAGE(PG8_SB(1, 1), b3 + hstepB, voffB); PG8_STAGE(PG8_SA(1, 0), a3, voffA);
            PG8_WAIT_V(8); PG8_WAIT_L(0); PG8_BAR; PG8_MMA(1, 0, At, B0); PG8_MMA(1, 1, At, B1); PG8_BAR; PG8_SCHED;
            } else {
            PG8_LDB(B0, 0, 0); PG8_SCHED; PG8_LDA(At, 0, 0); PG8_STAGE(PG8_SA(1, 1), a1 + hstepA, voffA);
            PG8_WAIT_L(8); PG8_BAR; PG8_WAIT_L(0); PG8_MMA(0, 0, At, B0); PG8_BAR; PG8_SCHED;
            PG8_LDB(B1, 0, 1); PG8_STAGE(PG8_SB(0, 0), b2, voffB);
            PG8_BAR; PG8_WAIT_L(0); PG8_MMA(0, 1, At, B1); PG8_BAR;
            PG8_LDA(At, 0, 1); PG8_STAGE(PG8_SA(0, 0), a2, voffA);
            PG8_BAR; PG8_WAIT_L(0); PG8_MMA(1, 0, At, B0); PG8_BAR; PG8_SCHED;
            PG8_STAGE(PG8_SB(0, 1), b2 + hstepB, voffB);
            PG8_WAIT_V(6); PG8_BAR; PG8_MMA(1, 1, At, B1); PG8_BAR;
            PG8_LDB(B0, 1, 0); PG8_SCHED; PG8_LDA(At, 1, 0); PG8_STAGE(PG8_SA(0, 1), a2 + hstepA, voffA);
            PG8_WAIT_L(8); PG8_BAR; PG8_WAIT_L(0); PG8_MMA(0, 0, At, B0); PG8_BAR; PG8_SCHED;
            PG8_LDB(B1, 1, 1); PG8_STAGE(PG8_SB(1, 0), b3, voffB);
            PG8_BAR; PG8_WAIT_L(0); PG8_MMA(0, 1, At, B1); PG8_BAR;
            PG8_LDA(At, 1, 1); PG8_STAGE(PG8_SA(1, 0), a3, voffA);
            PG8_BAR; PG8_WAIT_L(0); PG8_MMA(1, 0, At, B0); PG8_BAR; PG8_SCHED;
            PG8_STAGE(PG8_SB(1, 1), b3 + hstepB, voffB);
            PG8_WAIT_V(6); PG8_BAR; PG8_MMA(1, 1, At, B1); PG8_BAR;
            }
        }
        if constexpr (F8) { asm volatile("s_nop 15\n\ts_nop 15" ::: "memory"); }
        if constexpr (ALIGN_EPI) { if (wr == 0) PG8_BAR; }
        if constexpr (!Epi::AFTER_DRAIN) { E(acc, cur, wr, wc, fr, fq); S.done(cur); }
        if (!has_next) break;
#pragma unroll
        for (int a = 0; a < 2; ++a)
#pragma unroll
            for (int b = 0; b < 2; ++b)
#pragma unroll
                for (int m = 0; m < 4; ++m)
#pragma unroll
                    for (int n = 0; n < 2; ++n) acc[a][b][m][n] = (f32x4){0.f, 0.f, 0.f, 0.f};
        cur = nxt; cA = nA; cB = nB; ++ui;
        if constexpr (ALIGN_EPI) { if (wr == 1) PG8_BAR; }
    }
    PG8_WAIT_V(0);
    if constexpr (!ALIGN_EPI) { if (wr == 0) PG8_BAR; }
    PG8_BAR;
    if constexpr (Epi::AFTER_DRAIN) { E.fused(acc, cur, wr, wc, fr, fq, lds, wid, lane); S.done(cur); }
#undef PG8_SA
#undef PG8_SB
#undef PG8_STAGE
#undef PG8_LDA
#undef PG8_LDB
#undef PG8_MMA
#undef PG8_WAIT_V
#undef PG8_WAIT_L
#undef PG8_BAR
#undef PG8_SCHED
}}

constexpr size_t MiB = 1u << 20;
constexpr size_t WS_CTL = 0, CTL_ZERO_BYTES = 2 * MiB;
constexpr size_t WS_MOD = 1 * MiB;
constexpr size_t WS_BT1 = 2 * MiB;
constexpr size_t WS_W8IN = 16 * MiB;
constexpr size_t WS_G8 = 64 * MiB;
constexpr size_t WS_H8 = 96 * MiB;
constexpr size_t WS_BT2 = 128 * MiB;
constexpr size_t WS_WUK = 148 * MiB;
constexpr size_t WS_BTUV = 150 * MiB;
constexpr size_t WS_BTUP = 152 * MiB;
constexpr size_t WS_BTOUT = 184 * MiB;
constexpr size_t WS_BTPQ = 216 * MiB;
constexpr size_t WS_SK = 232 * MiB;
constexpr size_t WS_U8 = 233 * MiB, WS_V8 = 297 * MiB, WS_SU = 361 * MiB, WS_SV = 362 * MiB;
constexpr int ROW6 = 3072;
constexpr size_t WS_H = 489 * MiB;
constexpr size_t WS_P1 = 553 * MiB;
constexpr size_t WS_Q2 = 805 * MiB;
constexpr size_t WS_QL = 965 * MiB;
constexpr size_t WS_SC = 1093 * MiB;
constexpr size_t WS_SEL = 1157 * MiB, WS_CNT = 1165 * MiB, WS_WIDX = 1166 * MiB;
constexpr size_t WS_OLAT = 1168 * MiB;
constexpr size_t WS_YCAT = 1296 * MiB;
constexpr size_t WS_MERGED8 = 1328 * MiB;
constexpr size_t WS_MERGED = 1360 * MiB;
constexpr size_t WS_PQ = 1424 * MiB;
constexpr size_t WS_EID = 1456 * MiB, WS_GATE = 1460 * MiB;
constexpr size_t WS_CKV = 1528 * MiB;
constexpr size_t WS_END = 1536 * MiB;

constexpr int SCRATCH_BYTES = 155648;
constexpr int MISC_OFF = SCRATCH_BYTES;
constexpr int LDS_BYTES = SCRATCH_BYTES + 1024;
constexpr int NWAVES = 8, NTHR = 512;

struct Params {
    const float *x, *c, *w_ada, *b_ada, *g_mix, *w_in, *g_cq, *g_ckv, *w_uq, *w_uk, *w_uv, *w_qi, *g_ki, *b_ki, *t5, *g_ret, *w_up, *w_gate, *b_gate, *w_out, *g_ffn, *w_pq, *sub_keys, *u_exp, *v_exp, *g_final;
    float* out; unsigned char* ws; int ph_lo, ph_hi;
};

#define LDS_WAIT() asm volatile("s_waitcnt lgkmcnt(0)" ::: "memory")
#define VM_WAIT() asm volatile("s_waitcnt vmcnt(0)" ::: "memory")

#define XB_TMO      128
#define XB_XCNT(j)  (256  + 64 * (j))
#define XB_XSUB(j)  (1280 + 64 * (j))
#define XB_XGEN(j)  (2304 + 64 * (j))
#define XB_TOP      3328
#define XB_TOPGEN   3392
#define XCD_BAR_WORDS 3456
#define XB_ATT_RANK  4096
#define XB_SPIN_CAP (1u << 18)

__device__ __forceinline__ unsigned xb_ld(unsigned* p)              { return __hip_atomic_load(p, __ATOMIC_RELAXED, __HIP_MEMORY_SCOPE_AGENT); }
__device__ __forceinline__ unsigned xb_add(unsigned* p, unsigned v) { return __hip_atomic_fetch_add(p, v, __ATOMIC_RELAXED, __HIP_MEMORY_SCOPE_AGENT); }
__device__ __forceinline__ unsigned xb_xcc_id() { return (unsigned)__builtin_amdgcn_s_getreg((3 << 11) | 20) & 0xFu; }
#define XB_SPIN(cond, bar) do { unsigned _sp = 0; while (cond) { __builtin_amdgcn_s_sleep(1); \
    if ((++_sp & 255u) == 0u) { if (xb_ld(&(bar)[XB_TMO])) break; if (_sp > XB_SPIN_CAP) { atomicAdd(&(bar)[XB_TMO], 1u); break; } } } } while (0)

struct XcdBarrier { unsigned* bar; unsigned x; volatile LAS unsigned* st; };

__device__ __forceinline__ XcdBarrier xcd_barrier_post(unsigned* bar, volatile LAS unsigned* st) {
    XcdBarrier b; b.bar = bar; b.x = xb_xcc_id(); b.st = st;
    if (threadIdx.x == 0) (void)xb_add(&bar[XB_XCNT(b.x)], 1u);
    return b;
}
__device__ __forceinline__ void xcd_barrier_complete(unsigned* bar, unsigned x, unsigned& nloc, unsigned& nx) {
    const unsigned G = gridDim.x * gridDim.y * gridDim.z;
    unsigned sum, cnt, mine, sp = 0u;
    for (;;) {
        sum = 0u; cnt = 0u; mine = 0u;
#pragma unroll
        for (unsigned j = 0; j < 16; ++j) { const unsigned c = xb_ld(&bar[XB_XCNT(j)]); sum += c; cnt += (c > 0u) ? 1u : 0u; mine = (j == x) ? c : mine; }
        if (sum == G) break;
        __builtin_amdgcn_s_sleep(1);
        if ((++sp & 255u) == 0u) { if (xb_ld(&bar[XB_TMO])) break; if (sp > XB_SPIN_CAP) { atomicAdd(&bar[XB_TMO], 1u); break; } }
    }
    nloc = mine > 0u ? mine : 1u; nx = cnt > 0u ? cnt : 1u;
}
__device__ __forceinline__ void xcd_barrier(const XcdBarrier& b) {
    asm volatile("s_waitcnt vmcnt(0)" ::: "memory");
    __syncthreads();
    if (threadIdx.x == 0) {
        unsigned* bar = b.bar;
        __builtin_amdgcn_s_waitcnt(0);
        unsigned nloc = b.st[0], nx = b.st[1];
        if (nloc == 0u) { xcd_barrier_complete(bar, b.x, nloc, nx); b.st[0] = nloc; b.st[1] = nx; }
        const unsigned old = xb_add(&bar[XB_XSUB(b.x)], 1u);
        const unsigned gen = old / nloc;
        if (old + 1u == (gen + 1u) * nloc) {
            __builtin_amdgcn_fence(__ATOMIC_RELEASE, "agent");
            asm volatile("s_waitcnt vmcnt(0)" ::: "memory");
            const unsigned og = xb_add(&bar[XB_TOP], 1u);
            const unsigned tg = og / nx;
            if (og + 1u == (tg + 1u) * nx) xb_add(&bar[XB_TOPGEN], 1u);
            else XB_SPIN(xb_ld(&bar[XB_TOPGEN]) == tg, bar);
            __builtin_amdgcn_fence(__ATOMIC_ACQUIRE, "agent");
            xb_add(&bar[XB_XGEN(b.x)], 1u);
            asm volatile("s_waitcnt vmcnt(0)" ::: "memory");
        } else {
            XB_SPIN(xb_ld(&bar[XB_XGEN(b.x)]) == gen, bar);
            __builtin_amdgcn_fence(__ATOMIC_ACQUIRE, "agent");
            asm volatile("s_waitcnt vmcnt(0)" ::: "memory");
        }
    }
    __syncthreads();
}

struct Ctx { LAS unsigned char* lds; int tid, lane, wave, gw, ngw, bid, nb; };

__device__ __forceinline__ void p0_transpose_item(const float* W, int K, int N, bf16* WT, int row_off, LAS float* scr, int item, int lane, int ldw = 0) {
    if (!ldw) ldw = N;
    const int nblk = N / 32, kb = item / nblk, nb = item % nblk, k0 = 64 * kb, n0 = 32 * nb;
#pragma unroll 8
    for (int i = 0; i < 32; ++i) { const int kk = 2 * i + (lane >> 5); scr[kk * 33 + (lane & 31)] = W[(size_t)(k0 + kk) * ldw + n0 + (lane & 31)]; }
    LDS_WAIT(); asm volatile("" ::: "memory");
    const int c = lane & 7;
#pragma unroll
    for (int j = 0; j < 4; ++j) { const int n = (lane >> 3) + 8 * j; const LAS float* s = scr + (8 * c) * 33 + n;
        v4u o; o.x = cvt_pk_bf16(s[0 * 33], s[1 * 33]); o.y = cvt_pk_bf16(s[2 * 33], s[3 * 33]); o.z = cvt_pk_bf16(s[4 * 33], s[5 * 33]); o.w = cvt_pk_bf16(s[6 * 33], s[7 * 33]);
        *(v4u*)(WT + (size_t)(row_off + n0 + n) * K + k0 + 8 * c) = o; }
    LDS_WAIT(); asm volatile("" ::: "memory");
}
__device__ __forceinline__ void p0_transpose_item_f8(const float* W, int K, int N, unsigned char* WT, float sc, LAS float* scr, int item, int lane, int ldw = 0) {
    if (!ldw) ldw = N;
    const int nblk = N / 32, kb = item / nblk, nb = item % nblk, k0 = 64 * kb, n0 = 32 * nb;
#pragma unroll 8
    for (int i = 0; i < 32; ++i) { const int kk = 2 * i + (lane >> 5); scr[kk * 33 + (lane & 31)] = W[(size_t)(k0 + kk) * ldw + n0 + (lane & 31)]; }
    LDS_WAIT(); asm volatile("" ::: "memory");
    const int n = lane >> 1, kh = (lane & 1) * 32; const LAS float* s = scr + kh * 33 + n;
    unsigned o[8];
#pragma unroll
    for (int j = 0; j < 8; ++j) { int w = 0; w = PK_FP8(s[(4 * j) * 33] * sc, s[(4 * j + 1) * 33] * sc, w, false); w = PK_FP8(s[(4 * j + 2) * 33] * sc, s[(4 * j + 3) * 33] * sc, w, true); o[j] = (unsigned)w; }
    unsigned char* dp = WT + (size_t)(n0 + n) * K + k0 + kh;
    *(v4u*)dp = (v4u){o[0], o[1], o[2], o[3]}; *(v4u*)(dp + 16) = (v4u){o[4], o[5], o[6], o[7]};
    LDS_WAIT(); asm volatile("" ::: "memory");
}
__device__ __forceinline__ void p0_convert(const float* src, bf16* dst, size_t n, size_t i0, size_t stride) {
    for (size_t i = i0; i < n / 8; i += stride) { const f32x4 a = *(const f32x4*)(src + 8 * i), b = *(const f32x4*)(src + 8 * i + 4);
        v4u o; o.x = cvt_pk_bf16(a[0], a[1]); o.y = cvt_pk_bf16(a[2], a[3]); o.z = cvt_pk_bf16(b[0], b[1]); o.w = cvt_pk_bf16(b[2], b[3]); *(v4u*)(dst + 8 * i) = o; }
}

__device__ __forceinline__ void tr32_item(const float* W, int K, int N, bf16* WT, LAS float* scr, int item, int lane) {
    const int nblk = N / 32, kb = item / nblk, nb = item % nblk, k0 = 32 * kb, n0 = 32 * nb;
#pragma unroll 8
    for (int i = 0; i < 16; ++i) { const int kk = 2 * i + (lane >> 5); scr[kk * 33 + (lane & 31)] = W[(size_t)(k0 + kk) * N + n0 + (lane & 31)]; }
    LDS_WAIT(); asm volatile("" ::: "memory");
#pragma unroll
    for (int j = 0; j < 2; ++j) { const int q = lane + 64 * j, n = q >> 2, cch = q & 3; const LAS float* s = scr + (8 * cch) * 33 + n;
        v4u o; o.x = cvt_pk_bf16(s[0 * 33], s[1 * 33]); o.y = cvt_pk_bf16(s[2 * 33], s[3 * 33]); o.z = cvt_pk_bf16(s[4 * 33], s[5 * 33]); o.w = cvt_pk_bf16(s[6 * 33], s[7 * 33]);
        *(v4u*)(WT + (size_t)(n0 + n) * K + k0 + 8 * cch) = o; }
    LDS_WAIT(); asm volatile("" ::: "memory");
}
__device__ __forceinline__ void tr32_item_f8(const float* W, int K, int N, unsigned char* WT, float sc, LAS float* scr, int item, int lane) {
    const int nblk = N / 32, kb = item / nblk, nb = item % nblk, k0 = 32 * kb, n0 = 32 * nb;
#pragma unroll 8
    for (int i = 0; i < 16; ++i) { const int kk = 2 * i + (lane >> 5); scr[kk * 33 + (lane & 31)] = W[(size_t)(k0 + kk) * N + n0 + (lane & 31)]; }
    LDS_WAIT(); asm volatile("" ::: "memory");
    const int n = lane >> 1, kh = (lane & 1) * 16; const LAS float* s = scr + kh * 33 + n;
    unsigned o[4];
#pragma unroll
    for (int j = 0; j < 4; ++j) { int w = 0; w = PK_FP8(s[(4 * j) * 33] * sc, s[(4 * j + 1) * 33] * sc, w, false); w = PK_FP8(s[(4 * j + 2) * 33] * sc, s[(4 * j + 3) * 33] * sc, w, true); o[j] = (unsigned)w; }
    *(v4u*)(WT + (size_t)(n0 + n) * K + k0 + kh) = (v4u){o[0], o[1], o[2], o[3]};
    LDS_WAIT(); asm volatile("" ::: "memory");
}
__device__ __forceinline__ void convert_late_weights(const Params& p, LAS float* scr, int lane, int first, int stride) {
    unsigned char* ws = p.ws;
    constexpr int I_UP = 128 * (D / 32), I_OUT = 128 * (D / 32), I_PQ = 128 * (2048 / 32);
    for (int it = first; it < I_UP + I_OUT + I_PQ; it += stride) { int r = it;
        if (r < I_UP) { tr32_item_f8(p.w_up, D, D, ws + WS_BTUP, 1024.0f, scr, r, lane); continue; } r -= I_UP;
        if (r < I_OUT) { tr32_item_f8(p.w_out, D, D, ws + WS_BTOUT, 1024.0f, scr, r, lane); continue; } r -= I_OUT;
        tr32_item(p.w_pq, D, 2048, (bf16*)(ws + WS_BTPQ), scr, r, lane); }
}
constexpr size_t WS_MODP = 1093 * MiB;
__device__ __forceinline__ void adaln_late(const Params& p, int item, int lane) {
    const int cc = item & 63, rg = item >> 6;
    const float* wp = p.w_ada + (size_t)(rg * 256) * (6 * D) + 2 * D + cc * 256 + lane * 4;
    f32x4 a0 = {0.f, 0.f, 0.f, 0.f}, a1 = a0, a2 = a0, a3 = a0;
#pragma unroll 8
    for (int d = 0; d < 256; ++d) { const f32x4 w = *(const f32x4*)(wp + (size_t)d * (6 * D)); const int dd = rg * 256 + d;
        const float c0 = p.c[dd], c1 = p.c[D + dd], c2 = p.c[2 * D + dd], c3 = p.c[3 * D + dd];
        a0 += w * (c0 / (1.0f + __expf(-c0))); a1 += w * (c1 / (1.0f + __expf(-c1))); a2 += w * (c2 / (1.0f + __expf(-c2))); a3 += w * (c3 / (1.0f + __expf(-c3))); }
    float* pp = (float*)(p.ws + WS_MODP) + (size_t)(rg * 4) * (4 * D) + cc * 256 + lane * 4;
    *(f32x4*)(pp) = a0; *(f32x4*)(pp + 4 * D) = a1; *(f32x4*)(pp + 2 * 4 * D) = a2; *(f32x4*)(pp + 3 * 4 * D) = a3;
}
__device__ __forceinline__ void adaln_late_reduce(const Params& p, const Ctx& c) {
    const float* pp = (const float*)(p.ws + WS_MODP); float* mod = (float*)(p.ws + WS_MOD);
    for (int i = c.bid * NTHR + c.tid; i < 4 * 4 * D; i += c.nb * NTHR) { const int b = i / (4 * D), col = i % (4 * D); float s_ = p.b_ada[2 * D + col];
#pragma unroll
        for (int rg = 0; rg < 16; ++rg) s_ += pp[(size_t)(rg * 4 + b) * (4 * D) + col];
        mod[(size_t)b * 6 * D + 2 * D + col] = s_; }
}
__device__ __forceinline__ void convert_expert_rows(const Params& p, const Ctx& c, int r_first, int r_stride) {
    unsigned char* ws = p.ws;
        {
            typedef float v16f_t __attribute__((ext_vector_type(16))); typedef float v32f_t __attribute__((ext_vector_type(32))); typedef unsigned v6u_t __attribute__((ext_vector_type(6)));
            v16f_t pa, pb;
#pragma unroll
            for (int i = 0; i < 16; ++i) { pa[i] = (i < 8) ? 0.125f * i : 1.0f + 0.125f * (i - 8); pb[i] = (i < 8) ? 2.0f + 0.25f * i : 4.0f + 0.5f * (i - 8); }
            const v32f_t pd = __builtin_amdgcn_cvt_scalef32_pk32_f32_fp6(__builtin_amdgcn_cvt_scalef32_2xpk16_fp6_f32(pa, pb, 1.0f), 1.0f);
            const bool inter = (pd[1] == pb[0]);
            bool okl = true;
#pragma unroll
            for (int i = 0; i < 16; ++i) okl = okl && (inter ? (pd[2 * i] == pa[i] && pd[2 * i + 1] == pb[i]) : (pd[i] == pa[i] && pd[16 + i] == pb[i]));
            for (int r = r_first; r < 2 * P_EXP; r += r_stride) {
                const bool isv = r >= P_EXP; const int e = isv ? r - P_EXP : r;
                const float* src = (isv ? p.v_exp : p.u_exp) + (size_t)e * D;
                f32x4 v[16]; float mx = 0.f;
#pragma unroll
                for (int g = 0; g < 2; ++g)
#pragma unroll
                    for (int k = 0; k < 8; ++k) { v[g * 8 + k] = *(const f32x4*)(src + (g * 64 + c.lane) * 32 + k * 4);
                        mx = fmaxf(mx, fmaxf(fmaxf(fabsf(v[g * 8 + k].x), fabsf(v[g * 8 + k].y)), fmaxf(fabsf(v[g * 8 + k].z), fabsf(v[g * 8 + k].w)))); }
#pragma unroll
                for (int o = 1; o < 64; o <<= 1) mx = fmaxf(mx, __shfl_xor(mx, o));
                const float scale = (mx > 0.f) ? mx * (1.0f / 7.5f) : 1.0f; float inv = 1.0f / scale;
                if (!okl) inv = __builtin_nanf("");
                unsigned char* dst = ws + (isv ? WS_V8 : WS_U8) + (size_t)e * ROW6;
                v6u_t wq[2];
#pragma unroll
                for (int g = 0; g < 2; ++g) { v16f_t a, b;
#pragma unroll
                    for (int i = 0; i < 16; ++i) { const float ei = v[g * 8 + (2 * i) / 4][(2 * i) % 4], eo = v[g * 8 + (2 * i + 1) / 4][(2 * i + 1) % 4];
                        const float lo = v[g * 8 + i / 4][i % 4], hi = v[g * 8 + 4 + i / 4][i % 4];
                        a[i] = (inter ? ei : lo) * inv; b[i] = (inter ? eo : hi) * inv; }
                    wq[g] = __builtin_amdgcn_cvt_scalef32_2xpk16_fp6_f32(a, b, 1.0f); }
                *(v4u*)(dst + c.lane * 16) = (v4u){wq[0][0], wq[0][1], wq[0][2], wq[0][3]};
                *(v4u*)(dst + 1024 + c.lane * 16) = (v4u){wq[0][4], wq[0][5], wq[1][0], wq[1][1]};
                *(v4u*)(dst + 2048 + c.lane * 16) = (v4u){wq[1][2], wq[1][3], wq[1][4], wq[1][5]};
                if (c.lane == 0) ((float*)(ws + (isv ? WS_SV : WS_SU)))[e] = scale;
            }
        }
}

__device__ __forceinline__ void ph_prologue(const Params& p, const Ctx& c) {
    unsigned char* ws = p.ws;
    {
        float* mod = (float*)(ws + WS_MOD); LAS float* sc = (LAS float*)c.lds;
        LAS float* red = sc + 4 * D;
        for (int it = c.bid; it < 2 * D / 128; it += c.nb) {
            __syncthreads();
            for (int i = c.tid; i < 4 * D; i += NTHR) { const float v = p.c[i]; sc[i] = v / (1.0f + __expf(-v)); }
            __syncthreads();
            const int ct = c.tid & 31, dg = c.tid >> 5, e = it * 128 + ct * 4;
            f32x4 a0 = {0, 0, 0, 0}, a1 = a0, a2 = a0, a3 = a0;
            const float* wp = p.w_ada + (size_t)dg * (6 * D) + e;
#pragma unroll 8
            for (int i = 0; i < D / 16; ++i) { const f32x4 w = *(const f32x4*)(wp + (size_t)(16 * i) * (6 * D)); const int d = dg + 16 * i;
                a0 += w * sc[d]; a1 += w * sc[D + d]; a2 += w * sc[2 * D + d]; a3 += w * sc[3 * D + d]; }
            *(LAS f32x4*)(red + (dg * 4 + 0) * 128 + ct * 4) = a0; *(LAS f32x4*)(red + (dg * 4 + 1) * 128 + ct * 4) = a1;
            *(LAS f32x4*)(red + (dg * 4 + 2) * 128 + ct * 4) = a2; *(LAS f32x4*)(red + (dg * 4 + 3) * 128 + ct * 4) = a3;
            __syncthreads();
            { const int b = c.tid >> 7, col = c.tid & 127; float s = p.b_ada[it * 128 + col];
#pragma unroll
              for (int g = 0; g < 16; ++g) s += red[(g * 4 + b) * 128 + col];
              mod[(size_t)b * 6 * D + it * 128 + col] = s; }
        }
        __syncthreads();
    }
    {
        LAS float* scr = (LAS float*)(c.lds + c.wave * 8448);
        bf16* BT1 = (bf16*)(ws + WS_BT1); bf16* BT2 = (bf16*)(ws + WS_BT2);
        constexpr int I_IN = 64 * (IN_BF / 32), I_IN8 = 64 * ((IN_WIDTH - IN_BF) / 32), I_GATE = 64 * (2 * D / 32), I_UQ = 16 * (A_WIDTH / 32), I_QI = 16 * (IDX_H * IDX_D / 32), I_UV = 8 * (A_WIDTH / 32),
                      I_UVX = 0;
        constexpr int NITEMS = I_IN + I_IN8 + I_GATE + I_UQ + I_QI + I_UV + I_UVX;
        for (int it = c.gw; it < NITEMS; it += c.ngw) {
            int r = it;
            if (r < I_IN) { p0_transpose_item(p.w_in, D, IN_BF, BT1, 0, scr, r, c.lane, IN_WIDTH); continue; } r -= I_IN;
            if (r < I_IN8) { p0_transpose_item_f8(p.w_in + IN_BF, D, IN_WIDTH - IN_BF, ws + WS_W8IN, 1024.0f, scr, r, c.lane, IN_WIDTH); continue; } r -= I_IN8;
            if (r < I_GATE) { p0_transpose_item_f8(p.w_gate, D, 2 * D, ws + WS_G8, 1024.0f, scr, r, c.lane); continue; } r -= I_GATE;
            if (r < I_UQ) { p0_transpose_item(p.w_uq, A_QR, A_WIDTH, BT2, 0, scr, r, c.lane); continue; } r -= I_UQ;
            if (r < I_QI) { p0_transpose_item(p.w_qi, A_QR, IDX_H * IDX_D, BT2, A_WIDTH, scr, r, c.lane); continue; } r -= I_QI;
            p0_transpose_item(p.w_uv, A_KVR, A_WIDTH, (bf16*)(ws + WS_BTUV), 0, scr, r, c.lane);
        }
        const size_t gt = (size_t)c.bid * NTHR + c.tid, gs = (size_t)c.nb * NTHR;
        for (size_t i = gt; i < (size_t)(IN_PAD - IN_WIDTH) * D / 16; i += gs) *(v4u*)(ws + WS_W8IN + (size_t)(IN_WIDTH - IN_BF) * D + 16 * i) = (v4u){0u, 0u, 0u, 0u};
        p0_convert(p.w_uk, (bf16*)(ws + WS_WUK), (size_t)A_KVR * A_WIDTH, gt, gs);
        p0_convert(p.sub_keys, (bf16*)(ws + WS_SK), (size_t)2 * P_NK * 128, gt, gs);
    }
}

__device__ __forceinline__ void ph_modulate(const float* X, const float* g, const float* mod, int sh_off, int sc_off, bf16* H, unsigned char* H8, const Ctx& c) {
    for (int m = c.gw; m < T; m += c.ngw) {
        const int b = m / SEQ;
        const f32x4* xr = (const f32x4*)(X + (size_t)m * D) + c.lane;
        f32x4 v[16]; float s = 0.f;
#pragma unroll
        for (int j = 0; j < 16; ++j) { v[j] = xr[64 * j]; s += (v[j].x * v[j].x + v[j].y * v[j].y) + (v[j].z * v[j].z + v[j].w * v[j].w); }
        const float rstd = 1.0f / sqrtf(wave_sum(s) * (1.0f / D) + EPS);
        const f32x4* gp = (const f32x4*)g + c.lane; const f32x4* shp = (const f32x4*)(mod + (size_t)b * 6 * D + sh_off) + c.lane; const f32x4* scp = (const f32x4*)(mod + (size_t)b * 6 * D + sc_off) + c.lane;
        v2u* o = (v2u*)(H + (size_t)m * D) + c.lane;
#pragma unroll
        for (int j = 0; j < 16; ++j) { const f32x4 gg = gp[64 * j], sh = shp[64 * j], sc = scp[64 * j];
            const f32x4 y = (v[j] * rstd * gg) * (sc + 1.0f) + sh;
            v2u w; w.x = cvt_pk_bf16(y.x, y.y); w.y = cvt_pk_bf16(y.z, y.w); o[64 * j] = w;
            if (H8) { int q = 0; q = PK_FP8(y.x * 16.0f, y.y * 16.0f, q, false); q = PK_FP8(y.z * 16.0f, y.w * 16.0f, q, true); ((unsigned*)(H8 + (size_t)m * D))[c.lane + 64 * j] = (unsigned)q; } }
    }
}

__device__ __forceinline__ void ph_postproc(const Params& p, const Ctx& c) {
    bf16* P1 = (bf16*)(p.ws + WS_P1); float* WIDX = (float*)(p.ws + WS_WIDX);
    const int lane = c.lane;
    const float inv = exp2f(-(float)lane * (13.287712379549449f / 63.0f));
    for (int t = c.gw; t < T; t += c.ngw) {
        bf16* row = P1 + (size_t)t * N1;
        const int pos = t % SEQ;
        { v4u a = *(v4u*)(row + C_CQ + lane * 8), b = *(v4u*)(row + C_CQ + 512 + lane * 8);
          float f[16] = {bflo(a.x), bfhi(a.x), bflo(a.y), bfhi(a.y), bflo(a.z), bfhi(a.z), bflo(a.w), bfhi(a.w), bflo(b.x), bfhi(b.x), bflo(b.y), bfhi(b.y), bflo(b.z), bfhi(b.z), bflo(b.w), bfhi(b.w)};
          float s = 0.f;
#pragma unroll
          for (int j = 0; j < 16; ++j) s += f[j] * f[j];
          const float rstd = 1.0f / sqrtf(wave_sum(s) * (1.0f / A_QR) + EPS);
          const float* g0 = p.g_cq + lane * 8; const float* g1 = p.g_cq + 512 + lane * 8;
#pragma unroll
          for (int j = 0; j < 8; ++j) { f[j] *= rstd * g0[j]; f[8 + j] *= rstd * g1[j]; }
          a.x = cvt_pk_bf16(f[0], f[1]); a.y = cvt_pk_bf16(f[2], f[3]); a.z = cvt_pk_bf16(f[4], f[5]); a.w = cvt_pk_bf16(f[6], f[7]);
          b.x = cvt_pk_bf16(f[8], f[9]); b.y = cvt_pk_bf16(f[10], f[11]); b.z = cvt_pk_bf16(f[12], f[13]); b.w = cvt_pk_bf16(f[14], f[15]);
          *(v4u*)(row + C_CQ + lane * 8) = a; *(v4u*)(row + C_CQ + 512 + lane * 8) = b; }
        { v4u a = *(v4u*)(row + C_CKV + lane * 8);
          float f[8] = {bflo(a.x), bfhi(a.x), bflo(a.y), bfhi(a.y), bflo(a.z), bfhi(a.z), bflo(a.w), bfhi(a.w)};
          float s = 0.f;
#pragma unroll
          for (int j = 0; j < 8; ++j) s += f[j] * f[j];
          const float rstd = 1.0f / sqrtf(wave_sum(s) * (1.0f / A_KVR) + EPS);
          const float* g0 = p.g_ckv + lane * 8;
#pragma unroll
          for (int j = 0; j < 8; ++j) f[j] *= rstd * g0[j];
          a.x = cvt_pk_bf16(f[0], f[1]); a.y = cvt_pk_bf16(f[2], f[3]); a.z = cvt_pk_bf16(f[4], f[5]); a.w = cvt_pk_bf16(f[6], f[7]);
          *(v4u*)((bf16*)(p.ws + WS_CKV) + (size_t)t * A_KVR + lane * 8) = a; }
        { unsigned w = *(unsigned*)(row + C_KI + lane * 2); const float f0 = bflo(w), f1 = bfhi(w);
          const float mu = wave_sum(f0 + f1) * (1.0f / IDX_D); const float d0 = f0 - mu, d1 = f1 - mu;
          const float var = wave_sum(d0 * d0 + d1 * d1) * (1.0f / IDX_D); const float rstd = 1.0f / sqrtf(var + EPS);
          const float y0 = d0 * rstd * p.g_ki[lane * 2] + p.b_ki[lane * 2], y1 = d1 * rstd * p.g_ki[lane * 2 + 1] + p.b_ki[lane * 2 + 1];
          *(unsigned*)(row + C_KI + lane * 2) = cvt_pk_bf16(y0, y1); }
        WIDX[(size_t)t * IDX_H + lane] = bf2f(row[C_WI + lane]) * (0.125f * 0.08838834764831845f);
        { const float angf = (float)pos * inv; const double a = (double)angf; const double r = a - 6.283185307179586476925 * rint(a * 0.15915494309189533577);
          float sn, cs; __sincosf((float)r, &sn, &cs);
#pragma unroll
          for (int h = 0; h < R_HEADS; ++h) {
              bf16* q = row + C_RQ + h * 128; bf16* k = row + C_RK + h * 128;
              const float q1 = bf2f(q[lane]), q2 = bf2f(q[64 + lane]), k1 = bf2f(k[lane]) * 0.08838834764831845f, k2 = bf2f(k[64 + lane]) * 0.08838834764831845f;
              q[lane] = f2bf(q1 * cs - q2 * sn); q[64 + lane] = f2bf(q1 * sn + q2 * cs);
              k[lane] = f2bf(k1 * cs - k2 * sn); k[64 + lane] = f2bf(k1 * sn + k2 * cs); } }
    }
}

template <bool OUT8> __device__ __forceinline__ void lds_gemm_unit(const bf16* A, int lda, const bf16* Bt, int ldb, int K, void* C, int ldc, float s8, const Ctx& c) {
    constexpr int PB = 272; LAS unsigned char* As = c.lds; LAS unsigned char* Bs = c.lds + 256 * PB;
    const int tid = c.tid, lane = c.lane, wr = c.wave >> 1, wc = c.wave & 1, fr = lane & 15, fq = lane >> 4;
    f32x4 acc[4][4];
#pragma unroll
    for (int i = 0; i < 4; ++i)
#pragma unroll
        for (int j = 0; j < 4; ++j) acc[i][j] = (f32x4){0.f, 0.f, 0.f, 0.f};
    for (int k0 = 0; k0 < K; k0 += 128) {
        __syncthreads();
#pragma unroll
        for (int i = 0; i < 8; ++i) { const int q = tid + 512 * i, r = q >> 4, ch = q & 15; *(LAS v4u*)(As + r * PB + ch * 16) = *(const v4u*)(A + (size_t)r * lda + k0 + ch * 8); }
#pragma unroll
        for (int i = 0; i < 4; ++i) { const int q = tid + 512 * i, r = q >> 4, ch = q & 15; *(LAS v4u*)(Bs + r * PB + ch * 16) = *(const v4u*)(Bt + (size_t)r * ldb + k0 + ch * 8); }
        LDS_WAIT(); __syncthreads();
#pragma unroll
        for (int ks = 0; ks < 4; ++ks) { bf16x8 a[4], b[4];
#pragma unroll
            for (int i = 0; i < 4; ++i) { a[i] = *(const LAS bf16x8*)(As + (64 * wr + 16 * i + fr) * PB + ks * 64 + fq * 16); b[i] = *(const LAS bf16x8*)(Bs + (64 * wc + 16 * i + fr) * PB + ks * 64 + fq * 16); }
#pragma unroll
            for (int i = 0; i < 4; ++i)
#pragma unroll
                for (int j = 0; j < 4; ++j) acc[i][j] = __builtin_amdgcn_mfma_f32_16x16x32_bf16(b[j], a[i], acc[i][j], 0, 0, 0); }
    }
#pragma unroll
    for (int i = 0; i < 4; ++i)
#pragma unroll
        for (int j = 0; j < 4; ++j) { const size_t off = (size_t)(64 * wr + 16 * i + fr) * ldc + 64 * wc + 16 * j + 4 * fq;
            if constexpr (OUT8) { int q = 0; q = PK_FP8(acc[i][j][0] * s8, acc[i][j][1] * s8, q, false); q = PK_FP8(acc[i][j][2] * s8, acc[i][j][3] * s8, q, true); *(unsigned*)((unsigned char*)C + off) = (unsigned)q; }
            else { v2u w; w.x = cvt_pk_bf16(acc[i][j][0], acc[i][j][1]); w.y = cvt_pk_bf16(acc[i][j][2], acc[i][j][3]); *(v2u*)((bf16*)C + off) = w; } }
}
__device__ __forceinline__ void ph_qlat(const Params& p, const Ctx& c) {
    const bf16* Q2 = (const bf16*)(p.ws + WS_Q2); const bf16* WUK = (const bf16*)(p.ws + WS_WUK); bf16* QL = (bf16*)(p.ws + WS_QL);
    for (int u = c.bid; u < 16 * 32 * 4; u += c.nb) { const int h = u / 128, rem = u % 128, rt = rem / 4, ct = rem % 4;
        lds_gemm_unit<false>(Q2 + (size_t)(rt * 256) * N2 + h * 128, N2, WUK + (size_t)(ct * 128) * A_WIDTH + h * 128, A_WIDTH, 128, QL + (size_t)(rt * 256) * 8192 + h * 512 + ct * 128, 8192, 1.0f, c); }
    __syncthreads();
}
__device__ __forceinline__ void ph_oproj(const Params& p, const Ctx& c) {
    const bf16* OL = (const bf16*)(p.ws + WS_OLAT); const bf16* BTUV = (const bf16*)(p.ws + WS_BTUV); unsigned char* Y8 = p.ws + WS_YCAT;
    for (int u = c.bid; u < 16 * 32; u += c.nb) { const int h = u / 32, rt = u % 32;
        lds_gemm_unit<true>(OL + (size_t)(rt * 256) * 8192 + h * 512, 8192, BTUV + (size_t)(h * 128) * A_KVR, A_KVR, A_KVR, Y8 + (size_t)(rt * 256) * D + h * 128, D, 16.0f, c); }
    __syncthreads();
}

__device__ __forceinline__ void ph_scores(const Params& p, const Ctx& c) {
    const bf16* P1 = (const bf16*)(p.ws + WS_P1); const bf16* Q2 = (const bf16*)(p.ws + WS_Q2); const float* WIDX = (const float*)(p.ws + WS_WIDX); float* SC = (float*)(p.ws + WS_SC);
    constexpr int QPB = 272, STAGE = 2 * 4 * 16 * QPB;
    constexpr int WPB = 272; LAS unsigned char* wl = c.lds + 2 * STAGE;
    const int tid = c.tid, lane = c.lane, w = c.wave, fr = lane & 15, fq = lane >> 4;
    for (int bu = c.bid; bu < NB * 64; bu += c.nb) {
        const int b = bu / 64, pr = bu % 64;
        const int qtA = pr, qtB = 127 - pr, na = qtA / 4 + 1, nb_ = qtB / 4 + 1, nitems = na + nb_;
        const int tA = b * SEQ + qtA * 16, tB = b * SEQ + qtB * 16;
        const int nrounds = (nitems + 7) / 8, nstages = nrounds * 16;
        const bf16* gsrc[4];
#pragma unroll
        for (int i = 0; i < 4; ++i) { const int q = tid + 512 * i, tile = q >> 10, hh = (q >> 8) & 3, qq = (q >> 4) & 15, ch = q & 15;
            gsrc[i] = Q2 + (size_t)((tile ? tB : tA) + qq) * N2 + A_WIDTH + hh * IDX_D + ch * 8; }
        v4u r0[4], r1[4];
#define SC_LOAD(R, st) do { const int _hg = (st) & 15; _Pragma("unroll") for (int i = 0; i < 4; ++i) R[i] = *(const v4u*)(gsrc[i] + _hg * 4 * IDX_D); } while (0)
#define SC_STORE(R, st) do { LAS unsigned char* _buf = c.lds + ((st) & 1) * STAGE; _Pragma("unroll") for (int i = 0; i < 4; ++i) { const int q = tid + 512 * i; *(LAS v4u*)(_buf + (q >> 4) * QPB + (q & 15) * 16) = R[i]; } } while (0)
        __syncthreads();
        SC_LOAD(r0, 0); SC_LOAD(r1, 1);
        { const int wt = tid >> 8, wq = (tid >> 4) & 15, wc = tid & 15;
          *(LAS f32x4*)(wl + (wt * 16 + wq) * WPB + wc * 16) = *(const f32x4*)(WIDX + (size_t)((wt ? tB : tA) + wq) * IDX_H + wc * 4); }
        SC_STORE(r0, 0);
        LDS_WAIT(); __syncthreads();
        for (int r = 0; r < nrounds; ++r) {
            const int item = r * 8 + w; const bool active = item < nitems;
            const int tile = (item < na) ? 0 : 1, kc = (item < na) ? item : item - na;
            const int tq0 = tile ? tB : tA, s0 = b * SEQ + kc * 64;
            bf16x8 kf[4][4];
            if (active) {
#pragma unroll
                for (int mi = 0; mi < 4; ++mi)
#pragma unroll
                    for (int ks = 0; ks < 4; ++ks) kf[mi][ks] = *(const bf16x8*)(P1 + (size_t)(s0 + 16 * mi + fr) * N1 + C_KI + 32 * ks + 8 * fq); }
            __builtin_amdgcn_s_waitcnt(0x0F70);
            f32x4 sc[4];
#pragma unroll
            for (int mi = 0; mi < 4; ++mi) sc[mi] = (f32x4){0.f, 0.f, 0.f, 0.f};
            const LAS unsigned char* wb = wl + (tile * 16 + fr) * WPB;
#define SC_MM(A, hh) do { bf16x8 qf[4]; _Pragma("unroll") for (int ks = 0; ks < 4; ++ks) qf[ks] = *(const LAS bf16x8*)(buf + (hh) * 16 * QPB + ks * 64); \
                _Pragma("unroll") for (int mi = 0; mi < 4; ++mi) A[mi] = (f32x4){0.f, 0.f, 0.f, 0.f}; \
                _Pragma("unroll") for (int ks = 0; ks < 4; ++ks) _Pragma("unroll") for (int mi = 0; mi < 4; ++mi) A[mi] = __builtin_amdgcn_mfma_f32_16x16x32_bf16(kf[mi][ks], qf[ks], A[mi], 0, 0, 0); } while (0)
#define SC_EPI(A, hh) do { _Pragma("unroll") for (int mi = 0; mi < 4; ++mi) _Pragma("unroll") for (int j = 0; j < 4; ++j) sc[mi][j] += wv[hh] * __int_as_float(max(__float_as_int(A[mi][j]), 0)); } while (0)
#define SC_PIPE() do { _Pragma("unroll") for (int _q = 0; _q < 16; ++_q) { __builtin_amdgcn_sched_group_barrier(0x8, 1, 0); __builtin_amdgcn_sched_group_barrier(0x2, 2, 0); } } while (0)
#define SC_STAGE(st, RN, RF) do { \
                SC_LOAD(RF, (st) + 2); \
                if (active) { const int _hg = (st) & 15; const LAS unsigned char* buf = c.lds + ((st) & 1) * STAGE + (tile * 4 * 16 + fr) * QPB + fq * 16; \
                    const f32x4 wv = *(const LAS f32x4*)(wb + _hg * 16); \
                    f32x4 a0[4], a1[4]; \
                    SC_MM(a0, 0); \
                    SC_MM(a1, 1); SC_EPI(a0, 0); SC_PIPE(); \
                    SC_MM(a0, 2); SC_EPI(a1, 1); SC_PIPE(); \
                    SC_MM(a1, 3); SC_EPI(a0, 2); SC_PIPE(); \
                    SC_EPI(a1, 3); } \
                SC_STORE(RN, (st) + 1); \
                LDS_WAIT(); __syncthreads(); } while (0)
            for (int hg = 0; hg < 16; hg += 2) { const int st = r * 16 + hg; SC_STAGE(st, r1, r0); SC_STAGE(st + 1, r0, r1); }
            if (active) {
#pragma unroll
                for (int mi = 0; mi < 4; ++mi) *(f32x4*)(SC + (size_t)(tq0 + fr) * SEQ + kc * 64 + 16 * mi + 4 * fq) = sc[mi]; }
        }
#undef SC_STAGE
#undef SC_MM
#undef SC_EPI
#undef SC_PIPE
#undef SC_LOAD
#undef SC_STORE
    }
}

__device__ __forceinline__ void ph_topk(const Params& p, const Ctx& c) {
    const float* SC = (const float*)(p.ws + WS_SC); int* SEL = (int*)(p.ws + WS_SEL); int* CNT = (int*)(p.ws + WS_CNT);
    const int lane = c.lane; const unsigned long long lt_mask = (1ull << lane) - 1ull;
    for (int t = c.gw; t < T; t += c.ngw) {
        const int pos = t % SEQ, qc = pos / CHUNK, nadm = (qc + 1) * CHUNK;
        int* so = SEL + (size_t)t * TOPK;
        if (nadm <= TOPK) { for (int i = lane; i < nadm; i += 64) so[i] = i; if (lane == 0) CNT[t] = nadm; continue; }
        unsigned key[32];
        const float* sr = SC + (size_t)t * SEQ;
#pragma unroll
        for (int j = 0; j < 32; ++j) { unsigned k = 0u; if (j <= qc) { const unsigned bits = __float_as_uint(sr[lane + 64 * j]); k = (bits & 0x80000000u) ? ~bits : (bits | 0x80000000u); } key[j] = k; }
        unsigned thr = 0u;
        for (int bit = 31; bit >= 0; --bit) { const unsigned cand = thr | (1u << bit); int cnt = 0;
#pragma unroll
            for (int j = 0; j < 32; ++j) cnt += __popcll(__ballot(key[j] >= cand));
            if (cnt >= TOPK) { thr = cand; if (cnt == TOPK) break; } }
        int ngt = 0;
#pragma unroll
        for (int j = 0; j < 32; ++j) ngt += __popcll(__ballot(key[j] > thr));
        const int need = TOPK - ngt; int base = 0, eqt = 0;
#pragma unroll
        for (int j = 0; j < 32; ++j) {
            const unsigned long long mg = __ballot(key[j] > thr), me = __ballot(key[j] == thr);
            const int erank = __popcll(me & lt_mask) + eqt; const bool esel = (key[j] == thr) && (erank < need);
            const unsigned long long ms = mg | __ballot(esel);
            if ((ms >> lane) & 1ull) so[base + __popcll(ms & lt_mask)] = lane + 64 * j;
            base += __popcll(ms); eqt += __popcll(me);
        }
        if (lane == 0) CNT[t] = TOPK;
    }
}

__device__ __forceinline__ int t5_bucket(int rel) {
    const int n = rel < 0 ? -rel : rel; int bk;
    if (n < 8) bk = n; else { const int n2 = n * n; int k = 0;
#pragma unroll
        for (int j = 1; j <= 7; ++j) k += (n2 >= (64 << j)) ? 1 : 0;
        bk = 8 + k; }
    return (rel > 0 ? 16 : 0) + bk;
}
__device__ __forceinline__ bf16x4 tr_read4(unsigned addr, int) { bf16x4 r; asm volatile("ds_read_b64_tr_b16 %0, %1\n\ts_waitcnt lgkmcnt(0)" : "=&v"(r) : "v"(addr) : "memory"); return r; }
#define TR_READ(dst, addr, OFF) asm volatile("ds_read_b64_tr_b16 %0, %1 offset:%2" : "=&v"(dst) : "v"(addr), "i"(OFF) : "memory")

constexpr int KV_PITCH = 1056;
constexpr int ATT_LDS_END = 8 * 16 * KV_PITCH + 64 + 2048;
__device__ __forceinline__ void ph_attn(const Params& p, const Ctx& c) {
    const bf16* CKV = (const bf16*)(p.ws + WS_CKV); const bf16* QL = (const bf16*)(p.ws + WS_QL); const int* SEL = (const int*)(p.ws + WS_SEL); const int* CNT = (const int*)(p.ws + WS_CNT);
    bf16* OL = (bf16*)(p.ws + WS_OLAT);
    const int lane = c.lane, fr = lane & 15, fq = lane >> 4;
    const int cw = c.wave & 3;
    LAS unsigned char* buf0 = c.lds + cw * (32 * KV_PITCH);
    const unsigned bufa = (unsigned)(size_t)buf0;
    const unsigned tr_base0 = bufa + (unsigned)((4 * fq + (fr >> 2)) * KV_PITCH + (fr & 3) * 8);
    const float t5b_scale = 0.08838834764831845f;
    LAS float* t5l = (LAS float*)(c.lds + 8 * 16 * KV_PITCH + 64);
    unsigned* ctl = (unsigned*)(p.ws + WS_CTL);
    LAS unsigned* xm = (LAS unsigned*)(c.lds + 8 * 16 * KV_PITCH);
    if (c.tid == 0) { const unsigned x = xb_xcc_id(); unsigned pre = 0, tot = 0;
        for (unsigned j = 0; j < 16; ++j) { const unsigned n = xb_ld(&ctl[XB_XCNT(j)]); pre += (j < x) ? n : 0u; tot += n; }
        const bool ok = (tot == (unsigned)c.nb) && (T % (c.nb * 4) == 0);
        unsigned rk = 0; if (ok) rk = xb_add(&ctl[XB_ATT_RANK + 64 * x], 1u);
        xm[0] = ok ? (pre + rk) : 0xffffffffu; }
    t5l[c.tid] = p.t5[c.tid];
    __syncthreads();
    const unsigned vbx = xm[0]; const bool xmap = (vbx != 0xffffffffu);
    const int naw = c.nb * 4;
    if (c.wave >= 4) { for (int it = c.bid * 4 + (c.wave - 4); it < 1024; it += naw) adaln_late(p, it, c.lane); convert_late_weights(p, (LAS float*)(c.lds + ATT_LDS_END + (c.wave - 4) * 4224), c.lane, c.bid * 4 + (c.wave - 4), naw); convert_expert_rows(p, c, c.bid * 4 + (c.wave - 4), naw); }
    if (c.wave < 4)
    for (int it = c.bid * 4 + cw; it < T; it += naw) {
        int t = it;
        if (xmap) { const int base = (int)vbx * 4 + cw;
            const int bsz = naw / NB, q = it / naw;
            t = (base / bsz) * SEQ + (base % bsz) + q * bsz; }
        const int b = t / SEQ, pos = t % SEQ;
        const int cnt = CNT[t];
        int s0 = 0, s1 = 0, s2 = 0, s3 = 0;
        if (lane < cnt) s0 = SEL[(size_t)t * TOPK + lane];
        if (lane + 64 < cnt) s1 = SEL[(size_t)t * TOPK + 64 + lane];
        if (lane + 128 < cnt) s2 = SEL[(size_t)t * TOPK + 128 + lane];
        if (lane + 192 < cnt) s3 = SEL[(size_t)t * TOPK + 192 + lane];
        const bf16* kvb = CKV + (size_t)(b * SEQ) * A_KVR + lane * 8;
        const int nch = cnt >> 4;
#define ATT_GATHER(ch_) do { const int _c = (ch_); const int _sj = (_c < 4) ? s0 : (_c < 8) ? s1 : (_c < 12) ? s2 : s3; const int _lb = (_c & 3) * 16; \
            LAS unsigned char* _b = buf0 + (_c & 1) * (16 * KV_PITCH); \
            _Pragma("unroll") for (int r = 0; r < 16; ++r) { const int idx = __builtin_amdgcn_readlane(_sj, _lb + r); \
                __builtin_amdgcn_global_load_lds((const unsigned*)(kvb + (size_t)idx * A_KVR), (LAS unsigned*)(_b + r * KV_PITCH), 16, 0, 0); } } while (0)
        ATT_GATHER(0);
        bf16x8 qf[16];
#pragma unroll
        for (int ks = 0; ks < 16; ++ks) qf[ks] = *(const bf16x8*)(QL + (size_t)t * 8192 + fr * 512 + ks * 32 + fq * 8);
        f32x4 acc[32];
#pragma unroll
        for (int mt = 0; mt < 32; ++mt) acc[mt] = (f32x4){0.f, 0.f, 0.f, 0.f};
        float m_run = -INFINITY, l_run = 0.f;
        float bias[4];
#define ATT_BIAS(ch_) do { const int _c = (ch_); const int _sj = (_c < 4) ? s0 : (_c < 8) ? s1 : (_c < 12) ? s2 : s3; const int _lb = (_c & 3) * 16; \
            _Pragma("unroll") for (int j = 0; j < 4; ++j) { const int kidx = __shfl(_sj, _lb + 4 * fq + j); bias[j] = t5l[t5_bucket(kidx - pos) * A_HEADS + fr]; } } while (0)
        for (int ch = 0; ch < nch; ++ch) {
            ATT_BIAS(ch);
            if (ch + 1 < nch) { ATT_GATHER(ch + 1); asm volatile("s_waitcnt vmcnt(16)" ::: "memory"); } else { asm volatile("s_waitcnt vmcnt(0)" ::: "memory"); }
            LAS unsigned char* buf = buf0 + (ch & 1) * (16 * KV_PITCH);
            const unsigned tr_base = tr_base0 + (unsigned)((ch & 1) * (16 * KV_PITCH));
            f32x4 sa = {0.f, 0.f, 0.f, 0.f}, sb = sa;
#pragma unroll
            for (int ks = 0; ks < 16; ks += 2) {
                const bf16x8 a0 = *(const LAS bf16x8*)(buf + fr * KV_PITCH + (ks + 0) * 64 + fq * 16), a1 = *(const LAS bf16x8*)(buf + fr * KV_PITCH + (ks + 1) * 64 + fq * 16);
                sa = __builtin_amdgcn_mfma_f32_16x16x32_bf16(a0, qf[ks + 0], sa, 0, 0, 0); sb = __builtin_amdgcn_mfma_f32_16x16x32_bf16(a1, qf[ks + 1], sb, 0, 0, 0); }
            const f32x4 s = sa + sb;
            float lg[4]; float mc = -INFINITY;
#pragma unroll
            for (int j = 0; j < 4; ++j) { lg[j] = s[j] * t5b_scale + bias[j]; mc = fmaxf(mc, lg[j]); }
            mc = fmaxf(mc, __shfl_xor(mc, 16)); mc = fmaxf(mc, __shfl_xor(mc, 32));
            if (__ballot(mc > m_run + 8.0f)) { const float m_new = fmaxf(m_run, mc); const float alpha = __expf(m_run - m_new); l_run *= alpha; m_run = m_new;
#pragma unroll
                for (int mt = 0; mt < 32; ++mt) acc[mt] *= alpha; }
            float pe[4]; float ps = 0.f;
#pragma unroll
            for (int j = 0; j < 4; ++j) { pe[j] = __expf(lg[j] - m_run); ps += pe[j]; }
            l_run += ps;
            v2u pw; pw.x = cvt_pk_bf16(pe[0], pe[1]); pw.y = cvt_pk_bf16(pe[2], pe[3]);
            const unsigned qx = (unsigned)__shfl_xor((int)pw.x, 32), qy = (unsigned)__shfl_xor((int)pw.y, 32);
            const bool lowg = fq < 2;
            const v4u pb4 = lowg ? (v4u){pw.x, pw.y, qx, qy} : (v4u){0u, 0u, 0u, 0u};
            const bf16x8 pb = __builtin_bit_cast(bf16x8, pb4);
            const unsigned tr2 = tr_base + (unsigned)((lowg ? 8 : -8) * KV_PITCH);
            bf16x4 ta[2], tb[2], ua[2], ub[2];
#define ATT_TR(d1, d2, g) do { _Pragma("unroll") for (int i = 0; i < 2; ++i) { TR_READ(d1[i], tr_base, ((g) * 2 + i) * 32); TR_READ(d2[i], tr2, ((g) * 2 + i) * 32); } } while (0)
#define ATT_MM(s1, s2, g) do { _Pragma("unroll") for (int i = 0; i < 2; ++i) acc[(g) * 2 + i] = __builtin_amdgcn_mfma_f32_16x16x32_bf16(__builtin_shufflevector(s1[i], s2[i], 0, 1, 2, 3, 4, 5, 6, 7), pb, acc[(g) * 2 + i], 0, 0, 0); } while (0)
            ATT_TR(ta, ua, 0);
#pragma unroll
            for (int g = 0; g < 16; g += 2) {
                ATT_TR(tb, ub, g + 1);
                asm volatile("s_waitcnt lgkmcnt(4)" : "+v"(ta[0]), "+v"(ta[1]), "+v"(ua[0]), "+v"(ua[1]) :: "memory");
                ATT_MM(ta, ua, g);
                if (g + 2 < 16) ATT_TR(ta, ua, g + 2);
                if (g + 2 < 16) asm volatile("s_waitcnt lgkmcnt(4)" : "+v"(tb[0]), "+v"(tb[1]), "+v"(ub[0]), "+v"(ub[1]) :: "memory");
                else asm volatile("s_waitcnt lgkmcnt(0)" : "+v"(tb[0]), "+v"(tb[1]), "+v"(ub[0]), "+v"(ub[1]) :: "memory");
                ATT_MM(tb, ub, g + 1);
            }
#undef ATT_TR
#undef ATT_MM
            asm volatile("" ::: "memory");
        }
#undef ATT_BIAS
#undef ATT_GATHER
        float lt = l_run; lt += __shfl_xor(lt, 16); lt += __shfl_xor(lt, 32);
        const float il = 1.0f / lt;
        bf16* orow = OL + (size_t)t * 8192 + fr * 512 + 4 * fq;
#pragma unroll
        for (int mt = 0; mt < 32; ++mt) { v2u w; w.x = cvt_pk_bf16(acc[mt][0] * il, acc[mt][1] * il); w.y = cvt_pk_bf16(acc[mt][2] * il, acc[mt][3] * il); *(v2u*)(orow + 16 * mt) = w; }
    }
    __syncthreads();
}

#define TR_PAIR(dst, addr, PITCH4) do { bf16x4 _lo, _hi; \
    asm volatile("ds_read_b64_tr_b16 %0, %2\n\tds_read_b64_tr_b16 %1, %2 offset:%3\n\ts_waitcnt lgkmcnt(0)" : "=&v"(_lo), "=&v"(_hi) : "v"(addr), "i"(PITCH4) : "memory"); \
    dst = __builtin_shufflevector(_lo, _hi, 0, 1, 2, 3, 4, 5, 6, 7); } while (0)

constexpr size_t WS_SN = 1464 * MiB;
__device__ __forceinline__ void ph_ret_state(const Params& p, const Ctx& c) {
    const bf16* P1 = (const bf16*)(p.ws + WS_P1); bf16* SN = (bf16*)(p.ws + WS_SN);
    constexpr int KPB = 272, VPB = 80;
    LAS unsigned char* ktb = c.lds; LAS unsigned char* vtb = c.lds + 2 * 64 * KPB;
    const int tid = c.tid, lane = c.lane, w = c.wave, fr = lane & 15, fq = lane >> 4;
    for (int u = c.bid; u < NB * R_HEADS * 8; u += c.nb) {
        const int b = u / 64, h = (u / 8) % 8, vsl = u % 8;
        const float gam = 1.0f - exp2f(-5.0f - (float)h), lgm = logf(gam), dec64 = __expf(64.0f * lgm);
        f32x4 acc[2] = {{0.f, 0.f, 0.f, 0.f}, {0.f, 0.f, 0.f, 0.f}};
        const int kr0 = tid >> 4, kc0 = tid & 15;
        const int vr = tid >> 2, vc = tid & 3;
        const bf16* kbase = P1 + (size_t)(b * SEQ) * N1 + C_RK + h * 128 + kc0 * 8;
        const bf16* vbase = P1 + (size_t)(b * SEQ) * N1 + C_RV + h * 256 + vsl * 32 + vc * 8;
        const float sc0 = __expf((float)(63 - kr0) * lgm), sc1 = __expf((float)(31 - kr0) * lgm);
        v4u ka, kb, va = {0u, 0u, 0u, 0u};
        ka = *(const v4u*)(kbase + (size_t)kr0 * N1); kb = *(const v4u*)(kbase + (size_t)(kr0 + 32) * N1); if (tid < 256) va = *(const v4u*)(vbase + (size_t)vr * N1);
        __syncthreads();
        for (int n = 0; n < SEQ / CHUNK; ++n) {
            LAS unsigned char* kt = ktb + (n & 1) * 64 * KPB; LAS unsigned char* vt = vtb + (n & 1) * 64 * VPB;
            { v4u o; o.x = cvt_pk_bf16(bflo(ka.x) * sc0, bfhi(ka.x) * sc0); o.y = cvt_pk_bf16(bflo(ka.y) * sc0, bfhi(ka.y) * sc0); o.z = cvt_pk_bf16(bflo(ka.z) * sc0, bfhi(ka.z) * sc0); o.w = cvt_pk_bf16(bflo(ka.w) * sc0, bfhi(ka.w) * sc0);
              *(LAS v4u*)(kt + kr0 * KPB + kc0 * 16) = o;
              o.x = cvt_pk_bf16(bflo(kb.x) * sc1, bfhi(kb.x) * sc1); o.y = cvt_pk_bf16(bflo(kb.y) * sc1, bfhi(kb.y) * sc1); o.z = cvt_pk_bf16(bflo(kb.z) * sc1, bfhi(kb.z) * sc1); o.w = cvt_pk_bf16(bflo(kb.w) * sc1, bfhi(kb.w) * sc1);
              *(LAS v4u*)(kt + (kr0 + 32) * KPB + kc0 * 16) = o;
              if (tid < 256) *(LAS v4u*)(vt + vr * VPB + vc * 16) = va; }
            if (n + 1 < SEQ / CHUNK) { const size_t ro = (size_t)((n + 1) * CHUNK) * N1;
                ka = *(const v4u*)(kbase + ro + (size_t)kr0 * N1); kb = *(const v4u*)(kbase + ro + (size_t)(kr0 + 32) * N1); if (tid < 256) va = *(const v4u*)(vbase + ro + (size_t)vr * N1); }
            { bf16* sp = SN + ((size_t)((b * R_HEADS + h) * 32 + n) * 256 + vsl * 32 + fr) * 128 + 16 * w + 4 * fq;
#pragma unroll
              for (int nt = 0; nt < 2; ++nt) { v2u o; o.x = cvt_pk_bf16(acc[nt][0], acc[nt][1]); o.y = cvt_pk_bf16(acc[nt][2], acc[nt][3]); *(v2u*)(sp + (size_t)(16 * nt) * 128) = o; acc[nt] *= dec64; } }
            LDS_WAIT(); __syncthreads();
            const unsigned ka_addr = (unsigned)(size_t)kt + (unsigned)((8 * fq + (fr >> 2)) * KPB + (16 * w + 4 * (fr & 3)) * 2);
            const unsigned va_addr = (unsigned)(size_t)vt + (unsigned)((8 * fq + (fr >> 2)) * VPB + (4 * (fr & 3)) * 2);
#pragma unroll
            for (int ks = 0; ks < 2; ++ks) { bf16x8 af, b0, b1;
                TR_PAIR(af, ka_addr + ks * 32 * KPB, 4 * KPB); TR_PAIR(b0, va_addr + ks * 32 * VPB, 4 * VPB); TR_PAIR(b1, va_addr + ks * 32 * VPB + 32, 4 * VPB);
                acc[0] = __builtin_amdgcn_mfma_f32_16x16x32_bf16(af, b0, acc[0], 0, 0, 0); acc[1] = __builtin_amdgcn_mfma_f32_16x16x32_bf16(af, b1, acc[1], 0, 0, 0); }
        }
        __syncthreads();
    }
}
__device__ __forceinline__ void ph_ret_out(const Params& p, const Ctx& c) {
    const bf16* P1 = (const bf16*)(p.ws + WS_P1); const bf16* SN = (const bf16*)(p.ws + WS_SN); unsigned char* Y8 = p.ws + WS_YCAT;
    constexpr int QPB = 272, VPB = 528, APB = 144;
    LAS unsigned char* qt = c.lds; LAS unsigned char* kt = qt + 64 * QPB; LAS unsigned char* vt = kt + 64 * QPB; LAS unsigned char* at = vt + 64 * VPB;
    LAS float* red = (LAS float*)(at + 64 * APB);
    const int tid = c.tid, lane = c.lane, w = c.wave, fr = lane & 15, fq = lane >> 4;
    for (int u = c.bid; u < NB * 32 * R_HEADS; u += c.nb) {
        const int b = u / 256, n = (u / 8) % 32, h = u % 8;
        const float gam = 1.0f - exp2f(-5.0f - (float)h), lgm = logf(gam);
        const size_t t0 = (size_t)b * SEQ + n * CHUNK;
        __syncthreads();
        for (int i = tid; i < 64 * 16; i += NTHR) { const int l = i >> 4, ch = i & 15;
            *(LAS v4u*)(qt + l * QPB + ch * 16) = *(const v4u*)(P1 + (t0 + l) * N1 + C_RQ + h * 128 + ch * 8);
            *(LAS v4u*)(kt + l * QPB + ch * 16) = *(const v4u*)(P1 + (t0 + l) * N1 + C_RK + h * 128 + ch * 8); }
        for (int i = tid; i < 64 * 32; i += NTHR) { const int l = i >> 5, ch = i & 31; *(LAS v4u*)(vt + l * VPB + ch * 16) = *(const v4u*)(P1 + (t0 + l) * N1 + C_RV + h * 256 + ch * 8); }
        __syncthreads();
        { const int pt = w & 3, lt0 = 2 * (w >> 2);
          f32x4 a0 = {0.f, 0.f, 0.f, 0.f}, a1 = a0;
#pragma unroll
          for (int ks = 0; ks < 4; ++ks) { const bf16x8 qf = *(const LAS bf16x8*)(qt + (16 * pt + fr) * QPB + ks * 64 + fq * 16);
              const bf16x8 k0 = *(const LAS bf16x8*)(kt + (16 * lt0 + fr) * QPB + ks * 64 + fq * 16), k1 = *(const LAS bf16x8*)(kt + (16 * lt0 + 16 + fr) * QPB + ks * 64 + fq * 16);
              a0 = __builtin_amdgcn_mfma_f32_16x16x32_bf16(k0, qf, a0, 0, 0, 0); a1 = __builtin_amdgcn_mfma_f32_16x16x32_bf16(k1, qf, a1, 0, 0, 0); }
          const int pos = 16 * pt + fr;
#pragma unroll
          for (int j = 0; j < 4; ++j) { const int l0 = 16 * lt0 + 4 * fq + j, l1 = l0 + 16;
              a0[j] = (pos >= l0) ? a0[j] * __expf((float)(pos - l0) * lgm) : 0.f; a1[j] = (pos >= l1) ? a1[j] * __expf((float)(pos - l1) * lgm) : 0.f; }
          v2u o; o.x = cvt_pk_bf16(a0[0], a0[1]); o.y = cvt_pk_bf16(a0[2], a0[3]); *(LAS v2u*)(at + pos * APB + (16 * lt0 + 4 * fq) * 2) = o;
          o.x = cvt_pk_bf16(a1[0], a1[1]); o.y = cvt_pk_bf16(a1[2], a1[3]); *(LAS v2u*)(at + pos * APB + (16 * lt0 + 16 + 4 * fq) * 2) = o; }
        f32x4 acc[2][4];
#pragma unroll
        for (int mi = 0; mi < 2; ++mi)
#pragma unroll
            for (int pt = 0; pt < 4; ++pt) acc[mi][pt] = (f32x4){0.f, 0.f, 0.f, 0.f};
        { const bf16* sp = SN + ((size_t)((b * R_HEADS + h) * 32 + n) * 256 + 32 * w + fr) * 128 + 8 * fq;
#pragma unroll
          for (int ks = 0; ks < 4; ++ks) { const bf16x8 s0 = *(const bf16x8*)(sp + ks * 32), s1 = *(const bf16x8*)(sp + 16 * 128 + ks * 32);
#pragma unroll
              for (int pt = 0; pt < 4; ++pt) { const bf16x8 qf = *(const LAS bf16x8*)(qt + (16 * pt + fr) * QPB + ks * 64 + fq * 16);
                  acc[0][pt] = __builtin_amdgcn_mfma_f32_16x16x32_bf16(s0, qf, acc[0][pt], 0, 0, 0); acc[1][pt] = __builtin_amdgcn_mfma_f32_16x16x32_bf16(s1, qf, acc[1][pt], 0, 0, 0); } } }
#pragma unroll
        for (int pt = 0; pt < 4; ++pt) { const float dq = __expf((float)(16 * pt + fr + 1) * lgm); acc[0][pt] *= dq; acc[1][pt] *= dq; }
        LDS_WAIT(); __syncthreads();
        { const unsigned v_addr = (unsigned)(size_t)vt + (unsigned)((8 * fq + (fr >> 2)) * VPB + (32 * w + 4 * (fr & 3)) * 2);
#pragma unroll
          for (int ks = 0; ks < 2; ++ks) { bf16x8 v0, v1; TR_PAIR(v0, v_addr + ks * 32 * VPB, 4 * VPB); TR_PAIR(v1, v_addr + ks * 32 * VPB + 32, 4 * VPB);
#pragma unroll
              for (int pt = 0; pt < 4; ++pt) { const bf16x8 af = *(const LAS bf16x8*)(at + (16 * pt + fr) * APB + ks * 64 + fq * 16);
                  acc[0][pt] = __builtin_amdgcn_mfma_f32_16x16x32_bf16(v0, af, acc[0][pt], 0, 0, 0); acc[1][pt] = __builtin_amdgcn_mfma_f32_16x16x32_bf16(v1, af, acc[1][pt], 0, 0, 0); } } }
#pragma unroll
        for (int pt = 0; pt < 4; ++pt) { float s = 0.f;
#pragma unroll
            for (int mi = 0; mi < 2; ++mi)
#pragma unroll
                for (int j = 0; j < 4; ++j) s += acc[mi][pt][j] * acc[mi][pt][j];
            s += __shfl_xor(s, 16); s += __shfl_xor(s, 32);
            if (lane < 16) red[w * 64 + 16 * pt + lane] = s; }
        LDS_WAIT(); __syncthreads();
#pragma unroll
        for (int pt = 0; pt < 4; ++pt) { const int pos = 16 * pt + fr; float ss = 0.f;
#pragma unroll
            for (int ww = 0; ww < 8; ++ww) ss += red[ww * 64 + pos];
            const float rstd = 1.0f / sqrtf(ss * (1.0f / R_V) + EPS);
#pragma unroll
            for (int mi = 0; mi < 2; ++mi) { const int dv = 32 * w + 16 * mi + 4 * fq;
                const f32x4 g = *(const f32x4*)(p.g_ret + h * 256 + dv);
                const v2u rg = *(const v2u*)(P1 + (t0 + pos) * N1 + C_RG + h * 256 + dv);
                const float r0 = bflo(rg.x), r1 = bfhi(rg.x), r2 = bflo(rg.y), r3 = bfhi(rg.y);
                const float rs = rstd * 16.0f; int q = 0;
                q = PK_FP8(r0 * sigmoidf_(r0) * acc[mi][pt][0] * rs * g.x, r1 * sigmoidf_(r1) * acc[mi][pt][1] * rs * g.y, q, false);
                q = PK_FP8(r2 * sigmoidf_(r2) * acc[mi][pt][2] * rs * g.z, r3 * sigmoidf_(r3) * acc[mi][pt][3] * rs * g.w, q, true);
                *(unsigned*)(Y8 + (t0 + pos) * D + A_WIDTH + h * 256 + dv) = (unsigned)q; } }
    }
    __syncthreads();
}

__device__ __forceinline__ unsigned fkey(float f) { const unsigned b = __float_as_uint(f); return (b & 0x80000000u) ? ~b : (b | 0x80000000u); }
typedef __bf16 bf16x2_r __attribute__((ext_vector_type(2)));
template <int NV> __device__ __forceinline__ unsigned tok_thr16(const unsigned (&k)[NV]) {
    unsigned thr = 0u; bool done = false;
    for (int bit = 31; bit >= 0; --bit) { const unsigned cand = thr | (1u << bit); int cnt = 0;
#pragma unroll
        for (int i = 0; i < NV; ++i) cnt += (k[i] >= cand) ? 1 : 0;
        cnt += __shfl_xor(cnt, 16); cnt += __shfl_xor(cnt, 32);
        if (!done && cnt >= P_TOPK) { thr = cand; done = (cnt == P_TOPK); }
        if (!__ballot(!done)) break; }
    return thr;
}
__device__ __forceinline__ void ph_peer_route(const Params& p, const Ctx& c) {
    const bf16* PQ = (const bf16*)(p.ws + WS_PQ); const bf16* SK = (const bf16*)(p.ws + WS_SK); int* EID = (int*)(p.ws + WS_EID); float* GATE = (float*)(p.ws + WS_GATE);
    constexpr int KP = 272;
    LAS unsigned char* sk = c.lds;
    LAS float* wl = (LAS float*)(c.lds + 2 * 128 * KP) + c.wave * 1536;
    LAS float* v1l = wl; LAS int* i1l = (LAS int*)(wl + 256); LAS float* v2l = wl + 512; LAS int* i2l = (LAS int*)(wl + 768); LAS float* tvl = wl + 1024; LAS int* tel = (LAS int*)(wl + 1280);
    const int lane = c.lane, fr = lane & 15, fq = lane >> 4;
    __syncthreads();
    for (int i = c.tid; i < 2 * 128 * 16; i += NTHR) { const int r = i >> 4, ch = i & 15; *(LAS v4u*)(sk + r * KP + ch * 16) = *(const v4u*)(SK + r * 128 + ch * 8); }
    __syncthreads();
    for (int u = c.gw; u < (T / 16) * P_HEADS; u += c.ngw) {
        const int tgp = u / P_HEADS, h = u % P_HEADS, t = tgp * 16 + fr;
        unsigned ka[32], kb[32]; float sva[32], svb[32];
#pragma unroll
        for (int half = 0; half < 2; ++half) {
            f32x4 acc[8];
#pragma unroll
            for (int mt = 0; mt < 8; ++mt) acc[mt] = (f32x4){0.f, 0.f, 0.f, 0.f};
#pragma unroll
            for (int ks = 0; ks < 4; ++ks) { const bf16x8 qf = *(const bf16x8*)(PQ + (size_t)t * 2048 + h * 256 + half * 128 + ks * 32 + fq * 8);
#pragma unroll
                for (int mt = 0; mt < 8; ++mt) { const bf16x8 kf = *(const LAS bf16x8*)(sk + (half * 128 + 16 * mt + fr) * KP + ks * 64 + fq * 16); acc[mt] = __builtin_amdgcn_mfma_f32_16x16x32_bf16(kf, qf, acc[mt], 0, 0, 0); } }
#pragma unroll
            for (int mt = 0; mt < 8; ++mt)
#pragma unroll
                for (int j = 0; j < 4; ++j) { if (half == 0) { sva[mt * 4 + j] = acc[mt][j]; ka[mt * 4 + j] = fkey(acc[mt][j]); } else { svb[mt * 4 + j] = acc[mt][j]; kb[mt * 4 + j] = fkey(acc[mt][j]); } }
        }
#define ROUTE_EMIT(K, V, NV, thr, VL, IL, IDX) do { int ngl = 0, nel = 0; \
            _Pragma("unroll") for (int i = 0; i < NV; ++i) { ngl += (K[i] > thr) ? 1 : 0; nel += (K[i] == thr) ? 1 : 0; } \
            int pg = 0, pe = 0, ngt = 0; \
            _Pragma("unroll") for (int q = 0; q < 4; ++q) { const int cg = __shfl(ngl, fr + 16 * q), ce = __shfl(nel, fr + 16 * q); pg += (q < fq) ? cg : 0; pe += (q < fq) ? ce : 0; ngt += cg; } \
            const int need = P_TOPK - ngt; \
            _Pragma("unroll") for (int i = 0; i < NV; ++i) { int slot = -1; \
                if (K[i] > thr) { slot = pg; ++pg; } else if (K[i] == thr) { if (pe < need) slot = ngt + pe; ++pe; } \
                if (slot >= 0) { VL[fr * 16 + slot] = V[i]; IL[fr * 16 + slot] = IDX(i); } } } while (0)
#define KEYIDX(i) (16 * ((i) >> 2) + 4 * fq + ((i) & 3))
        { const unsigned ta = tok_thr16<32>(ka); ROUTE_EMIT(ka, sva, 32, ta, v1l, i1l, KEYIDX);
          const unsigned tb = tok_thr16<32>(kb); ROUTE_EMIT(kb, svb, 32, tb, v2l, i2l, KEYIDX); }
        LDS_WAIT();
        float cd[64]; unsigned ck[64];
        { const f32x4 va = *(const LAS f32x4*)(v1l + fr * 16 + 4 * fq);
#pragma unroll
          for (int bq = 0; bq < 4; ++bq) { const f32x4 vb = *(const LAS f32x4*)(v2l + fr * 16 + 4 * bq);
#pragma unroll
              for (int ai = 0; ai < 4; ++ai)
#pragma unroll
                  for (int bj = 0; bj < 4; ++bj) { const float v = va[ai] + vb[bj]; cd[ai * 16 + bq * 4 + bj] = v; ck[ai * 16 + bq * 4 + bj] = fkey(v); } } }
#define CANDEID(i) (i1l[fr * 16 + 4 * fq + ((i) >> 4)] * P_NK + i2l[fr * 16 + ((i) & 15)])
        { const unsigned tc = tok_thr16<64>(ck); ROUTE_EMIT(ck, cd, 64, tc, tvl, tel, CANDEID); }
#undef ROUTE_EMIT
#undef KEYIDX
#undef CANDEID
        LDS_WAIT();
        { const f32x4 tv = *(const LAS f32x4*)(tvl + fr * 16 + 4 * fq); const v4u te = *(const LAS v4u*)(tel + fr * 16 + 4 * fq);
          float mx = fmaxf(fmaxf(tv[0], tv[1]), fmaxf(tv[2], tv[3])); mx = fmaxf(mx, __shfl_xor(mx, 16)); mx = fmaxf(mx, __shfl_xor(mx, 32));
          f32x4 e; float sm = 0.f;
#pragma unroll
          for (int j = 0; j < 4; ++j) { e[j] = __expf(tv[j] - mx); sm += e[j]; }
          sm += __shfl_xor(sm, 16); sm += __shfl_xor(sm, 32);
          const float inv = 1.0f / sm;
          *(v4u*)(EID + (size_t)t * 128 + h * 16 + 4 * fq) = te; *(f32x4*)(GATE + (size_t)t * 128 + h * 16 + 4 * fq) = e * inv; }
        LDS_WAIT();
    }
    __syncthreads();
}
typedef __bf16 bf16x2_t __attribute__((ext_vector_type(2)));
typedef float v32f_t __attribute__((ext_vector_type(32))); typedef unsigned v6u_t __attribute__((ext_vector_type(6))); typedef __bf16 v32bf_t __attribute__((ext_vector_type(32)));
typedef unsigned v16u_t __attribute__((ext_vector_type(16)));
__device__ __forceinline__ void ld48(const unsigned char* ptr, v6u_t& w0, v6u_t& w1) { const v4u a = *(const v4u*)ptr, b = *(const v4u*)(ptr + 1024), c = *(const v4u*)(ptr + 2048);
    w0 = (v6u_t){a.x, a.y, a.z, a.w, b.x, b.y}; w1 = (v6u_t){b.z, b.w, c.x, c.y, c.z, c.w}; }
#ifndef PG
#define PG 2
#endif
__device__ __forceinline__ void ph_peer_experts(const Params& p, const Ctx& c) {
    const bf16* H = (const bf16*)(p.ws + WS_H); const unsigned char* U8 = p.ws + WS_U8; const unsigned char* V8 = p.ws + WS_V8;
    const float* SU = (const float*)(p.ws + WS_SU); const float* SV = (const float*)(p.ws + WS_SV);
    const int* EID = (const int*)(p.ws + WS_EID); const float* GATE = (const float*)(p.ws + WS_GATE); const float* mod = (const float*)(p.ws + WS_MOD);
    const int lane = c.lane;
    for (int t = c.gw; t < T; t += c.ngw) {
        const int b = t / SEQ;
        unsigned xp[32];
#pragma unroll
        for (int g = 0; g < 2; ++g)
#pragma unroll
            for (int k = 0; k < 4; ++k) { const v4u a = *(const v4u*)(H + (size_t)t * D + (g * 64 + lane) * 32 + k * 8); xp[g * 16 + k * 4 + 0] = a.x; xp[g * 16 + k * 4 + 1] = a.y; xp[g * 16 + k * 4 + 2] = a.z; xp[g * 16 + k * 4 + 3] = a.w; }
        const int e0 = EID[(size_t)t * 128 + lane], e1 = EID[(size_t)t * 128 + 64 + lane];
        const float g0 = GATE[(size_t)t * 128 + lane], g1 = GATE[(size_t)t * 128 + 64 + lane];
        f32x2 acc[32];
#pragma unroll
        for (int i = 0; i < 32; ++i) acc[i] = (f32x2){0.f, 0.f};
        for (int pg = 0; pg < 32; ++pg) {
            const int esel = (pg < 16) ? e0 : e1; const float gsel = (pg < 16) ? g0 : g1; const int lb = (pg & 15) * 4;
            int e[4]; float cf[4]; v6u_t w[4][2];
#pragma unroll
            for (int j = 0; j < 4; ++j) { e[j] = __builtin_amdgcn_readlane(esel, lb + j); const unsigned char* ur = U8 + (size_t)e[j] * ROW6 + lane * 16;
                ld48(ur, w[j][0], w[j][1]); }
#pragma unroll
            for (int j = 0; j < 4; ++j) { float d = 0.f;
#pragma unroll
                for (int g = 0; g < 2; ++g) { const v16u_t ub = __builtin_bit_cast(v16u_t, __builtin_amdgcn_cvt_scalef32_pk32_bf16_fp6(w[j][g], 1.0f));
#pragma unroll
                    for (int k = 0; k < 16; ++k) asm("v_dot2c_f32_bf16 %0, %1, %2" : "+v"(d) : "v"(ub[k]), "v"(xp[g * 16 + k])); }
                cf[j] = d; }
#pragma unroll
            for (int o = 1; o < 64; o <<= 1) { cf[0] += __shfl_xor(cf[0], o); cf[1] += __shfl_xor(cf[1], o); cf[2] += __shfl_xor(cf[2], o); cf[3] += __shfl_xor(cf[3], o); }
#pragma unroll
            for (int j = 0; j < 4; ++j) { const unsigned char* vr = V8 + (size_t)e[j] * ROW6 + lane * 16;
                ld48(vr, w[j][0], w[j][1]);
                const float d = cf[j] * SU[e[j]]; const float g = __shfl(gsel, lb + j);
                cf[j] = g * 0.5f * d * (1.0f + erff(d * 0.70710678118654752f)) * SV[e[j]]; }
#pragma unroll
            for (int j = 0; j < 4; ++j) { const f32x2 c2 = {cf[j], cf[j]};
#pragma unroll
                for (int g = 0; g < 2; ++g) { const v32f_t vf = __builtin_amdgcn_cvt_scalef32_pk32_f32_fp6(w[j][g], 1.0f);
#pragma unroll
                    for (int k = 0; k < 16; ++k) acc[g * 16 + k] = __builtin_elementwise_fma((f32x2){vf[2 * k], vf[2 * k + 1]}, c2, acc[g * 16 + k]); } }
        }
        int lo32 = lane * 32; asm volatile("" : "+v"(lo32));
        float* orow = p.out + (size_t)t * D; const float* gt = mod + (size_t)b * 6 * D + 5 * D; float ss = 0.f;
#pragma unroll
        for (int g = 0; g < 2; ++g)
#pragma unroll
            for (int k = 0; k < 8; ++k) { const int col = g * 2048 + lo32 + k * 4; const f32x4 xa = *(const f32x4*)(orow + col), ga = *(const f32x4*)(gt + col);
                f32x2& a0 = acc[g * 16 + 2 * k]; f32x2& a1 = acc[g * 16 + 2 * k + 1];
                a0.x = xa.x + ga.x * a0.x; a0.y = xa.y + ga.y * a0.y; a1.x = xa.z + ga.z * a1.x; a1.y = xa.w + ga.w * a1.y;
                ss += (a0.x * a0.x + a0.y * a0.y) + (a1.x * a1.x + a1.y * a1.y); }
        const float rstd = 1.0f / sqrtf(wave_sum(ss) * (1.0f / D) + EPS);
#pragma unroll
        for (int g = 0; g < 2; ++g)
#pragma unroll
            for (int k = 0; k < 8; ++k) { const int col = g * 2048 + lo32 + k * 4; const f32x4 ga = *(const f32x4*)(p.g_final + col); const f32x2 a0 = acc[g * 16 + 2 * k], a1 = acc[g * 16 + 2 * k + 1];
                *(f32x4*)(orow + col) = (f32x4){a0.x * rstd * ga.x, a0.y * rstd * ga.y, a1.x * rstd * ga.z, a1.y * rstd * ga.w}; }
    }
}

constexpr int N_PHASES = 19;
__global__ void __launch_bounds__(NTHR, 2) fwd_kernel(Params p) {
    extern __shared__ __attribute__((aligned(16))) unsigned char lds_raw[];
    Ctx c; c.lds = (LAS unsigned char*)lds_raw; c.tid = threadIdx.x; c.lane = c.tid & 63; c.wave = __builtin_amdgcn_readfirstlane(c.tid >> 6);
    c.bid = blockIdx.x; c.nb = gridDim.x; c.gw = c.bid * NWAVES + c.wave; c.ngw = c.nb * NWAVES;
    volatile LAS unsigned* MISC = (volatile LAS unsigned*)(c.lds + MISC_OFF);
    if (c.tid < 64) MISC[c.tid] = 0u;
    __syncthreads();
    const int lo = p.ph_lo, hi = p.ph_hi;
    XcdBarrier bar; bar.bar = (unsigned*)(p.ws + WS_CTL); bar.x = 0; bar.st = nullptr;
    if (hi - lo > 1) bar = xcd_barrier_post((unsigned*)(p.ws + WS_CTL), MISC + 8);
#define IN(k) (lo <= (k) && (k) < hi)
#define SEAM(k) do { if (IN(k) && IN((k) + 1)) xcd_barrier(bar); } while (0)
    unsigned char* ws = p.ws;
    const float* mod = (const float*)(ws + WS_MOD);
    if (IN(0)) { ph_prologue(p, c); } SEAM(0);
    if (IN(1)) { ph_modulate(p.x, p.g_mix, mod, 0 * D, 1 * D, (bf16*)(ws + WS_H), ws + WS_H8, c); } SEAM(1);
    if (IN(2)) {
        { pg8::Gemm g{(const bf16*)(ws + WS_H), (const bf16*)(ws + WS_BT1), T, IN_BF, D, D, D}; pg8::StaticOrder S; S.init(T, IN_BF, c.nb, c.bid);
          pg8::EpiB<0> E{(bf16*)(ws + WS_P1), nullptr, nullptr, nullptr, N1, 0, 1.0f, 0.f};
          pg8::gemm_phase<pg8::EpiB<0>, pg8::StaticOrder, true, true>(c.lds, g, S, E); }
        { pg8::Gemm g{(const bf16*)(ws + WS_H8), (const bf16*)(ws + WS_W8IN), T, IN_PAD - IN_BF, D / 2, D / 2, D / 2}; pg8::StaticOrder S; S.init(T, IN_PAD - IN_BF, c.nb, c.bid);
          pg8::EpiB<0> E{(bf16*)(ws + WS_P1) + IN_BF, nullptr, nullptr, nullptr, N1, 0, 1.0f / 16384.0f, 0.f};
          pg8::gemm_phase<pg8::EpiB<0>, pg8::StaticOrder, true, true, true>(c.lds, g, S, E); }
        { pg8::Gemm g{(const bf16*)(ws + WS_H8), (const bf16*)(ws + WS_G8), T, 2 * D, D / 2, D / 2, D / 2}; pg8::StaticOrder S; S.init(T, 2 * D, c.nb, c.bid);
          pg8::EpiGate E{(bf16*)(ws + WS_P1) + C_GA, N1, p.b_gate, 1.0f / 16384.0f};
          pg8::gemm_phase<pg8::EpiGate, pg8::StaticOrder, true, true, true>(c.lds, g, S, E); }
    } SEAM(2);
    if (IN(3)) { ph_postproc(p, c); } SEAM(3);
    if (IN(4)) { pg8::Gemm g{(const bf16*)(ws + WS_P1) + C_CQ, (const bf16*)(ws + WS_BT2), T, N2, A_QR, N1, A_QR}; pg8::StaticOrder S; S.init(T, N2, c.nb, c.bid);
        pg8::EpiB<0> E{(bf16*)(ws + WS_Q2), nullptr, nullptr, nullptr, N2, 0, 1.0f, 0.f};
        pg8::gemm_phase<pg8::EpiB<0>, pg8::StaticOrder, true, true>(c.lds, g, S, E); } SEAM(4);
    if (IN(5)) { ph_ret_state(p, c); ph_qlat(p, c); } SEAM(5);
    if (IN(6)) { ph_scores(p, c); } SEAM(6);
    if (IN(7)) { ph_topk(p, c); } SEAM(7);
    if (IN(8)) { ph_attn(p, c); } SEAM(8);
    if (IN(9)) { adaln_late_reduce(p, c); ph_oproj(p, c); ph_ret_out(p, c); } SEAM(9);
    if (IN(12)) { pg8::Gemm g{(const bf16*)(ws + WS_YCAT), (const bf16*)(ws + WS_BTUP), T, D, A_WIDTH / 2, D / 2, D / 2}; pg8::StaticOrder S; S.init(T, D, c.nb, c.bid);
        pg8::EpiB<2> E{(bf16*)(ws + WS_MERGED), nullptr, nullptr, (const bf16*)(ws + WS_P1) + C_GA, D, N1, 1.0f / 16384.0f, 0.f};
        pg8::gemm_phase<pg8::EpiB<2>, pg8::StaticOrder, true, true, true>(c.lds, g, S, E); }
    if (IN(12) && IN(13)) { VM_WAIT(); __syncthreads(); }
    if (IN(13)) { pg8::Gemm g{(const bf16*)(ws + WS_YCAT + A_WIDTH), (const bf16*)(ws + WS_BTUP + A_WIDTH), T, D, R_W / 2, D / 2, D / 2}; pg8::StaticOrder S; S.init(T, D, c.nb, c.bid);
        pg8::EpiB<3> E{(bf16*)(ws + WS_MERGED), ws + WS_MERGED8, nullptr, (const bf16*)(ws + WS_P1) + C_GR, D, N1, 1.0f / 16384.0f, 64.0f};
        pg8::gemm_phase<pg8::EpiB<3>, pg8::StaticOrder, true, true, true>(c.lds, g, S, E); } SEAM(13);
    if (IN(14)) { pg8::Gemm g{(const bf16*)(ws + WS_MERGED8), (const bf16*)(ws + WS_BTOUT), T, D, D / 2, D / 2, D / 2}; pg8::StaticOrder S; S.init(T, D, c.nb, c.bid);
        pg8::EpiRes E{p.x, p.out, D, mod + 2 * D, 6 * D, 1.0f / 65536.0f};
        pg8::gemm_phase<pg8::EpiRes, pg8::StaticOrder, true, true, true>(c.lds, g, S, E); } SEAM(14);
    if (IN(15)) { ph_modulate(p.out, p.g_ffn, mod, 3 * D, 4 * D, (bf16*)(ws + WS_H), nullptr, c); } SEAM(15);
    if (IN(16)) { pg8::Gemm g{(const bf16*)(ws + WS_H), (const bf16*)(ws + WS_BTPQ), T, 2048, D, D, D}; pg8::StaticOrder S; S.init(T, 2048, c.nb, c.bid);
        pg8::EpiB<0> E{(bf16*)(ws + WS_PQ), nullptr, nullptr, nullptr, 2048, 0, 1.0f, 0.f};
        pg8::gemm_phase<pg8::EpiB<0>, pg8::StaticOrder, true, true>(c.lds, g, S, E); } SEAM(16);
    if (IN(17)) { ph_peer_route(p, c); } SEAM(17);
    if (IN(18)) { ph_peer_experts(p, c); }
#undef IN
#undef SEAM
}

#ifdef DBG_STOP
__device__ __forceinline__ float dsan(float v) { return (v - v == 0.0f) ? v : 777.0f; }
__global__ void dump_kernel(Params p, int k) {
    unsigned char* ws = p.ws; const size_t n = (size_t)T * D;
    for (size_t i = (size_t)blockIdx.x * blockDim.x + threadIdx.x; i < n; i += (size_t)gridDim.x * blockDim.x) {
        float v = 0.f;
        if (k == 0) { v = ((const float*)(ws + WS_MOD))[i % 98304] + bf2f(((const bf16*)(ws + WS_BT1))[i] ) + bf2f(((const bf16*)(ws + WS_BT1))[(i + n) % 66060288])
                + bf2f(((const bf16*)(ws + WS_BT2))[i % 10485760]) + bf2f(((const bf16*)(ws + WS_WUK))[i % 1048576]) + bf2f(((const bf16*)(ws + WS_BTUV))[i % 1048576])
                + bf2f(((const bf16*)(ws + WS_BTUP))[i % 16777216]) + bf2f(((const bf16*)(ws + WS_BTOUT))[i % 16777216]) + bf2f(((const bf16*)(ws + WS_BTPQ))[i % 8388608])
                + bf2f(((const bf16*)(ws + WS_SK))[i % 32768]) + (float)(ws + WS_U8)[i] + (float)(ws + WS_V8)[i]; }
        else if (k == 1 || k == 15) v = bf2f(((const bf16*)(ws + WS_H))[i]);
        else if (k == 2 || k == 3) { const bf16* P = (const bf16*)(ws + WS_P1); v = bf2f(P[i]) + bf2f(P[i + n]) + bf2f(P[i + 2 * n]) + bf2f(P[(i + 3 * n) % 132120576]) + ((const float*)(ws + WS_WIDX))[i % 524288] * (k == 3 ? 1.f : 0.f); }
        else if (k == 4) { const bf16* P = (const bf16*)(ws + WS_Q2); v = bf2f(P[i]) + bf2f(P[i + n]) + bf2f(P[(i + 2 * n) % 83886080]); }
        else if (k == 5) { const bf16* P = (const bf16*)(ws + WS_QL); v = bf2f(P[i]) + bf2f(P[i + n]); }
        else if (k == 6) { const size_t j = i % ((size_t)T * SEQ); const int t = (int)(j / SEQ), s = (int)(j % SEQ); v = (s < (((t % SEQ) / 64) + 1) * 64) ? ((const float*)(ws + WS_SC))[j] : 0.f; }
        else if (k == 7) { const size_t j = i % ((size_t)T * TOPK); const int t = (int)(j / TOPK), s = (int)(j % TOPK); const int cnt = ((const int*)(ws + WS_CNT))[t]; v = (s < cnt) ? (float)((const int*)(ws + WS_SEL))[j] : (float)cnt; }
        else if (k == 8) { const bf16* P = (const bf16*)(ws + WS_OLAT); v = bf2f(P[i]) + bf2f(P[i + n]); }
        else if (k == 9) { v = (float)(ws + WS_YCAT)[(i / 2048) * 4096 + (i % 2048)]; }
        else if (k == 10) { v = ((const float*)(ws + WS_SC))[i % ((size_t)T * 2048)]; }
        else if (k == 11) { v = (float)(ws + WS_YCAT)[i]; }
        else if (k == 12 || k == 13) { v = bf2f(((const bf16*)(ws + WS_MERGED))[i]); }
        else if (k == 14 || k == 18) { v = p.out[i]; }
        else if (k == 16) { v = bf2f(((const bf16*)(ws + WS_PQ))[i % ((size_t)T * 2048)]); }
        else if (k == 17) { v = (float)((const int*)(ws + WS_EID))[i % ((size_t)T * 128)] + ((const float*)(ws + WS_GATE))[i % ((size_t)T * 128)]; }
        p.out[i] = dsan(v);
    }
}
#endif

#ifndef MK_SINGLE
#define MK_SINGLE 1
#endif
extern "C" void kernel_launch(void* const* d_in, const int* in_sizes, int n_in, void* d_out, int out_size, void* d_ws, size_t ws_size, hipStream_t stream) {
    static int grid = 0;
    if (grid == 0) {
        if (n_in != 26 || in_sizes[0] != T * D || out_size != T * D || ws_size < WS_END) { fprintf(stderr, "kernel_launch: unexpected shapes (n_in %d, in0 %d, out %d, ws %zu < %zu)\n", n_in, n_in > 0 ? in_sizes[0] : -1, out_size, ws_size, (size_t)WS_END); grid = -1; return; }
        int dev = 0, cus = 0, per_cu = 0;
        if (hipGetDevice(&dev) != hipSuccess || hipDeviceGetAttribute(&cus, hipDeviceAttributeMultiprocessorCount, dev) != hipSuccess) { grid = -1; return; }
        if (hipFuncSetAttribute((const void*)fwd_kernel, hipFuncAttributeMaxDynamicSharedMemorySize, LDS_BYTES) != hipSuccess) { fprintf(stderr, "kernel_launch: hipFuncSetAttribute failed\n"); grid = -1; return; }
        if (hipOccupancyMaxActiveBlocksPerMultiprocessor(&per_cu, (const void*)fwd_kernel, NTHR, LDS_BYTES) != hipSuccess || per_cu < 1) { fprintf(stderr, "kernel_launch: occupancy query reports %d blocks per CU\n", per_cu); }
        (void)hipGetLastError();
        grid = cus;
    }
    if (grid < 0) return;
    (void)hipMemsetAsync((char*)d_ws + WS_CTL, 0, CTL_ZERO_BYTES, stream);
    Params p{};
    const float** pf = (const float**)&p;
    for (int i = 0; i < 26; ++i) pf[i] = (const float*)d_in[i];
    p.out = (float*)d_out; p.ws = (unsigned char*)d_ws;
#ifdef DBG_STOP
    for (int ph = 0; ph <= DBG_STOP; ++ph) { p.ph_lo = ph; p.ph_hi = ph + 1; hipLaunchKernelGGL(fwd_kernel, dim3(grid), dim3(NTHR), LDS_BYTES, stream, p); }
    p.ph_lo = 0; p.ph_hi = 0;
    hipLaunchKernelGGL(dump_kernel, dim3(2048), dim3(256), 0, stream, p, (int)DBG_STOP);
#elif MK_SINGLE
    p.ph_lo = 0; p.ph_hi = N_PHASES;
    hipLaunchKernelGGL(fwd_kernel, dim3(grid), dim3(NTHR), LDS_BYTES, stream, p);
#else
    for (int ph = 0; ph < N_PHASES; ++ph) { p.ph_lo = ph; p.ph_hi = ph + 1; hipLaunchKernelGGL(fwd_kernel, dim3(grid), dim3(NTHR), LDS_BYTES, stream, p);
#ifdef REP_MASK
        if ((REP_MASK >> ph) & 1) hipLaunchKernelGGL(fwd_kernel, dim3(grid), dim3(NTHR), LDS_BYTES, stream, p);
#endif
    }
#endif
}
```

```cpp
#include <hip/hip_runtime.h>
#include <cstdio>
#include <cstdint>

#define GAS __attribute__((address_space(1)))
#define LAS __attribute__((address_space(3)))
typedef unsigned short bf16;
typedef unsigned v4u __attribute__((ext_vector_type(4)));
typedef unsigned v2u __attribute__((ext_vector_type(2)));
typedef float f32x4 __attribute__((ext_vector_type(4)));
typedef float f32x2 __attribute__((ext_vector_type(2)));
typedef short bf16x8 __attribute__((ext_vector_type(8)));
typedef short bf16x4 __attribute__((ext_vector_type(4)));

constexpr int D = 4096, NB = 4, SEQ = 2048, T = NB * SEQ;
constexpr int CHUNK = 64;
constexpr float EPS = 1e-6f;
constexpr int A_HEADS = 16, A_HD = 128, A_QR = 1024, A_KVR = 512, A_WIDTH = 2048;
constexpr int IDX_H = 64, IDX_D = 128, TOPK = 256;
constexpr int R_HEADS = 8, R_QK = 128, R_V = 256, R_QKW = 1024, R_W = 2048;
constexpr int P_HEADS = 8, P_QD = 256, P_NK = 128, P_TOPK = 16, P_EXP = 16384;
constexpr int IN_WIDTH = 7872, IN_PAD = 7936, IN_BF = 1792;
constexpr int N1 = IN_PAD + 2 * D;
constexpr int N2 = A_WIDTH + IDX_H * IDX_D;
constexpr int C_CQ = 0, C_CKV = 1024, C_KI = 1536, C_WI = 1664, C_RQ = 1728, C_RK = 2752, C_RV = 3776, C_RG = 5824, C_GA = IN_PAD, C_GR = IN_PAD + D;

__device__ __forceinline__ float bf2f(bf16 h) { return __uint_as_float(((unsigned)h) << 16); }
__device__ __forceinline__ float bflo(unsigned w) { return __uint_as_float(w << 16); }
__device__ __forceinline__ float bfhi(unsigned w) { return __uint_as_float(w & 0xffff0000u); }
typedef __bf16 bf16v2_t __attribute__((ext_vector_type(2)));
__device__ __forceinline__ unsigned cvt_pk_bf16(float lo, float hi) { const bf16v2_t v = __builtin_convertvector((f32x2){lo, hi}, bf16v2_t); return __builtin_bit_cast(unsigned, v); }
__device__ __forceinline__ bf16 f2bf(float f) { return (bf16)(cvt_pk_bf16(f, 0.f) & 0xffffu); }
__device__ __forceinline__ float wave_sum(float v) {
#pragma unroll
    for (int o = 1; o < 64; o <<= 1) v += __shfl_xor(v, o);
    return v;
}
#define PK_FP8(a, b, old, hi) __builtin_amdgcn_cvt_pk_fp8_f32(__builtin_amdgcn_fmed3f((a), -448.0f, 448.0f), __builtin_amdgcn_fmed3f((b), -448.0f, 448.0f), (old), (hi))
__device__ __forceinline__ float sigmoidf_(float v) { return 1.0f / (1.0f + __expf(-v)); }

namespace pg8 {
#define PG8_LAS __attribute__((address_space(3)))
typedef unsigned short bf16_t;
typedef unsigned u32x4 __attribute__((ext_vector_type(4)));
constexpr int BM = 256, BK = 64, HALF = 128, HTB = HALF * BK * 2  , STAGE_BYTES = 8 * HTB, NXCD = 8, WGM = 8;

__host__ __device__ __forceinline__ int lds_byte(int r, int c) { const int st = (r >> 4) * 2 + (c >> 5), rr = r & 15, cc = c & 31, ob = rr * 64 + cc * 2; return st * 1024 + (ob ^ (((ob >> 9) & 1) << 5)); }
__host__ __device__ __forceinline__ void stage_rc(int b, int& R, int& C) { const int st = b / 1024, sb = b % 1024, swz = sb ^ (((sb >> 9) & 1) << 5); R = (st >> 1) * 16 + swz / 64; C = (st & 1) * 32 + (swz % 64) / 2; }
__host__ __device__ __forceinline__ int perm32(int rho) { const int n = rho >> 4, i = rho & 15; return 8 * (i >> 2) + 4 * n + (i & 3); }

struct Unit { int pm, pn; };
struct Gemm { const bf16_t* A; const bf16_t* Bt; int M, N, K, lda, ldb; };

struct StaticOrder {
    int nM, nN, nwg, G, c;
    __host__ __device__ void init(int M, int N, int G_, int c_) { nM = M / BM; nN = N / BM; nwg = nM * nN; G = G_; c = c_; }
    __host__ __device__ bool next(int i, Unit& u) const {
        const long L = (long)i * G + c; if (L >= nwg) return false;
        int wgid = (int)L; { const int q = nwg / NXCD, r = nwg % NXCD, xcd = wgid % NXCD, off = wgid / NXCD; wgid = (xcd < r ? xcd * (q + 1) : r * (q + 1) + (xcd - r) * q) + off; }
        const int nig = WGM * nN, gid = wgid / nig, fm = gid * WGM, gsz = (nM - fm) < WGM ? (nM - fm) : WGM;
        u.pm = fm + ((wgid % nig) % gsz); u.pn = (wgid % nig) / gsz; return true;
    }
    __device__ __forceinline__ void a_ready(const Unit&) const {}
    __device__ __forceinline__ void done(const Unit&) const {}
};

template <int MODE> struct EpiB {
    static constexpr bool PERM = true, AFTER_DRAIN = false;
    bf16_t* O; unsigned char* O8; const float* bias; const bf16_t* gate; int ldc, ldg; float scale, scale8;
    __device__ __forceinline__ void operator()(const f32x4 (&acc)[2][2][4][2], const Unit& u, int wr, int wc, int fr, int fq) const {
        const int row0 = u.pm * BM + wr * 64 + fr; const int col0 = u.pn * BM + wc * 32 + 8 * fq;
        const bool gates = (MODE == 1) && (u.pn >= 31);
        f32x4 bv[2][2];
#pragma unroll
        for (int bj = 0; bj < 2; ++bj)
#pragma unroll
            for (int n = 0; n < 2; ++n) bv[bj][n] = gates ? *(const f32x4*)(bias + (col0 - 31 * BM) + bj * HALF + 4 * n) : (f32x4){0.f, 0.f, 0.f, 0.f};
#pragma unroll
        for (int ai = 0; ai < 2; ++ai)
#pragma unroll
            for (int m = 0; m < 4; ++m) { const size_t r = (size_t)(row0 + ai * HALF + m * 16); bf16_t* rowp = O + r * ldc + col0;
#pragma unroll
                for (int bj = 0; bj < 2; ++bj) { f32x4 v0 = acc[ai][bj][m][0] * scale, v1 = acc[ai][bj][m][1] * scale;
                    if (MODE == 1) { if (gates) { v0 = v0 + bv[bj][0]; v1 = v1 + bv[bj][1];
#pragma unroll
                            for (int j = 0; j < 4; ++j) { v0[j] = sigmoidf_(v0[j]); v1[j] = sigmoidf_(v1[j]); } } }
                    if (MODE == 2 || MODE == 3) { const u32x4 gw = *(const u32x4*)(gate + r * ldg + col0 + bj * HALF);
                        v0[0] *= bflo(gw.x); v0[1] *= bfhi(gw.x); v0[2] *= bflo(gw.y); v0[3] *= bfhi(gw.y); v1[0] *= bflo(gw.z); v1[1] *= bfhi(gw.z); v1[2] *= bflo(gw.w); v1[3] *= bfhi(gw.w); }
                    if (MODE == 3) { const u32x4 pw = *(const u32x4*)(rowp + bj * HALF);
                        v0[0] += bflo(pw.x); v0[1] += bfhi(pw.x); v0[2] += bflo(pw.y); v0[3] += bfhi(pw.y); v1[0] += bflo(pw.z); v1[1] += bfhi(pw.z); v1[2] += bflo(pw.w); v1[3] += bfhi(pw.w); }
                    u32x4 w; w.x = cvt_pk_bf16(v0[0], v0[1]); w.y = cvt_pk_bf16(v0[2], v0[3]); w.z = cvt_pk_bf16(v1[0], v1[1]); w.w = cvt_pk_bf16(v1[2], v1[3]);
                    *(u32x4*)(rowp + bj * HALF) = w;
                    if (MODE == 3) { int q0 = 0, q1 = 0; q0 = PK_FP8(v0[0] * scale8, v0[1] * scale8, q0, false); q0 = PK_FP8(v0[2] * scale8, v0[3] * scale8, q0, true);
                        q1 = PK_FP8(v1[0] * scale8, v1[1] * scale8, q1, false); q1 = PK_FP8(v1[2] * scale8, v1[3] * scale8, q1, true);
                        *(v2u*)(O8 + r * ldc + col0 + bj * HALF) = (v2u){(unsigned)q0, (unsigned)q1}; } } }
    }
};
typedef int v8i_t __attribute__((ext_vector_type(8)));
typedef int v4i_t __attribute__((ext_vector_type(4)));
__device__ __forceinline__ v8i_t f8cat(const bf16x8 lo, const bf16x8 hi) { const v4i_t a = __builtin_bit_cast(v4i_t, lo), b = __builtin_bit_cast(v4i_t, hi); return __builtin_shufflevector(a, b, 0, 1, 2, 3, 4, 5, 6, 7); }
struct EpiGate {
    static constexpr bool PERM = true, AFTER_DRAIN = false;
    bf16_t* O; int ldc; const float* bias; float scale;
    __device__ __forceinline__ void operator()(const f32x4 (&acc)[2][2][4][2], const Unit& u, int wr, int wc, int fr, int fq) const {
        const int row0 = u.pm * BM + wr * 64 + fr; const int col0 = u.pn * BM + wc * 32 + 8 * fq;
        f32x4 bv[2][2];
#pragma unroll
        for (int bj = 0; bj < 2; ++bj)
#pragma unroll
            for (int n = 0; n < 2; ++n) bv[bj][n] = *(const f32x4*)(bias + col0 + bj * HALF + 4 * n);
#pragma unroll
        for (int ai = 0; ai < 2; ++ai)
#pragma unroll
            for (int m = 0; m < 4; ++m) { bf16_t* rowp = O + (size_t)(row0 + ai * HALF + m * 16) * ldc + col0;
#pragma unroll
                for (int bj = 0; bj < 2; ++bj) { f32x4 v0 = acc[ai][bj][m][0] * scale + bv[bj][0], v1 = acc[ai][bj][m][1] * scale + bv[bj][1];
#pragma unroll
                    for (int j = 0; j < 4; ++j) { v0[j] = sigmoidf_(v0[j]); v1[j] = sigmoidf_(v1[j]); }
                    u32x4 w; w.x = cvt_pk_bf16(v0[0], v0[1]); w.y = cvt_pk_bf16(v0[2], v0[3]); w.z = cvt_pk_bf16(v1[0], v1[1]); w.w = cvt_pk_bf16(v1[2], v1[3]);
                    *(u32x4*)(rowp + bj * HALF) = w; } }
    }
};
struct EpiRes {
    static constexpr bool PERM = false, AFTER_DRAIN = false;
    const float* X; float* O; int ldc; const float* gt; int ldgt; float scale;
    __device__ __forceinline__ void operator()(const f32x4 (&acc)[2][2][4][2], const Unit& u, int wr, int wc, int fr, int fq) const {
        const int row0 = u.pm * BM + wr * 64 + fr, col0 = u.pn * BM + wc * 32 + 4 * fq;
        const float* g = gt + (size_t)(u.pm / (SEQ / BM)) * ldgt;
        f32x4 gv[2][2];
#pragma unroll
        for (int bj = 0; bj < 2; ++bj)
#pragma unroll
            for (int n = 0; n < 2; ++n) gv[bj][n] = *(const f32x4*)(g + col0 + bj * HALF + n * 16);
#pragma unroll
        for (int ai = 0; ai < 2; ++ai)
#pragma unroll
            for (int m = 0; m < 4; ++m) { const size_t off = (size_t)(row0 + ai * HALF + m * 16) * ldc + col0;
#pragma unroll
                for (int bj = 0; bj < 2; ++bj)
#pragma unroll
                    for (int n = 0; n < 2; ++n) { const f32x4 xv = *(const f32x4*)(X + off + bj * HALF + n * 16); *(f32x4*)(O + off + bj * HALF + n * 16) = xv + gv[bj][n] * (acc[ai][bj][m][n] * scale); } }
    }
};

template <class Epi, class Sched, bool ALIGN_EPI = false, bool SP2 = false, bool F8 = false>
__device__ __forceinline__ void gemm_phase(PG8_LAS unsigned char* lds, const Gemm g, const Sched& S, const Epi& E) {
    const int tid = threadIdx.x, wid = __builtin_amdgcn_readfirstlane(tid >> 6), lane = tid & 63, wr = wid >> 2, wc = wid & 3, fr = lane & 15, fq = lane >> 4;
    const int K = g.K, nt = K / BK;
    unsigned voffA[2], voffB[2];
#pragma unroll
    for (int i = 0; i < 2; ++i) { int R, C; stage_rc(tid * 16 + i * 8192, R, C); const int Rb = Epi::PERM ? ((R & ~31) + perm32(R & 31)) : R;
        voffA[i] = (unsigned)(R * g.lda + C) * 2u; voffB[i] = (unsigned)(Rb * g.ldb + C) * 2u; }
    const size_t kstep = (size_t)(BK * 2);
    const size_t hstepA = (size_t)HALF * g.lda * 2, hstepB = (size_t)HALF * g.ldb * 2;
    const size_t tstepA = 2 * hstepA, tstepB = 2 * hstepB;
    const unsigned ldsw = (unsigned)wid * 1024u;
    const int aoff = lds_byte(wr * 64 + fr, fq * 8), boff = lds_byte(wc * 32 + fr, fq * 8);
#define PG8_SA(b, h) (((b) * 2 + (h)) * HTB)
#define PG8_SB(b, h) ((4 + (b) * 2 + (h)) * HTB)
#define PG8_STAGE(bufoff, gbase, voff) do { _Pragma("unroll") for (int _i = 0; _i < 2; ++_i) \
        __builtin_amdgcn_global_load_lds((const unsigned*)((const char*)(gbase) + (voff)[_i]), (PG8_LAS unsigned*)(lds + (bufoff) + ldsw + _i * 8192), 16, 0, 0); } while (0)
#define PG8_LDA(dst, b, h) do { if constexpr (F8) { _Pragma("unroll") for (int m = 0; m < 4; ++m) dst##8[m] = f8cat(*(const PG8_LAS bf16x8*)(lds + PG8_SA(b, h) + aoff + m * 2048), *(const PG8_LAS bf16x8*)(lds + PG8_SA(b, h) + aoff + m * 2048 + 1024)); } \
        else { _Pragma("unroll") for (int m = 0; m < 4; ++m) _Pragma("unroll") for (int k = 0; k < 2; ++k) dst[m][k] = *(const PG8_LAS bf16x8*)(lds + PG8_SA(b, h) + aoff + m * 2048 + k * 1024); } } while (0)
#define PG8_LDB(dst, b, h) do { if constexpr (F8) { _Pragma("unroll") for (int n = 0; n < 2; ++n) dst##8[n] = f8cat(*(const PG8_LAS bf16x8*)(lds + PG8_SB(b, h) + boff + n * 2048), *(const PG8_LAS bf16x8*)(lds + PG8_SB(b, h) + boff + n * 2048 + 1024)); } \
        else { _Pragma("unroll") for (int n = 0; n < 2; ++n) _Pragma("unroll") for (int k = 0; k < 2; ++k) dst[n][k] = *(const PG8_LAS bf16x8*)(lds + PG8_SB(b, h) + boff + n * 2048 + k * 1024); } } while (0)
#define PG8_MMA(ai, bj, At, Bt) do { __builtin_amdgcn_s_setprio(1); _Pragma("unroll") for (int m = 0; m < 4; ++m) _Pragma("unroll") for (int n = 0; n < 2; ++n) { \
        if constexpr (F8) { asm volatile("v_mfma_scale_f32_16x16x128_f8f6f4 %0, %1, %2, %0, %3, %3 op_sel_hi:[0,0,0]" : "+v"(acc[ai][bj][m][n]) : "v"(Bt##8[n]), "v"(At##8[m]), "v"(f8scale)); } \
        else { _Pragma("unroll") for (int k = 0; k < 2; ++k) acc[ai][bj][m][n] = __builtin_amdgcn_mfma_f32_16x16x32_bf16(Bt[n][k], At[m][k], acc[ai][bj][m][n], 0, 0, 0); } } __builtin_amdgcn_s_setprio(0); } while (0)
#define PG8_WAIT_V(n) asm volatile("s_waitcnt vmcnt(" #n ")" ::: "memory")
#define PG8_WAIT_L(n) asm volatile("s_waitcnt lgkmcnt(" #n ")" ::: "memory")
#define PG8_BAR __builtin_amdgcn_s_barrier()
#define PG8_SCHED __builtin_amdgcn_sched_barrier(0)
    Unit cur, nxt; int ui = 0;
    if (!S.next(0, cur)) return;
    f32x4 acc[2][2][4][2];
#pragma unroll
    for (int a = 0; a < 2; ++a)
#pragma unroll
        for (int b = 0; b < 2; ++b)
#pragma unroll
            for (int m = 0; m < 4; ++m)
#pragma unroll
                for (int n = 0; n < 2; ++n) acc[a][b][m][n] = (f32x4){0.f, 0.f, 0.f, 0.f};
    bf16x8 At[4][2], B0[2][2], B1[2][2]; v8i_t At8[4], B08[2], B18[2];
    const int f8scale = 0x7f7f7f7f;
    const char* cA = (const char*)g.A + (size_t)cur.pm * tstepA; const char* cB = (const char*)g.Bt + (size_t)cur.pn * tstepB;
    S.a_ready(cur);
    if constexpr (SP2) {
        PG8_STAGE(PG8_SB(0, 0), cB, voffB); PG8_STAGE(PG8_SB(0, 1), cB + hstepB, voffB); PG8_STAGE(PG8_SA(0, 0), cA, voffA); PG8_STAGE(PG8_SA(0, 1), cA + hstepA, voffA);
        if (wr == 1) PG8_BAR;
        PG8_WAIT_V(2); PG8_BAR;
        PG8_STAGE(PG8_SB(1, 0), cB + kstep, voffB); PG8_STAGE(PG8_SA(1, 0), cA + kstep, voffA); PG8_STAGE(PG8_SB(1, 1), cB + hstepB + kstep, voffB);
        PG8_WAIT_V(6); PG8_BAR;
    } else {
        PG8_STAGE(PG8_SB(0, 0), cB, voffB); PG8_STAGE(PG8_SA(0, 0), cA, voffA); PG8_STAGE(PG8_SB(0, 1), cB + hstepB, voffB); PG8_STAGE(PG8_SA(0, 1), cA + hstepA, voffA);
        if (wr == 1) PG8_BAR;
        PG8_WAIT_V(4); PG8_BAR;
        PG8_STAGE(PG8_SB(1, 0), cB + kstep, voffB); PG8_STAGE(PG8_SA(1, 0), cA + kstep, voffA); PG8_STAGE(PG8_SB(1, 1), cB + hstepB + kstep, voffB);
        PG8_WAIT_V(6); PG8_BAR;
    }
    for (;;) {
        const bool has_next = S.next(ui + 1, nxt);
        const char* nA = has_next ? (const char*)g.A + (size_t)nxt.pm * tstepA : cA; const char* nB = has_next ? (const char*)g.Bt + (size_t)nxt.pn * tstepB : cB;
        for (int t = 0; t < nt; t += 2) {
            const bool last = (t == nt - 2);
            const char* a1 = cA + (size_t)(t + 1) * kstep;
            const char* a2 = last ? nA : cA + (size_t)(t + 2) * kstep; const char* b2 = last ? nB : cB + (size_t)(t + 2) * kstep;
            const char* a3 = a2 + kstep; const char* b3 = b2 + kstep;
            if (last && has_next) S.a_ready(nxt);
            if constexpr (SP2) {
            PG8_LDB(B0, 0, 0); PG8_LDB(B1, 0, 1); PG8_SCHED; PG8_LDA(At, 0, 0); PG8_STAGE(PG8_SA(1, 1), a1 + hstepA, voffA);
            PG8_WAIT_V(8); PG8_WAIT_L(0); PG8_BAR; PG8_MMA(0, 0, At, B0); PG8_MMA(0, 1, At, B1); PG8_BAR; PG8_SCHED;
            PG8_LDA(At, 0, 1); PG8_STAGE(PG8_SB(0, 0), b2, voffB); PG8_STAGE(PG8_SB(0, 1), b2 + hstepB, voffB); PG8_STAGE(PG8_SA(0, 0), a2, voffA);
            PG8_WAIT_V(8); PG8_WAIT_L(0); PG8_BAR; PG8_MMA(1, 0, At, B0); PG8_MMA(1, 1, At, B1); PG8_BAR; PG8_SCHED;
            PG8_LDB(B0, 1, 0); PG8_LDB(B1, 1, 1); PG8_SCHED; PG8_LDA(At, 1, 0); PG8_STAGE(PG8_SA(0, 1), a2 + hstepA, voffA);
            PG8_WAIT_V(8); PG8_WAIT_L(0); PG8_BAR; PG8_MMA(0, 0, At, B0); PG8_MMA(0, 1, At, B1); PG8_BAR; PG8_SCHED;
            PG8_LDA(At, 1, 1); PG8_STAGE(PG8_SB(1, 0), b3, voffB); PG8_STAGE(PG8_SB(1, 1), b3 + hstepB, voffB); PG8_STAGE(PG8_SA(1, 0), a3, voffA);
            PG8_WAIT_V(8); PG8_WAIT_L(0); PG8_BAR; PG8_MMA(1, 0, At, B0); PG8_MMA(1, 1, At, B1); PG8_BAR; PG8_SCHED;
            } else {
            PG8_LDB(B0, 0, 0); PG8_SCHED; PG8_LDA(At, 0, 0); PG8_STAGE(PG8_SA(1, 1), a1 + hstepA, voffA);
            PG8_WAIT_L(8); PG8_BAR; PG8_WAIT_L(0); PG8_MMA(0, 0, At, B0); PG8_BAR; PG8_SCHED;
            PG8_LDB(B1, 0, 1); PG8_STAGE(PG8_SB(0, 0), b2, voffB);
            PG8_BAR; PG8_WAIT_L(0); PG8_MMA(0, 1, At, B1); PG8_BAR;
            PG8_LDA(At, 0, 1); PG8_STAGE(PG8_SA(0, 0), a2, voffA);
            PG8_BAR; PG8_WAIT_L(0); PG8_MMA(1, 0, At, B0); PG8_BAR; PG8_SCHED;
            PG8_STAGE(PG8_SB(0, 1), b2 + hstepB, voffB);
            PG8_WAIT_V(6); PG8_BAR; PG8_MMA(1, 1, At, B1); PG8_BAR;
            PG8_LDB(B0, 1, 0); PG8_SCHED; PG8_LDA(At, 1, 0); PG8_STAGE(PG8_SA(0, 1), a2 + hstepA, voffA);
            PG8_WAIT_L(8); PG8_BAR; PG8_WAIT_L(0); PG8_MMA(0, 0, At, B0); PG8_BAR; PG8_SCHED;
            PG8_LDB(B1, 1, 1); PG8_STAGE(PG8_SB(1, 0), b3, voffB);
            PG8_BAR; PG8_WAIT_L(0); PG8_MMA(0, 1, At, B1); PG8_BAR;
            PG8_LDA(At, 1, 1); PG8_STAGE(PG8_SA(1, 0), a3, voffA);
            PG8_BAR; PG8_WAIT_L(0); PG8_MMA(1, 0, At, B0); PG8_BAR; PG8_SCHED;
            PG8_STAGE(PG8_SB(1, 1), b3 + hstepB, voffB);
            PG8_WAIT_V(6); PG8_BAR; PG8_MMA(1, 1, At, B1); PG8_BAR;
            }
        }
        if constexpr (F8) { asm volatile("s_nop 15\n\ts_nop 15" ::: "memory"); }
        if constexpr (ALIGN_EPI) { if (wr == 0) PG8_BAR; }
        if constexpr (!Epi::AFTER_DRAIN) { E(acc, cur, wr, wc, fr, fq); S.done(cur); }
        if (!has_next) break;
#pragma unroll
        for (int a = 0; a < 2; ++a)
#pragma unroll
            for (int b = 0; b < 2; ++b)
#pragma unroll
                for (int m = 0; m < 4; ++m)
#pragma unroll
                    for (int n = 0; n < 2; ++n) acc[a][b][m][n] = (f32x4){0.f, 0.f, 0.f, 0.f};
        cur = nxt; cA = nA; cB = nB; ++ui;
        if constexpr (ALIGN_EPI) { if (wr == 1) PG8_BAR; }
    }
    PG8_WAIT_V(0);
    if constexpr (!ALIGN_EPI) { if (wr == 0) PG8_BAR; }
    PG8_BAR;
    if constexpr (Epi::AFTER_DRAIN) { E.fused(acc, cur, wr, wc, fr, fq, lds, wid, lane); S.done(cur); }
#undef PG8_SA
#undef PG8_SB
#undef PG8_STAGE
#undef PG8_LDA
#undef PG8_LDB
#undef PG8_MMA
#undef PG8_WAIT_V
#undef PG8_WAIT_L
#undef PG8_BAR
#undef PG8_SCHED
}}

constexpr size_t MiB = 1u << 20;
constexpr size_t WS_CTL = 0, CTL_ZERO_BYTES = 2 * MiB;
constexpr size_t WS_MOD = 1 * MiB;
constexpr size_t WS_BT1 = 2 * MiB;
constexpr size_t WS_W8IN = 16 * MiB;
constexpr size_t WS_G8 = 64 * MiB;
constexpr size_t WS_H8 = 96 * MiB;
constexpr size_t WS_BT2 = 128 * MiB;
constexpr size_t WS_WUK = 148 * MiB;
constexpr size_t WS_BTUV = 150 * MiB;
constexpr size_t WS_BTUP = 152 * MiB;
constexpr size_t WS_BTOUT = 184 * MiB;
constexpr size_t WS_BTPQ = 216 * MiB;
constexpr size_t WS_SK = 232 * MiB;
constexpr size_t WS_U8 = 233 * MiB, WS_V8 = 297 * MiB, WS_SU = 361 * MiB, WS_SV = 362 * MiB;
constexpr int ROW6 = 3072;
constexpr size_t WS_H = 489 * MiB;
constexpr size_t WS_P1 = 553 * MiB;
constexpr size_t WS_Q2 = 805 * MiB;
constexpr size_t WS_QL = 965 * MiB;
constexpr size_t WS_SC = 1093 * MiB;
constexpr size_t WS_SEL = 1157 * MiB, WS_CNT = 1165 * MiB, WS_WIDX = 1166 * MiB;
constexpr size_t WS_OLAT = 1168 * MiB;
constexpr size_t WS_YCAT = 1296 * MiB;
constexpr size_t WS_MERGED8 = 1328 * MiB;
constexpr size_t WS_MERGED = 1360 * MiB;
constexpr size_t WS_PQ = 1424 * MiB;
constexpr size_t WS_EID = 1456 * MiB, WS_GATE = 1460 * MiB;
constexpr size_t WS_CKV = 1528 * MiB;
constexpr size_t WS_END = 1536 * MiB;

constexpr int SCRATCH_BYTES = 155648;
constexpr int MISC_OFF = SCRATCH_BYTES;
constexpr int LDS_BYTES = SCRATCH_BYTES + 1024;
constexpr int NWAVES = 8, NTHR = 512;

struct Params {
    const float *x, *c, *w_ada, *b_ada, *g_mix, *w_in, *g_cq, *g_ckv, *w_uq, *w_uk, *w_uv, *w_qi, *g_ki, *b_ki, *t5, *g_ret, *w_up, *w_gate, *b_gate, *w_out, *g_ffn, *w_pq, *sub_keys, *u_exp, *v_exp, *g_final;
    float* out; unsigned char* ws; int ph_lo, ph_hi;
};

#define LDS_WAIT() asm volatile("s_waitcnt lgkmcnt(0)" ::: "memory")
#define VM_WAIT() asm volatile("s_waitcnt vmcnt(0)" ::: "memory")

#define XB_TMO      128
#define XB_XCNT(j)  (256  + 64 * (j))
#define XB_XSUB(j)  (1280 + 64 * (j))
#define XB_XGEN(j)  (2304 + 64 * (j))
#define XB_TOP      3328
#define XB_TOPGEN   3392
#define XCD_BAR_WORDS 3456
#define XB_ATT_RANK  4096
#define XB_SPIN_CAP (1u << 18)

__device__ __forceinline__ unsigned xb_ld(unsigned* p)              { return __hip_atomic_load(p, __ATOMIC_RELAXED, __HIP_MEMORY_SCOPE_AGENT); }
__device__ __forceinline__ unsigned xb_add(unsigned* p, unsigned v) { return __hip_atomic_fetch_add(p, v, __ATOMIC_RELAXED, __HIP_MEMORY_SCOPE_AGENT); }
__device__ __forceinline__ unsigned xb_xcc_id() { return (unsigned)__builtin_amdgcn_s_getreg((3 << 11) | 20) & 0xFu; }
#define XB_SPIN(cond, bar) do { unsigned _sp = 0; while (cond) { __builtin_amdgcn_s_sleep(1); \
    if ((++_sp & 255u) == 0u) { if (xb_ld(&(bar)[XB_TMO])) break; if (_sp > XB_SPIN_CAP) { atomicAdd(&(bar)[XB_TMO], 1u); break; } } } } while (0)

struct XcdBarrier { unsigned* bar; unsigned x; volatile LAS unsigned* st; };

__device__ __forceinline__ XcdBarrier xcd_barrier_post(unsigned* bar, volatile LAS unsigned* st) {
    XcdBarrier b; b.bar = bar; b.x = xb_xcc_id(); b.st = st;
    if (threadIdx.x == 0) (void)xb_add(&bar[XB_XCNT(b.x)], 1u);
    return b;
}
__device__ __forceinline__ void xcd_barrier_complete(unsigned* bar, unsigned x, unsigned& nloc, unsigned& nx) {
    const unsigned G = gridDim.x * gridDim.y * gridDim.z;
    unsigned sum, cnt, mine, sp = 0u;
    for (;;) {
        sum = 0u; cnt = 0u; mine = 0u;
#pragma unroll
        for (unsigned j = 0; j < 16; ++j) { const unsigned c = xb_ld(&bar[XB_XCNT(j)]); sum += c; cnt += (c > 0u) ? 1u : 0u; mine = (j == x) ? c : mine; }
        if (sum == G) break;
        __builtin_amdgcn_s_sleep(1);
        if ((++sp & 255u) == 0u) { if (xb_ld(&bar[XB_TMO])) break; if (sp > XB_SPIN_CAP) { atomicAdd(&bar[XB_TMO], 1u); break; } }
    }
    nloc = mine > 0u ? mine : 1u; nx = cnt > 0u ? cnt : 1u;
}
__device__ __forceinline__ void xcd_barrier(const XcdBarrier& b) {
    asm volatile("s_waitcnt vmcnt(0)" ::: "memory");
    __syncthreads();
    if (threadIdx.x == 0) {
        unsigned* bar = b.bar;
        __builtin_amdgcn_s_waitcnt(0);
        unsigned nloc = b.st[0], nx = b.st[1];
        if (nloc == 0u) { xcd_barrier_complete(bar, b.x, nloc, nx); b.st[0] = nloc; b.st[1] = nx; }
        const unsigned old = xb_add(&bar[XB_XSUB(b.x)], 1u);
        const unsigned gen = old / nloc;
        if (old + 1u == (gen + 1u) * nloc) {
            __builtin_amdgcn_fence(__ATOMIC_RELEASE, "agent");
            asm volatile("s_waitcnt vmcnt(0)" ::: "memory");
            const unsigned og = xb_add(&bar[XB_TOP], 1u);
            const unsigned tg = og / nx;
            if (og + 1u == (tg + 1u) * nx) xb_add(&bar[XB_TOPGEN], 1u);
            else XB_SPIN(xb_ld(&bar[XB_TOPGEN]) == tg, bar);
            __builtin_amdgcn_fence(__ATOMIC_ACQUIRE, "agent");
            xb_add(&bar[XB_XGEN(b.x)], 1u);
            asm volatile("s_waitcnt vmcnt(0)" ::: "memory");
        } else {
            XB_SPIN(xb_ld(&bar[XB_XGEN(b.x)]) == gen, bar);
            __builtin_amdgcn_fence(__ATOMIC_ACQUIRE, "agent");
            asm volatile("s_waitcnt vmcnt(0)" ::: "memory");
        }
    }
    __syncthreads();
}

struct Ctx { LAS unsigned char* lds; int tid, lane, wave, gw, ngw, bid, nb; };

__device__ __forceinline__ void p0_transpose_item(const float* W, int K, int N, bf16* WT, int row_off, LAS float* scr, int item, int lane, int ldw = 0) {
    if (!ldw) ldw = N;
    const int nblk = N / 32, kb = item / nblk, nb = item % nblk, k0 = 64 * kb, n0 = 32 * nb;
#pragma unroll 8
    for (int i = 0; i < 32; ++i) { const int kk = 2 * i + (lane >> 5); scr[kk * 33 + (lane & 31)] = W[(size_t)(k0 + kk) * ldw + n0 + (lane & 31)]; }
    LDS_WAIT(); asm volatile("" ::: "memory");
    const int c = lane & 7;
#pragma unroll
    for (int j = 0; j < 4; ++j) { const int n = (lane >> 3) + 8 * j; const LAS float* s = scr + (8 * c) * 33 + n;
        v4u o; o.x = cvt_pk_bf16(s[0 * 33], s[1 * 33]); o.y = cvt_pk_bf16(s[2 * 33], s[3 * 33]); o.z = cvt_pk_bf16(s[4 * 33], s[5 * 33]); o.w = cvt_pk_bf16(s[6 * 33], s[7 * 33]);
        *(v4u*)(WT + (size_t)(row_off + n0 + n) * K + k0 + 8 * c) = o; }
    LDS_WAIT(); asm volatile("" ::: "memory");
}
__device__ __forceinline__ void p0_transpose_item_f8(const float* W, int K, int N, unsigned char* WT, float sc, LAS float* scr, int item, int lane, int ldw = 0) {
    if (!ldw) ldw = N;
    const int nblk = N / 32, kb = item / nblk, nb = item % nblk, k0 = 64 * kb, n0 = 32 * nb;
#pragma unroll 8
    for (int i = 0; i < 32; ++i) { const int kk = 2 * i + (lane >> 5); scr[kk * 33 + (lane & 31)] = W[(size_t)(k0 + kk) * ldw + n0 + (lane & 31)]; }
    LDS_WAIT(); asm volatile("" ::: "memory");
    const int n = lane >> 1, kh = (lane & 1) * 32; const LAS float* s = scr + kh * 33 + n;
    unsigned o[8];
#pragma unroll
    for (int j = 0; j < 8; ++j) { int w = 0; w = PK_FP8(s[(4 * j) * 33] * sc, s[(4 * j + 1) * 33] * sc, w, false); w = PK_FP8(s[(4 * j + 2) * 33] * sc, s[(4 * j + 3) * 33] * sc, w, true); o[j] = (unsigned)w; }
    unsigned char* dp = WT + (size_t)(n0 + n) * K + k0 + kh;
    *(v4u*)dp = (v4u){o[0], o[1], o[2], o[3]}; *(v4u*)(dp + 16) = (v4u){o[4], o[5], o[6], o[7]};
    LDS_WAIT(); asm volatile("" ::: "memory");
}
__device__ __forceinline__ void p0_convert(const float* src, bf16* dst, size_t n, size_t i0, size_t stride) {
    for (size_t i = i0; i < n / 8; i += stride) { const f32x4 a = *(const f32x4*)(src + 8 * i), b = *(const f32x4*)(src + 8 * i + 4);
        v4u o; o.x = cvt_pk_bf16(a[0], a[1]); o.y = cvt_pk_bf16(a[2], a[3]); o.z = cvt_pk_bf16(b[0], b[1]); o.w = cvt_pk_bf16(b[2], b[3]); *(v4u*)(dst + 8 * i) = o; }
}

__device__ __forceinline__ void tr32_item(const float* W, int K, int N, bf16* WT, LAS float* scr, int item, int lane) {
    const int nblk = N / 32, kb = item / nblk, nb = item % nblk, k0 = 32 * kb, n0 = 32 * nb;
#pragma unroll 8
    for (int i = 0; i < 16; ++i) { const int kk = 2 * i + (lane >> 5); scr[kk * 33 + (lane & 31)] = W[(size_t)(k0 + kk) * N + n0 + (lane & 31)]; }
    LDS_WAIT(); asm volatile("" ::: "memory");
#pragma unroll
    for (int j = 0; j < 2; ++j) { const int q = lane + 64 * j, n = q >> 2, cch = q & 3; const LAS float* s = scr + (8 * cch) * 33 + n;
        v4u o; o.x = cvt_pk_bf16(s[0 * 33], s[1 * 33]); o.y = cvt_pk_bf16(s[2 * 33], s[3 * 33]); o.z = cvt_pk_bf16(s[4 * 33], s[5 * 33]); o.w = cvt_pk_bf16(s[6 * 33], s[7 * 33]);
        *(v4u*)(WT + (size_t)(n0 + n) * K + k0 + 8 * cch) = o; }
    LDS_WAIT(); asm volatile("" ::: "memory");
}
__device__ __forceinline__ void tr32_item_f8(const float* W, int K, int N, unsigned char* WT, float sc, LAS float* scr, int item, int lane) {
    const int nblk = N / 32, kb = item / nblk, nb = item % nblk, k0 = 32 * kb, n0 = 32 * nb;
#pragma unroll 8
    for (int i = 0; i < 16; ++i) { const int kk = 2 * i + (lane >> 5); scr[kk * 33 + (lane & 31)] = W[(size_t)(k0 + kk) * N + n0 + (lane & 31)]; }
    LDS_WAIT(); asm volatile("" ::: "memory");
    const int n = lane >> 1, kh = (lane & 1) * 16; const LAS float* s = scr + kh * 33 + n;
    unsigned o[4];
#pragma unroll
    for (int j = 0; j < 4; ++j) { int w = 0; w = PK_FP8(s[(4 * j) * 33] * sc, s[(4 * j + 1) * 33] * sc, w, false); w = PK_FP8(s[(4 * j + 2) * 33] * sc, s[(4 * j + 3) * 33] * sc, w, true); o[j] = (unsigned)w; }
    *(v4u*)(WT + (size_t)(n0 + n) * K + k0 + kh) = (v4u){o[0], o[1], o[2], o[3]};
    LDS_WAIT(); asm volatile("" ::: "memory");
}
__device__ __forceinline__ void convert_late_weights(const Params& p, LAS float* scr, int lane, int first, int stride) {
    unsigned char* ws = p.ws;
    constexpr int I_UP = 128 * (D / 32), I_OUT = 128 * (D / 32), I_PQ = 128 * (2048 / 32);
    for (int it = first; it < I_UP + I_OUT + I_PQ; it += stride) { int r = it;
        if (r < I_UP) { tr32_item_f8(p.w_up, D, D, ws + WS_BTUP, 1024.0f, scr, r, lane); continue; } r -= I_UP;
        if (r < I_OUT) { tr32_item_f8(p.w_out, D, D, ws + WS_BTOUT, 1024.0f, scr, r, lane); continue; } r -= I_OUT;
        tr32_item(p.w_pq, D, 2048, (bf16*)(ws + WS_BTPQ), scr, r, lane); }
}
constexpr size_t WS_MODP = 1093 * MiB;
__device__ __forceinline__ void adaln_late(const Params& p, int item, int lane) {
    const int cc = item & 63, rg = item >> 6;
    const float* wp = p.w_ada + (size_t)(rg * 256) * (6 * D) + 2 * D + cc * 256 + lane * 4;
    f32x4 a0 = {0.f, 0.f, 0.f, 0.f}, a1 = a0, a2 = a0, a3 = a0;
#pragma unroll 8
    for (int d = 0; d < 256; ++d) { const f32x4 w = *(const f32x4*)(wp + (size_t)d * (6 * D)); const int dd = rg * 256 + d;
        const float c0 = p.c[dd], c1 = p.c[D + dd], c2 = p.c[2 * D + dd], c3 = p.c[3 * D + dd];
        a0 += w * (c0 / (1.0f + __expf(-c0))); a1 += w * (c1 / (1.0f + __expf(-c1))); a2 += w * (c2 / (1.0f + __expf(-c2))); a3 += w * (c3 / (1.0f + __expf(-c3))); }
    float* pp = (float*)(p.ws + WS_MODP) + (size_t)(rg * 4) * (4 * D) + cc * 256 + lane * 4;
    *(f32x4*)(pp) = a0; *(f32x4*)(pp + 4 * D) = a1; *(f32x4*)(pp + 2 * 4 * D) = a2; *(f32x4*)(pp + 3 * 4 * D) = a3;
}
__device__ __forceinline__ void adaln_late_reduce(const Params& p, const Ctx& c) {
    const float* pp = (const float*)(p.ws + WS_MODP); float* mod = (float*)(p.ws + WS_MOD);
    for (int i = c.bid * NTHR + c.tid; i < 4 * 4 * D; i += c.nb * NTHR) { const int b = i / (4 * D), col = i % (4 * D); float s_ = p.b_ada[2 * D + col];
#pragma unroll
        for (int rg = 0; rg < 16; ++rg) s_ += pp[(size_t)(rg * 4 + b) * (4 * D) + col];
        mod[(size_t)b * 6 * D + 2 * D + col] = s_; }
}
__device__ __forceinline__ void convert_expert_rows(const Params& p, const Ctx& c, int r_first, int r_stride) {
    unsigned char* ws = p.ws;
        {
            typedef float v16f_t __attribute__((ext_vector_type(16))); typedef float v32f_t __attribute__((ext_vector_type(32))); typedef unsigned v6u_t __attribute__((ext_vector_type(6)));
            v16f_t pa, pb;
#pragma unroll
            for (int i = 0; i < 16; ++i) { pa[i] = (i < 8) ? 0.125f * i : 1.0f + 0.125f * (i - 8); pb[i] = (i < 8) ? 2.0f + 0.25f * i : 4.0f + 0.5f * (i - 8); }
            const v32f_t pd = __builtin_amdgcn_cvt_scalef32_pk32_f32_fp6(__builtin_amdgcn_cvt_scalef32_2xpk16_fp6_f32(pa, pb, 1.0f), 1.0f);
            const bool inter = (pd[1] == pb[0]);
            bool okl = true;
#pragma unroll
            for (int i = 0; i < 16; ++i) okl = okl && (inter ? (pd[2 * i] == pa[i] && pd[2 * i + 1] == pb[i]) : (pd[i] == pa[i] && pd[16 + i] == pb[i]));
            for (int r = r_first; r < 2 * P_EXP; r += r_stride) {
                const bool isv = r >= P_EXP; const int e = isv ? r - P_EXP : r;
                const float* src = (isv ? p.v_exp : p.u_exp) + (size_t)e * D;
                f32x4 v[16]; float mx = 0.f;
#pragma unroll
                for (int g = 0; g < 2; ++g)
#pragma unroll
                    for (int k = 0; k < 8; ++k) { v[g * 8 + k] = *(const f32x4*)(src + (g * 64 + c.lane) * 32 + k * 4);
                        mx = fmaxf(mx, fmaxf(fmaxf(fabsf(v[g * 8 + k].x), fabsf(v[g * 8 + k].y)), fmaxf(fabsf(v[g * 8 + k].z), fabsf(v[g * 8 + k].w)))); }
#pragma unroll
                for (int o = 1; o < 64; o <<= 1) mx = fmaxf(mx, __shfl_xor(mx, o));
                const float scale = (mx > 0.f) ? mx * (1.0f / 7.5f) : 1.0f; float inv = 1.0f / scale;
                if (!okl) inv = __builtin_nanf("");
                unsigned char* dst = ws + (isv ? WS_V8 : WS_U8) + (size_t)e * ROW6;
                v6u_t wq[2];
#pragma unroll
                for (int g = 0; g < 2; ++g) { v16f_t a, b;
#pragma unroll
                    for (int i = 0; i < 16; ++i) { const float ei = v[g * 8 + (2 * i) / 4][(2 * i) % 4], eo = v[g * 8 + (2 * i + 1) / 4][(2 * i + 1) % 4];
                        const float lo = v[g * 8 + i / 4][i % 4], hi = v[g * 8 + 4 + i / 4][i % 4];
                        a[i] = (inter ? ei : lo) * inv; b[i] = (inter ? eo : hi) * inv; }
                    wq[g] = __builtin_amdgcn_cvt_scalef32_2xpk16_fp6_f32(a, b, 1.0f); }
                *(v4u*)(dst + c.lane * 16) = (v4u){wq[0][0], wq[0][1], wq[0][2], wq[0][3]};
                *(v4u*)(dst + 1024 + c.lane * 16) = (v4u){wq[0][4], wq[0][5], wq[1][0], wq[1][1]};
                *(v4u*)(dst + 2048 + c.lane * 16) = (v4u){wq[1][2], wq[1][3], wq[1][4], wq[1][5]};
                if (c.lane == 0) ((float*)(ws + (isv ? WS_SV : WS_SU)))[e] = scale;
            }
        }
}

__device__ __forceinline__ void ph_prologue(const Params& p, const Ctx& c) {
    unsigned char* ws = p.ws;
    {
        float* mod = (float*)(ws + WS_MOD); LAS float* sc = (LAS float*)c.lds;
        LAS float* red = sc + 4 * D;
        for (int it = c.bid; it < 2 * D / 128; it += c.nb) {
            __syncthreads();
            for (int i = c.tid; i < 4 * D; i += NTHR) { const float v = p.c[i]; sc[i] = v / (1.0f + __expf(-v)); }
            __syncthreads();
            const int ct = c.tid & 31, dg = c.tid >> 5, e = it * 128 + ct * 4;
            f32x4 a0 = {0, 0, 0, 0}, a1 = a0, a2 = a0, a3 = a0;
            const float* wp = p.w_ada + (size_t)dg * (6 * D) + e;
#pragma unroll 8
            for (int i = 0; i < D / 16; ++i) { const f32x4 w = *(const f32x4*)(wp + (size_t)(16 * i) * (6 * D)); const int d = dg + 16 * i;
                a0 += w * sc[d]; a1 += w * sc[D + d]; a2 += w * sc[2 * D + d]; a3 += w * sc[3 * D + d]; }
            *(LAS f32x4*)(red + (dg * 4 + 0) * 128 + ct * 4) = a0; *(LAS f32x4*)(red + (dg * 4 + 1) * 128 + ct * 4) = a1;
            *(LAS f32x4*)(red + (dg * 4 + 2) * 128 + ct * 4) = a2; *(LAS f32x4*)(red + (dg * 4 + 3) * 128 + ct * 4) = a3;
            __syncthreads();
            { const int b = c.tid >> 7, col = c.tid & 127; float s = p.b_ada[it * 128 + col];
#pragma unroll
              for (int g = 0; g < 16; ++g) s += red[(g * 4 + b) * 128 + col];
              mod[(size_t)b * 6 * D + it * 128 + col] = s; }
        }
        __syncthreads();
    }
    {
        LAS float* scr = (LAS float*)(c.lds + c.wave * 8448);
        bf16* BT1 = (bf16*)(ws + WS_BT1); bf16* BT2 = (bf16*)(ws + WS_BT2);
        constexpr int I_IN = 64 * (IN_BF / 32), I_IN8 = 64 * ((IN_WIDTH - IN_BF) / 32), I_GATE = 64 * (2 * D / 32), I_UQ = 16 * (A_WIDTH / 32), I_QI = 16 * (IDX_H * IDX_D / 32), I_UV = 8 * (A_WIDTH / 32),
                      I_UVX = 0;
        constexpr int NITEMS = I_IN + I_IN8 + I_GATE + I_UQ + I_QI + I_UV + I_UVX;
        for (int it = c.gw; it < NITEMS; it += c.ngw) {
            int r = it;
            if (r < I_IN) { p0_transpose_item(p.w_in, D, IN_BF, BT1, 0, scr, r, c.lane, IN_WIDTH); continue; } r -= I_IN;
            if (r < I_IN8) { p0_transpose_item_f8(p.w_in + IN_BF, D, IN_WIDTH - IN_BF, ws + WS_W8IN, 1024.0f, scr, r, c.lane, IN_WIDTH); continue; } r -= I_IN8;
            if (r < I_GATE) { p0_transpose_item_f8(p.w_gate, D, 2 * D, ws + WS_G8, 1024.0f, scr, r, c.lane); continue; } r -= I_GATE;
            if (r < I_UQ) { p0_transpose_item(p.w_uq, A_QR, A_WIDTH, BT2, 0, scr, r, c.lane); continue; } r -= I_UQ;
            if (r < I_QI) { p0_transpose_item(p.w_qi, A_QR, IDX_H * IDX_D, BT2, A_WIDTH, scr, r, c.lane); continue; } r -= I_QI;
            p0_transpose_item(p.w_uv, A_KVR, A_WIDTH, (bf16*)(ws + WS_BTUV), 0, scr, r, c.lane);
        }
        const size_t gt = (size_t)c.bid * NTHR + c.tid, gs = (size_t)c.nb * NTHR;
        for (size_t i = gt; i < (size_t)(IN_PAD - IN_WIDTH) * D / 16; i += gs) *(v4u*)(ws + WS_W8IN + (size_t)(IN_WIDTH - IN_BF) * D + 16 * i) = (v4u){0u, 0u, 0u, 0u};
        p0_convert(p.w_uk, (bf16*)(ws + WS_WUK), (size_t)A_KVR * A_WIDTH, gt, gs);
        p0_convert(p.sub_keys, (bf16*)(ws + WS_SK), (size_t)2 * P_NK * 128, gt, gs);
    }
}

__device__ __forceinline__ void ph_modulate(const float* X, const float* g, const float* mod, int sh_off, int sc_off, bf16* H, unsigned char* H8, const Ctx& c) {
    for (int m = c.gw; m < T; m += c.ngw) {
        const int b = m / SEQ;
        const f32x4* xr = (const f32x4*)(X + (size_t)m * D) + c.lane;
        f32x4 v[16]; float s = 0.f;
#pragma unroll
        for (int j = 0; j < 16; ++j) { v[j] = xr[64 * j]; s += (v[j].x * v[j].x + v[j].y * v[j].y) + (v[j].z * v[j].z + v[j].w * v[j].w); }
        const float rstd = 1.0f / sqrtf(wave_sum(s) * (1.0f / D) + EPS);
        const f32x4* gp = (const f32x4*)g + c.lane; const f32x4* shp = (const f32x4*)(mod + (size_t)b * 6 * D + sh_off) + c.lane; const f32x4* scp = (const f32x4*)(mod + (size_t)b * 6 * D + sc_off) + c.lane;
        v2u* o = (v2u*)(H + (size_t)m * D) + c.lane;
#pragma unroll
        for (int j = 0; j < 16; ++j) { const f32x4 gg = gp[64 * j], sh = shp[64 * j], sc = scp[64 * j];
            const f32x4 y = (v[j] * rstd * gg) * (sc + 1.0f) + sh;
            v2u w; w.x = cvt_pk_bf16(y.x, y.y); w.y = cvt_pk_bf16(y.z, y.w); o[64 * j] = w;
            if (H8) { int q = 0; q = PK_FP8(y.x * 16.0f, y.y * 16.0f, q, false); q = PK_FP8(y.z * 16.0f, y.w * 16.0f, q, true); ((unsigned*)(H8 + (size_t)m * D))[c.lane + 64 * j] = (unsigned)q; } }
    }
}

__device__ __forceinline__ void ph_postproc(const Params& p, const Ctx& c) {
    bf16* P1 = (bf16*)(p.ws + WS_P1); float* WIDX = (float*)(p.ws + WS_WIDX);
    const int lane = c.lane;
    const float inv = exp2f(-(float)lane * (13.287712379549449f / 63.0f));
    for (int t = c.gw; t < T; t += c.ngw) {
        bf16* row = P1 + (size_t)t * N1;
        const int pos = t % SEQ;
        { v4u a = *(v4u*)(row + C_CQ + lane * 8), b = *(v4u*)(row + C_CQ + 512 + lane * 8);
          float f[16] = {bflo(a.x), bfhi(a.x), bflo(a.y), bfhi(a.y), bflo(a.z), bfhi(a.z), bflo(a.w), bfhi(a.w), bflo(b.x), bfhi(b.x), bflo(b.y), bfhi(b.y), bflo(b.z), bfhi(b.z), bflo(b.w), bfhi(b.w)};
          float s = 0.f;
#pragma unroll
          for (int j = 0; j < 16; ++j) s += f[j] * f[j];
          const float rstd = 1.0f / sqrtf(wave_sum(s) * (1.0f / A_QR) + EPS);
          const float* g0 = p.g_cq + lane * 8; const float* g1 = p.g_cq + 512 + lane * 8;
#pragma unroll
          for (int j = 0; j < 8; ++j) { f[j] *= rstd * g0[j]; f[8 + j] *= rstd * g1[j]; }
          a.x = cvt_pk_bf16(f[0], f[1]); a.y = cvt_pk_bf16(f[2], f[3]); a.z = cvt_pk_bf16(f[4], f[5]); a.w = cvt_pk_bf16(f[6], f[7]);
          b.x = cvt_pk_bf16(f[8], f[9]); b.y = cvt_pk_bf16(f[10], f[11]); b.z = cvt_pk_bf16(f[12], f[13]); b.w = cvt_pk_bf16(f[14], f[15]);
          *(v4u*)(row + C_CQ + lane * 8) = a; *(v4u*)(row + C_CQ + 512 + lane * 8) = b; }
        { v4u a = *(v4u*)(row + C_CKV + lane * 8);
          float f[8] = {bflo(a.x), bfhi(a.x), bflo(a.y), bfhi(a.y), bflo(a.z), bfhi(a.z), bflo(a.w), bfhi(a.w)};
          float s = 0.f;
#pragma unroll
          for (int j = 0; j < 8; ++j) s += f[j] * f[j];
          const float rstd = 1.0f / sqrtf(wave_sum(s) * (1.0f / A_KVR) + EPS);
          const float* g0 = p.g_ckv + lane * 8;
#pragma unroll
          for (int j = 0; j < 8; ++j) f[j] *= rstd * g0[j];
          a.x = cvt_pk_bf16(f[0], f[1]); a.y = cvt_pk_bf16(f[2], f[3]); a.z = cvt_pk_bf16(f[4], f[5]); a.w = cvt_pk_bf16(f[6], f[7]);
          *(v4u*)((bf16*)(p.ws + WS_CKV) + (size_t)t * A_KVR + lane * 8) = a; }
        { unsigned w = *(unsigned*)(row + C_KI + lane * 2); const float f0 = bflo(w), f1 = bfhi(w);
          const float mu = wave_sum(f0 + f1) * (1.0f / IDX_D); const float d0 = f0 - mu, d1 = f1 - mu;
          const float var = wave_sum(d0 * d0 + d1 * d1) * (1.0f / IDX_D); const float rstd = 1.0f / sqrtf(var + EPS);
          const float y0 = d0 * rstd * p.g_ki[lane * 2] + p.b_ki[lane * 2], y1 = d1 * rstd * p.g_ki[lane * 2 + 1] + p.b_ki[lane * 2 + 1];
          *(unsigned*)(row + C_KI + lane * 2) = cvt_pk_bf16(y0, y1); }
        WIDX[(size_t)t * IDX_H + lane] = bf2f(row[C_WI + lane]) * (0.125f * 0.08838834764831845f);
        { const float angf = (float)pos * inv; const double a = (double)angf; const double r = a - 6.283185307179586476925 * rint(a * 0.15915494309189533577);
          float sn, cs; __sincosf((float)r, &sn, &cs);
#pragma unroll
          for (int h = 0; h < R_HEADS; ++h) {
              bf16* q = row + C_RQ + h * 128; bf16* k = row + C_RK + h * 128;
              const float q1 = bf2f(q[lane]), q2 = bf2f(q[64 + lane]), k1 = bf2f(k[lane]) * 0.08838834764831845f, k2 = bf2f(k[64 + lane]) * 0.08838834764831845f;
              q[lane] = f2bf(q1 * cs - q2 * sn); q[64 + lane] = f2bf(q1 * sn + q2 * cs);
              k[lane] = f2bf(k1 * cs - k2 * sn); k[64 + lane] = f2bf(k1 * sn + k2 * cs); } }
    }
}

template <bool OUT8> __device__ __forceinline__ void lds_gemm_unit(const bf16* A, int lda, const bf16* Bt, int ldb, int K, void* C, int ldc, float s8, const Ctx& c) {
    constexpr int PB = 272; LAS unsigned char* As = c.lds; LAS unsigned char* Bs = c.lds + 256 * PB;
    const int tid = c.tid, lane = c.lane, wr = c.wave >> 1, wc = c.wave & 1, fr = lane & 15, fq = lane >> 4;
    f32x4 acc[4][4];
#pragma unroll
    for (int i = 0; i < 4; ++i)
#pragma unroll
        for (int j = 0; j < 4; ++j) acc[i][j] = (f32x4){0.f, 0.f, 0.f, 0.f};
    for (int k0 = 0; k0 < K; k0 += 128) {
        __syncthreads();
#pragma unroll
        for (int i = 0; i < 8; ++i) { const int q = tid + 512 * i, r = q >> 4, ch = q & 15; *(LAS v4u*)(As + r * PB + ch * 16) = *(const v4u*)(A + (size_t)r * lda + k0 + ch * 8); }
#pragma unroll
        for (int i = 0; i < 4; ++i) { const int q = tid + 512 * i, r = q >> 4, ch = q & 15; *(LAS v4u*)(Bs + r * PB + ch * 16) = *(const v4u*)(Bt + (size_t)r * ldb + k0 + ch * 8); }
        LDS_WAIT(); __syncthreads();
#pragma unroll
        for (int ks = 0; ks < 4; ++ks) { bf16x8 a[4], b[4];
#pragma unroll
            for (int i = 0; i < 4; ++i) { a[i] = *(const LAS bf16x8*)(As + (64 * wr + 16 * i + fr) * PB + ks * 64 + fq * 16); b[i] = *(const LAS bf16x8*)(Bs + (64 * wc + 16 * i + fr) * PB + ks * 64 + fq * 16); }
#pragma unroll
            for (int i = 0; i < 4; ++i)
#pragma unroll
                for (int j = 0; j < 4; ++j) acc[i][j] = __builtin_amdgcn_mfma_f32_16x16x32_bf16(b[j], a[i], acc[i][j], 0, 0, 0); }
    }
#pragma unroll
    for (int i = 0; i < 4; ++i)
#pragma unroll
        for (int j = 0; j < 4; ++j) { const size_t off = (size_t)(64 * wr + 16 * i + fr) * ldc + 64 * wc + 16 * j + 4 * fq;
            if constexpr (OUT8) { int q = 0; q = PK_FP8(acc[i][j][0] * s8, acc[i][j][1] * s8, q, false); q = PK_FP8(acc[i][j][2] * s8, acc[i][j][3] * s8, q, true); *(unsigned*)((unsigned char*)C + off) = (unsigned)q; }
            else { v2u w; w.x = cvt_pk_bf16(acc[i][j][0], acc[i][j][1]); w.y = cvt_pk_bf16(acc[i][j][2], acc[i][j][3]); *(v2u*)((bf16*)C + off) = w; } }
}
__device__ __forceinline__ void ph_qlat(const Params& p, const Ctx& c) {
    const bf16* Q2 = (const bf16*)(p.ws + WS_Q2); const bf16* WUK = (const bf16*)(p.ws + WS_WUK); bf16* QL = (bf16*)(p.ws + WS_QL);
    for (int u = c.bid; u < 16 * 32 * 4; u += c.nb) { const int h = u / 128, rem = u % 128, rt = rem / 4, ct = rem % 4;
        lds_gemm_unit<false>(Q2 + (size_t)(rt * 256) * N2 + h * 128, N2, WUK + (size_t)(ct * 128) * A_WIDTH + h * 128, A_WIDTH, 128, QL + (size_t)(rt * 256) * 8192 + h * 512 + ct * 128, 8192, 1.0f, c); }
    __syncthreads();
}
__device__ __forceinline__ void ph_oproj(const Params& p, const Ctx& c) {
    const bf16* OL = (const bf16*)(p.ws + WS_OLAT); const bf16* BTUV = (const bf16*)(p.ws + WS_BTUV); unsigned char* Y8 = p.ws + WS_YCAT;
    for (int u = c.bid; u < 16 * 32; u += c.nb) { const int h = u / 32, rt = u % 32;
        lds_gemm_unit<true>(OL + (size_t)(rt * 256) * 8192 + h * 512, 8192, BTUV + (size_t)(h * 128) * A_KVR, A_KVR, A_KVR, Y8 + (size_t)(rt * 256) * D + h * 128, D, 16.0f, c); }
    __syncthreads();
}

__device__ __forceinline__ void ph_scores(const Params& p, const Ctx& c) {
    const bf16* P1 = (const bf16*)(p.ws + WS_P1); const bf16* Q2 = (const bf16*)(p.ws + WS_Q2); const float* WIDX = (const float*)(p.ws + WS_WIDX); float* SC = (float*)(p.ws + WS_SC);
    constexpr int QPB = 272, QH = 32, QBYTES = QH * 16 * QPB;
    constexpr int WPB = 272; LAS unsigned char* wl = c.lds + QBYTES;
    const int tid = c.tid, lane = c.lane, w = c.wave, fr = lane & 15, fq = lane >> 4;
    for (int bu = c.bid; bu < NB * 64; bu += c.nb) {
        const int b = bu / 64, pr = bu % 64;
        for (int side = 0; side < 2; ++side) {
            const int qt = side ? 127 - pr : pr, nitems = qt / 4 + 1, t0 = b * SEQ + qt * 16;
            for (int half = 0; half < 2; ++half) {
                __syncthreads();
                if (half == 0 && tid < 256) { const int wq = tid >> 4, wc = tid & 15;
                    *(LAS f32x4*)(wl + wq * WPB + wc * 16) = *(const f32x4*)(WIDX + (size_t)(t0 + wq) * IDX_H + wc * 4); }
#pragma unroll
                for (int g = 0; g < 2; ++g) { v4u r[8];
#pragma unroll
                    for (int i = 0; i < 8; ++i) { const int q = tid + 512 * (g * 8 + i), hh = q >> 8, qq = (q >> 4) & 15, ch = q & 15;
                        r[i] = *(const v4u*)(Q2 + (size_t)(t0 + qq) * N2 + A_WIDTH + (half * QH + hh) * IDX_D + ch * 8); }
#pragma unroll
                    for (int i = 0; i < 8; ++i) { const int q = tid + 512 * (g * 8 + i);
                        *(LAS v4u*)(c.lds + (q >> 4) * QPB + (q & 15) * 16) = r[i]; } }
                LDS_WAIT(); __syncthreads();
                for (int item = w; item < nitems; item += 8) {
                    const int s0 = b * SEQ + item * 64;
                    bf16x8 kf[4][4];
#pragma unroll
                    for (int mi = 0; mi < 4; ++mi)
#pragma unroll
                        for (int ks = 0; ks < 4; ++ks) kf[mi][ks] = *(const bf16x8*)(P1 + (size_t)(s0 + 16 * mi + fr) * N1 + C_KI + 32 * ks + 8 * fq);
                    f32x4 sc[4];
                    float* scp = SC + (size_t)(t0 + fr) * SEQ + item * 64 + 4 * fq;
                    if (half) {
#pragma unroll
                        for (int mi = 0; mi < 4; ++mi) sc[mi] = *(const f32x4*)(scp + 16 * mi); }
                    else {
#pragma unroll
                        for (int mi = 0; mi < 4; ++mi) sc[mi] = (f32x4){0.f, 0.f, 0.f, 0.f}; }
                    __builtin_amdgcn_s_waitcnt(0x0F70);
                    const LAS unsigned char* wb = wl + fr * WPB + half * QH * 4;
                    const LAS unsigned char* qb = c.lds + fr * QPB + fq * 16;
#define SC_MM(A, hh) do { bf16x8 qf[4]; _Pragma("unroll") for (int ks = 0; ks < 4; ++ks) qf[ks] = *(const LAS bf16x8*)(buf + (hh) * 16 * QPB + ks * 64); \
                _Pragma("unroll") for (int mi = 0; mi < 4; ++mi) A[mi] = (f32x4){0.f, 0.f, 0.f, 0.f}; \
                _Pragma("unroll") for (int ks = 0; ks < 4; ++ks) _Pragma("unroll") for (int mi = 0; mi < 4; ++mi) A[mi] = __builtin_amdgcn_mfma_f32_16x16x32_bf16(kf[mi][ks], qf[ks], A[mi], 0, 0, 0); } while (0)
#define SC_EPI(A, hh) do { _Pragma("unroll") for (int mi = 0; mi < 4; ++mi) _Pragma("unroll") for (int j = 0; j < 4; ++j) sc[mi][j] += wv[hh] * __int_as_float(max(__float_as_int(A[mi][j]), 0)); } while (0)
#define SC_PIPE() do { _Pragma("unroll") for (int _q = 0; _q < 16; ++_q) { __builtin_amdgcn_sched_group_barrier(0x8, 1, 0); __builtin_amdgcn_sched_group_barrier(0x2, 2, 0); } } while (0)
                    for (int hg = 0; hg < QH / 4; ++hg) {
                        const LAS unsigned char* buf = qb + hg * 4 * 16 * QPB;
                        const f32x4 wv = *(const LAS f32x4*)(wb + hg * 16);
                        f32x4 a0[4], a1[4];
                        SC_MM(a0, 0);
                        SC_MM(a1, 1); SC_EPI(a0, 0); SC_PIPE();
                        SC_MM(a0, 2); SC_EPI(a1, 1); SC_PIPE();
                        SC_MM(a1, 3); SC_EPI(a0, 2); SC_PIPE();
                        SC_EPI(a1, 3);
                    }
#undef SC_MM
#undef SC_EPI
#undef SC_PIPE
#pragma unroll
                    for (int mi = 0; mi < 4; ++mi) *(f32x4*)(scp + 16 * mi) = sc[mi];
                }
            }
        }
    }
    __syncthreads();
}

__device__ __forceinline__ void ph_topk(const Params& p, const Ctx& c) {
    const float* SC = (const float*)(p.ws + WS_SC); int* SEL = (int*)(p.ws + WS_SEL); int* CNT = (int*)(p.ws + WS_CNT);
    const int lane = c.lane; const unsigned long long lt_mask = (1ull << lane) - 1ull;
    for (int t = c.gw; t < T; t += c.ngw) {
        const int pos = t % SEQ, qc = pos / CHUNK, nadm = (qc + 1) * CHUNK;
        int* so = SEL + (size_t)t * TOPK;
        if (nadm <= TOPK) { for (int i = lane; i < nadm; i += 64) so[i] = i; if (lane == 0) CNT[t] = nadm; continue; }
        unsigned key[32];
        const float* sr = SC + (size_t)t * SEQ;
#pragma unroll
        for (int j = 0; j < 32; ++j) { unsigned k = 0u; if (j <= qc) { const unsigned bits = __float_as_uint(sr[lane + 64 * j]); k = (bits & 0x80000000u) ? ~bits : (bits | 0x80000000u); } key[j] = k; }
        unsigned thr = 0u;
        for (int bit = 31; bit >= 0; --bit) { const unsigned cand = thr | (1u << bit); int cnt = 0;
#pragma unroll
            for (int j = 0; j < 32; ++j) cnt += __popcll(__ballot(key[j] >= cand));
            if (cnt >= TOPK) { thr = cand; if (cnt == TOPK) break; } }
        int ngt = 0;
#pragma unroll
        for (int j = 0; j < 32; ++j) ngt += __popcll(__ballot(key[j] > thr));
        const int need = TOPK - ngt; int base = 0, eqt = 0;
#pragma unroll
        for (int j = 0; j < 32; ++j) {
            const unsigned long long mg = __ballot(key[j] > thr), me = __ballot(key[j] == thr);
            const int erank = __popcll(me & lt_mask) + eqt; const bool esel = (key[j] == thr) && (erank < need);
            const unsigned long long ms = mg | __ballot(esel);
            if ((ms >> lane) & 1ull) so[base + __popcll(ms & lt_mask)] = lane + 64 * j;
            base += __popcll(ms); eqt += __popcll(me);
        }
        if (lane == 0) CNT[t] = TOPK;
    }
}

__device__ __forceinline__ int t5_bucket(int rel) {
    const int n = rel < 0 ? -rel : rel; int bk;
    if (n < 8) bk = n; else { const int n2 = n * n; int k = 0;
#pragma unroll
        for (int j = 1; j <= 7; ++j) k += (n2 >= (64 << j)) ? 1 : 0;
        bk = 8 + k; }
    return (rel > 0 ? 16 : 0) + bk;
}
__device__ __forceinline__ bf16x4 tr_read4(unsigned addr, int) { bf16x4 r; asm volatile("ds_read_b64_tr_b16 %0, %1\n\ts_waitcnt lgkmcnt(0)" : "=&v"(r) : "v"(addr) : "memory"); return r; }
#define TR_READ(dst, addr, OFF) asm volatile("ds_read_b64_tr_b16 %0, %1 offset:%2" : "=&v"(dst) : "v"(addr), "i"(OFF) : "memory")

constexpr int KV_PITCH = 1056;
constexpr int ATT_LDS_END = 8 * 16 * KV_PITCH + 64 + 2048;
__device__ __forceinline__ void ph_attn(const Params& p, const Ctx& c) {
    const bf16* CKV = (const bf16*)(p.ws + WS_CKV); const bf16* QL = (const bf16*)(p.ws + WS_QL); const int* SEL = (const int*)(p.ws + WS_SEL); const int* CNT = (const int*)(p.ws + WS_CNT);
    bf16* OL = (bf16*)(p.ws + WS_OLAT);
    const int lane = c.lane, fr = lane & 15, fq = lane >> 4;
    const int cw = c.wave & 3;
    LAS unsigned char* buf0 = c.lds + cw * (32 * KV_PITCH);
    const unsigned bufa = (unsigned)(size_t)buf0;
    const unsigned tr_base0 = bufa + (unsigned)((4 * fq + (fr >> 2)) * KV_PITCH + (fr & 3) * 8);
    const float t5b_scale = 0.08838834764831845f;
    LAS float* t5l = (LAS float*)(c.lds + 8 * 16 * KV_PITCH + 64);
    unsigned* ctl = (unsigned*)(p.ws + WS_CTL);
    LAS unsigned* xm = (LAS unsigned*)(c.lds + 8 * 16 * KV_PITCH);
    if (c.tid == 0) { const unsigned x = xb_xcc_id(); unsigned pre = 0, tot = 0;
        for (unsigned j = 0; j < 16; ++j) { const unsigned n = xb_ld(&ctl[XB_XCNT(j)]); pre += (j < x) ? n : 0u; tot += n; }
        const bool ok = (tot == (unsigned)c.nb) && (T % (c.nb * 4) == 0);
        unsigned rk = 0; if (ok) rk = xb_add(&ctl[XB_ATT_RANK + 64 * x], 1u);
        xm[0] = ok ? (pre + rk) : 0xffffffffu; }
    t5l[c.tid] = p.t5[c.tid];
    __syncthreads();
    const unsigned vbx = xm[0]; const bool xmap = (vbx != 0xffffffffu);
    const int naw = c.nb * 4;
    if (c.wave >= 4) { for (int it = c.bid * 4 + (c.wave - 4); it < 1024; it += naw) adaln_late(p, it, c.lane); convert_late_weights(p, (LAS float*)(c.lds + ATT_LDS_END + (c.wave - 4) * 4224), c.lane, c.bid * 4 + (c.wave - 4), naw); convert_expert_rows(p, c, c.bid * 4 + (c.wave - 4), naw); }
    if (c.wave < 4)
    for (int it = c.bid * 4 + cw; it < T; it += naw) {
        int t = it;
        if (xmap) { const int base = (int)vbx * 4 + cw;
            const int bsz = naw / NB, q = it / naw;
            t = (base / bsz) * SEQ + (base % bsz) + q * bsz; }
        const int b = t / SEQ, pos = t % SEQ;
        const int cnt = CNT[t];
        int s0 = 0, s1 = 0, s2 = 0, s3 = 0;
        if (lane < cnt) s0 = SEL[(size_t)t * TOPK + lane];
        if (lane + 64 < cnt) s1 = SEL[(size_t)t * TOPK + 64 + lane];
        if (lane + 128 < cnt) s2 = SEL[(size_t)t * TOPK + 128 + lane];
        if (lane + 192 < cnt) s3 = SEL[(size_t)t * TOPK + 192 + lane];
        const bf16* kvb = CKV + (size_t)(b * SEQ) * A_KVR + lane * 8;
        const int nch = cnt >> 4;
#define ATT_GATHER(ch_) do { const int _c = (ch_); const int _sj = (_c < 4) ? s0 : (_c < 8) ? s1 : (_c < 12) ? s2 : s3; const int _lb = (_c & 3) * 16; \
            LAS unsigned char* _b = buf0 + (_c & 1) * (16 * KV_PITCH); \
            _Pragma("unroll") for (int r = 0; r < 16; ++r) { const int idx = __builtin_amdgcn_readlane(_sj, _lb + r); \
                __builtin_amdgcn_global_load_lds((const unsigned*)(kvb + (size_t)idx * A_KVR), (LAS unsigned*)(_b + r * KV_PITCH), 16, 0, 0); } } while (0)
        ATT_GATHER(0);
        bf16x8 qf[16];
#pragma unroll
        for (int ks = 0; ks < 16; ++ks) qf[ks] = *(const bf16x8*)(QL + (size_t)t * 8192 + fr * 512 + ks * 32 + fq * 8);
        f32x4 acc[32];
#pragma unroll
        for (int mt = 0; mt < 32; ++mt) acc[mt] = (f32x4){0.f, 0.f, 0.f, 0.f};
        float m_run = -INFINITY, l_run = 0.f;
        float bias[4];
#define ATT_BIAS(ch_) do { const int _c = (ch_); const int _sj = (_c < 4) ? s0 : (_c < 8) ? s1 : (_c < 12) ? s2 : s3; const int _lb = (_c & 3) * 16; \
            _Pragma("unroll") for (int j = 0; j < 4; ++j) { const int kidx = __shfl(_sj, _lb + 4 * fq + j); bias[j] = t5l[t5_bucket(kidx - pos) * A_HEADS + fr]; } } while (0)
        for (int ch = 0; ch < nch; ++ch) {
            ATT_BIAS(ch);
            if (ch + 1 < nch) { ATT_GATHER(ch + 1); asm volatile("s_waitcnt vmcnt(16)" ::: "memory"); } else { asm volatile("s_waitcnt vmcnt(0)" ::: "memory"); }
            LAS unsigned char* buf = buf0 + (ch & 1) * (16 * KV_PITCH);
            const unsigned tr_base = tr_base0 + (unsigned)((ch & 1) * (16 * KV_PITCH));
            f32x4 sa = {0.f, 0.f, 0.f, 0.f}, sb = sa;
#pragma unroll
            for (int ks = 0; ks < 16; ks += 2) {
                const bf16x8 a0 = *(const LAS bf16x8*)(buf + fr * KV_PITCH + (ks + 0) * 64 + fq * 16), a1 = *(const LAS bf16x8*)(buf + fr * KV_PITCH + (ks + 1) * 64 + fq * 16);
                sa = __builtin_amdgcn_mfma_f32_16x16x32_bf16(a0, qf[ks + 0], sa, 0, 0, 0); sb = __builtin_amdgcn_mfma_f32_16x16x32_bf16(a1, qf[ks + 1], sb, 0, 0, 0); }
            const f32x4 s = sa + sb;
            float lg[4]; float mc = -INFINITY;
#pragma unroll
            for (int j = 0; j < 4; ++j) { lg[j] = s[j] * t5b_scale + bias[j]; mc = fmaxf(mc, lg[j]); }
            mc = fmaxf(mc, __shfl_xor(mc, 16)); mc = fmaxf(mc, __shfl_xor(mc, 32));
            if (__ballot(mc > m_run + 8.0f)) { const float m_new = fmaxf(m_run, mc); const float alpha = __expf(m_run - m_new); l_run *= alpha; m_run = m_new;
#pragma unroll
                for (int mt = 0; mt < 32; ++mt) acc[mt] *= alpha; }
            float pe[4]; float ps = 0.f;
#pragma unroll
            for (int j = 0; j < 4; ++j) { pe[j] = __expf(lg[j] - m_run); ps += pe[j]; }
            l_run += ps;
            v2u pw; pw.x = cvt_pk_bf16(pe[0], pe[1]); pw.y = cvt_pk_bf16(pe[2], pe[3]);
            const unsigned qx = (unsigned)__shfl_xor((int)pw.x, 32), qy = (unsigned)__shfl_xor((int)pw.y, 32);
            const bool lowg = fq < 2;
            const v4u pb4 = lowg ? (v4u){pw.x, pw.y, qx, qy} : (v4u){0u, 0u, 0u, 0u};
            const bf16x8 pb = __builtin_bit_cast(bf16x8, pb4);
            const unsigned tr2 = tr_base + (unsigned)((lowg ? 8 : -8) * KV_PITCH);
            bf16x4 ta[2], tb[2], ua[2], ub[2];
#define ATT_TR(d1, d2, g) do { _Pragma("unroll") for (int i = 0; i < 2; ++i) { TR_READ(d1[i], tr_base, ((g) * 2 + i) * 32); TR_READ(d2[i], tr2, ((g) * 2 + i) * 32); } } while (0)
#define ATT_MM(s1, s2, g) do { _Pragma("unroll") for (int i = 0; i < 2; ++i) acc[(g) * 2 + i] = __builtin_amdgcn_mfma_f32_16x16x32_bf16(__builtin_shufflevector(s1[i], s2[i], 0, 1, 2, 3, 4, 5, 6, 7), pb, acc[(g) * 2 + i], 0, 0, 0); } while (0)
            ATT_TR(ta, ua, 0);
#pragma unroll
            for (int g = 0; g < 16; g += 2) {
                ATT_TR(tb, ub, g + 1);
                asm volatile("s_waitcnt lgkmcnt(4)" : "+v"(ta[0]), "+v"(ta[1]), "+v"(ua[0]), "+v"(ua[1]) :: "memory");
                ATT_MM(ta, ua, g);
                if (g + 2 < 16) ATT_TR(ta, ua, g + 2);
                if (g + 2 < 16) asm volatile("s_waitcnt lgkmcnt(4)" : "+v"(tb[0]), "+v"(tb[1]), "+v"(ub[0]), "+v"(ub[1]) :: "memory");
                else asm volatile("s_waitcnt lgkmcnt(0)" : "+v"(tb[0]), "+v"(tb[1]), "+v"(ub[0]), "+v"(ub[1]) :: "memory");
                ATT_MM(tb, ub, g + 1);
            }
#undef ATT_TR
#undef ATT_MM
            asm volatile("" ::: "memory");
        }
#undef ATT_BIAS
#undef ATT_GATHER
        float lt = l_run; lt += __shfl_xor(lt, 16); lt += __shfl_xor(lt, 32);
        const float il = 1.0f / lt;
        bf16* orow = OL + (size_t)t * 8192 + fr * 512 + 4 * fq;
#pragma unroll
        for (int mt = 0; mt < 32; ++mt) { v2u w; w.x = cvt_pk_bf16(acc[mt][0] * il, acc[mt][1] * il); w.y = cvt_pk_bf16(acc[mt][2] * il, acc[mt][3] * il); *(v2u*)(orow + 16 * mt) = w; }
    }
    __syncthreads();
}

#define TR_PAIR(dst, addr, PITCH4) do { bf16x4 _lo, _hi; \
    asm volatile("ds_read_b64_tr_b16 %0, %2\n\tds_read_b64_tr_b16 %1, %2 offset:%3\n\ts_waitcnt lgkmcnt(0)" : "=&v"(_lo), "=&v"(_hi) : "v"(addr), "i"(PITCH4) : "memory"); \
    dst = __builtin_shufflevector(_lo, _hi, 0, 1, 2, 3, 4, 5, 6, 7); } while (0)

constexpr size_t WS_SN = 1464 * MiB;
__device__ __forceinline__ void ph_ret_state(const Params& p, const Ctx& c) {
    const bf16* P1 = (const bf16*)(p.ws + WS_P1); bf16* SN = (bf16*)(p.ws + WS_SN);
    constexpr int KPB = 272, VPB = 80;
    LAS unsigned char* ktb = c.lds; LAS unsigned char* vtb = c.lds + 2 * 64 * KPB;
    const int tid = c.tid, lane = c.lane, w = c.wave, fr = lane & 15, fq = lane >> 4;
    for (int u = c.bid; u < NB * R_HEADS * 8; u += c.nb) {
        const int b = u / 64, h = (u / 8) % 8, vsl = u % 8;
        const float gam = 1.0f - exp2f(-5.0f - (float)h), lgm = logf(gam), dec64 = __expf(64.0f * lgm);
        f32x4 acc[2] = {{0.f, 0.f, 0.f, 0.f}, {0.f, 0.f, 0.f, 0.f}};
        const int kr0 = tid >> 4, kc0 = tid & 15;
        const int vr = tid >> 2, vc = tid & 3;
        const bf16* kbase = P1 + (size_t)(b * SEQ) * N1 + C_RK + h * 128 + kc0 * 8;
        const bf16* vbase = P1 + (size_t)(b * SEQ) * N1 + C_RV + h * 256 + vsl * 32 + vc * 8;
        const float sc0 = __expf((float)(63 - kr0) * lgm), sc1 = __expf((float)(31 - kr0) * lgm);
        v4u ka, kb, va = {0u, 0u, 0u, 0u};
        ka = *(const v4u*)(kbase + (size_t)kr0 * N1); kb = *(const v4u*)(kbase + (size_t)(kr0 + 32) * N1); if (tid < 256) va = *(const v4u*)(vbase + (size_t)vr * N1);
        __syncthreads();
        for (int n = 0; n < SEQ / CHUNK; ++n) {
            LAS unsigned char* kt = ktb + (n & 1) * 64 * KPB; LAS unsigned char* vt = vtb + (n & 1) * 64 * VPB;
            { v4u o; o.x = cvt_pk_bf16(bflo(ka.x) * sc0, bfhi(ka.x) * sc0); o.y = cvt_pk_bf16(bflo(ka.y) * sc0, bfhi(ka.y) * sc0); o.z = cvt_pk_bf16(bflo(ka.z) * sc0, bfhi(ka.z) * sc0); o.w = cvt_pk_bf16(bflo(ka.w) * sc0, bfhi(ka.w) * sc0);
              *(LAS v4u*)(kt + kr0 * KPB + kc0 * 16) = o;
              o.x = cvt_pk_bf16(bflo(kb.x) * sc1, bfhi(kb.x) * sc1); o.y = cvt_pk_bf16(bflo(kb.y) * sc1, bfhi(kb.y) * sc1); o.z = cvt_pk_bf16(bflo(kb.z) * sc1, bfhi(kb.z) * sc1); o.w = cvt_pk_bf16(bflo(kb.w) * sc1, bfhi(kb.w) * sc1);
              *(LAS v4u*)(kt + (kr0 + 32) * KPB + kc0 * 16) = o;
              if (tid < 256) *(LAS v4u*)(vt + vr * VPB + vc * 16) = va; }
            if (n + 1 < SEQ / CHUNK) { const size_t ro = (size_t)((n + 1) * CHUNK) * N1;
                ka = *(const v4u*)(kbase + ro + (size_t)kr0 * N1); kb = *(const v4u*)(kbase + ro + (size_t)(kr0 + 32) * N1); if (tid < 256) va = *(const v4u*)(vbase + ro + (size_t)vr * N1); }
            { bf16* sp = SN + ((size_t)((b * R_HEADS + h) * 32 + n) * 256 + vsl * 32 + fr) * 128 + 16 * w + 4 * fq;
#pragma unroll
              for (int nt = 0; nt < 2; ++nt) { v2u o; o.x = cvt_pk_bf16(acc[nt][0], acc[nt][1]); o.y = cvt_pk_bf16(acc[nt][2], acc[nt][3]); *(v2u*)(sp + (size_t)(16 * nt) * 128) = o; acc[nt] *= dec64; } }
            LDS_WAIT(); __syncthreads();
            const unsigned ka_addr = (unsigned)(size_t)kt + (unsigned)((8 * fq + (fr >> 2)) * KPB + (16 * w + 4 * (fr & 3)) * 2);
            const unsigned va_addr = (unsigned)(size_t)vt + (unsigned)((8 * fq + (fr >> 2)) * VPB + (4 * (fr & 3)) * 2);
#pragma unroll
            for (int ks = 0; ks < 2; ++ks) { bf16x8 af, b0, b1;
                TR_PAIR(af, ka_addr + ks * 32 * KPB, 4 * KPB); TR_PAIR(b0, va_addr + ks * 32 * VPB, 4 * VPB); TR_PAIR(b1, va_addr + ks * 32 * VPB + 32, 4 * VPB);
                acc[0] = __builtin_amdgcn_mfma_f32_16x16x32_bf16(af, b0, acc[0], 0, 0, 0); acc[1] = __builtin_amdgcn_mfma_f32_16x16x32_bf16(af, b1, acc[1], 0, 0, 0); }
        }
        __syncthreads();
    }
}
__device__ __forceinline__ void ph_ret_out(const Params& p, const Ctx& c) {
    const bf16* P1 = (const bf16*)(p.ws + WS_P1); const bf16* SN = (const bf16*)(p.ws + WS_SN); unsigned char* Y8 = p.ws + WS_YCAT;
    constexpr int QPB = 272, VPB = 528, APB = 144;
    LAS unsigned char* qt = c.lds; LAS unsigned char* kt = qt + 64 * QPB; LAS unsigned char* vt = kt + 64 * QPB; LAS unsigned char* at = vt + 64 * VPB;
    LAS float* red = (LAS float*)(at + 64 * APB);
    const int tid = c.tid, lane = c.lane, w = c.wave, fr = lane & 15, fq = lane >> 4;
    for (int u = c.bid; u < NB * 32 * R_HEADS; u += c.nb) {
        const int b = u / 256, n = (u / 8) % 32, h = u % 8;
        const float gam = 1.0f - exp2f(-5.0f - (float)h), lgm = logf(gam);
        const size_t t0 = (size_t)b * SEQ + n * CHUNK;
        __syncthreads();
        for (int i = tid; i < 64 * 16; i += NTHR) { const int l = i >> 4, ch = i & 15;
            *(LAS v4u*)(qt + l * QPB + ch * 16) = *(const v4u*)(P1 + (t0 + l) * N1 + C_RQ + h * 128 + ch * 8);
            *(LAS v4u*)(kt + l * QPB + ch * 16) = *(const v4u*)(P1 + (t0 + l) * N1 + C_RK + h * 128 + ch * 8); }
        for (int i = tid; i < 64 * 32; i += NTHR) { const int l = i >> 5, ch = i & 31; *(LAS v4u*)(vt + l * VPB + ch * 16) = *(const v4u*)(P1 + (t0 + l) * N1 + C_RV + h * 256 + ch * 8); }
        __syncthreads();
        { const int pt = w & 3, lt0 = 2 * (w >> 2);
          f32x4 a0 = {0.f, 0.f, 0.f, 0.f}, a1 = a0;
#pragma unroll
          for (int ks = 0; ks < 4; ++ks) { const bf16x8 qf = *(const LAS bf16x8*)(qt + (16 * pt + fr) * QPB + ks * 64 + fq * 16);
              const bf16x8 k0 = *(const LAS bf16x8*)(kt + (16 * lt0 + fr) * QPB + ks * 64 + fq * 16), k1 = *(const LAS bf16x8*)(kt + (16 * lt0 + 16 + fr) * QPB + ks * 64 + fq * 16);
              a0 = __builtin_amdgcn_mfma_f32_16x16x32_bf16(k0, qf, a0, 0, 0, 0); a1 = __builtin_amdgcn_mfma_f32_16x16x32_bf16(k1, qf, a1, 0, 0, 0); }
          const int pos = 16 * pt + fr;
#pragma unroll
          for (int j = 0; j < 4; ++j) { const int l0 = 16 * lt0 + 4 * fq + j, l1 = l0 + 16;
              a0[j] = (pos >= l0) ? a0[j] * __expf((float)(pos - l0) * lgm) : 0.f; a1[j] = (pos >= l1) ? a1[j] * __expf((float)(pos - l1) * lgm) : 0.f; }
          v2u o; o.x = cvt_pk_bf16(a0[0], a0[1]); o.y = cvt_pk_bf16(a0[2], a0[3]); *(LAS v2u*)(at + pos * APB + (16 * lt0 + 4 * fq) * 2) = o;
          o.x = cvt_pk_bf16(a1[0], a1[1]); o.y = cvt_pk_bf16(a1[2], a1[3]); *(LAS v2u*)(at + pos * APB + (16 * lt0 + 16 + 4 * fq) * 2) = o; }
        f32x4 acc[2][4];
#pragma unroll
        for (int mi = 0; mi < 2; ++mi)
#pragma unroll
            for (int pt = 0; pt < 4; ++pt) acc[mi][pt] = (f32x4){0.f, 0.f, 0.f, 0.f};
        { const bf16* sp = SN + ((size_t)((b * R_HEADS + h) * 32 + n) * 256 + 32 * w + fr) * 128 + 8 * fq;
#pragma unroll
          for (int ks = 0; ks < 4; ++ks) { const bf16x8 s0 = *(const bf16x8*)(sp + ks * 32), s1 = *(const bf16x8*)(sp + 16 * 128 + ks * 32);
#pragma unroll
              for (int pt = 0; pt < 4; ++pt) { const bf16x8 qf = *(const LAS bf16x8*)(qt + (16 * pt + fr) * QPB + ks * 64 + fq * 16);
                  acc[0][pt] = __builtin_amdgcn_mfma_f32_16x16x32_bf16(s0, qf, acc[0][pt], 0, 0, 0); acc[1][pt] = __builtin_amdgcn_mfma_f32_16x16x32_bf16(s1, qf, acc[1][pt], 0, 0, 0); } } }
#pragma unroll
        for (int pt = 0; pt < 4; ++pt) { const float dq = __expf((float)(16 * pt + fr + 1) * lgm); acc[0][pt] *= dq; acc[1][pt] *= dq; }
        LDS_WAIT(); __syncthreads();
        { const unsigned v_addr = (unsigned)(size_t)vt + (unsigned)((8 * fq + (fr >> 2)) * VPB + (32 * w + 4 * (fr & 3)) * 2);
#pragma unroll
          for (int ks = 0; ks < 2; ++ks) { bf16x8 v0, v1; TR_PAIR(v0, v_addr + ks * 32 * VPB, 4 * VPB); TR_PAIR(v1, v_addr + ks * 32 * VPB + 32, 4 * VPB);
#pragma unroll
              for (int pt = 0; pt < 4; ++pt) { const bf16x8 af = *(const LAS bf16x8*)(at + (16 * pt + fr) * APB + ks * 64 + fq * 16);
                  acc[0][pt] = __builtin_amdgcn_mfma_f32_16x16x32_bf16(v0, af, acc[0][pt], 0, 0, 0); acc[1][pt] = __builtin_amdgcn_mfma_f32_16x16x32_bf16(v1, af, acc[1][pt], 0, 0, 0); } } }
#pragma unroll
        for (int pt = 0; pt < 4; ++pt) { float s = 0.f;
#pragma unroll
            for (int mi = 0; mi < 2; ++mi)
#pragma unroll
                for (int j = 0; j < 4; ++j) s += acc[mi][pt][j] * acc[mi][pt][j];
            s += __shfl_xor(s, 16); s += __shfl_xor(s, 32);
            if (lane < 16) red[w * 64 + 16 * pt + lane] = s; }
        LDS_WAIT(); __syncthreads();
#pragma unroll
        for (int pt = 0; pt < 4; ++pt) { const int pos = 16 * pt + fr; float ss = 0.f;
#pragma unroll
            for (int ww = 0; ww < 8; ++ww) ss += red[ww * 64 + pos];
            const float rstd = 1.0f / sqrtf(ss * (1.0f / R_V) + EPS);
#pragma unroll
            for (int mi = 0; mi < 2; ++mi) { const int dv = 32 * w + 16 * mi + 4 * fq;
                const f32x4 g = *(const f32x4*)(p.g_ret + h * 256 + dv);
                const v2u rg = *(const v2u*)(P1 + (t0 + pos) * N1 + C_RG + h * 256 + dv);
                const float r0 = bflo(rg.x), r1 = bfhi(rg.x), r2 = bflo(rg.y), r3 = bfhi(rg.y);
                const float rs = rstd * 16.0f; int q = 0;
                q = PK_FP8(r0 * sigmoidf_(r0) * acc[mi][pt][0] * rs * g.x, r1 * sigmoidf_(r1) * acc[mi][pt][1] * rs * g.y, q, false);
                q = PK_FP8(r2 * sigmoidf_(r2) * acc[mi][pt][2] * rs * g.z, r3 * sigmoidf_(r3) * acc[mi][pt][3] * rs * g.w, q, true);
                *(unsigned*)(Y8 + (t0 + pos) * D + A_WIDTH + h * 256 + dv) = (unsigned)q; } }
    }
    __syncthreads();
}

__device__ __forceinline__ unsigned fkey(float f) { const unsigned b = __float_as_uint(f); return (b & 0x80000000u) ? ~b : (b | 0x80000000u); }
typedef __bf16 bf16x2_r __attribute__((ext_vector_type(2)));
template <int NV> __device__ __forceinline__ unsigned tok_thr16(const unsigned (&k)[NV]) {
    unsigned thr = 0u; bool done = false;
    for (int bit = 31; bit >= 0; --bit) { const unsigned cand = thr | (1u << bit); int cnt = 0;
#pragma unroll
        for (int i = 0; i < NV; ++i) cnt += (k[i] >= cand) ? 1 : 0;
        cnt += __shfl_xor(cnt, 16); cnt += __shfl_xor(cnt, 32);
        if (!done && cnt >= P_TOPK) { thr = cand; done = (cnt == P_TOPK); }
        if (!__ballot(!done)) break; }
    return thr;
}
__device__ __forceinline__ void ph_peer_route(const Params& p, const Ctx& c) {
    const bf16* PQ = (const bf16*)(p.ws + WS_PQ); const bf16* SK = (const bf16*)(p.ws + WS_SK); int* EID = (int*)(p.ws + WS_EID); float* GATE = (float*)(p.ws + WS_GATE);
    constexpr int KP = 272;
    LAS unsigned char* sk = c.lds;
    LAS float* wl = (LAS float*)(c.lds + 2 * 128 * KP) + c.wave * 1536;
    LAS float* v1l = wl; LAS int* i1l = (LAS int*)(wl + 256); LAS float* v2l = wl + 512; LAS int* i2l = (LAS int*)(wl + 768); LAS float* tvl = wl + 1024; LAS int* tel = (LAS int*)(wl + 1280);
    const int lane = c.lane, fr = lane & 15, fq = lane >> 4;
    __syncthreads();
    for (int i = c.tid; i < 2 * 128 * 16; i += NTHR) { const int r = i >> 4, ch = i & 15; *(LAS v4u*)(sk + r * KP + ch * 16) = *(const v4u*)(SK + r * 128 + ch * 8); }
    __syncthreads();
    for (int u = c.gw; u < (T / 16) * P_HEADS; u += c.ngw) {
        const int tgp = u / P_HEADS, h = u % P_HEADS, t = tgp * 16 + fr;
        unsigned ka[32], kb[32]; float sva[32], svb[32];
#pragma unroll
        for (int half = 0; half < 2; ++half) {
            f32x4 acc[8];
#pragma unroll
            for (int mt = 0; mt < 8; ++mt) acc[mt] = (f32x4){0.f, 0.f, 0.f, 0.f};
#pragma unroll
            for (int ks = 0; ks < 4; ++ks) { const bf16x8 qf = *(const bf16x8*)(PQ + (size_t)t * 2048 + h * 256 + half * 128 + ks * 32 + fq * 8);
#pragma unroll
                for (int mt = 0; mt < 8; ++mt) { const bf16x8 kf = *(const LAS bf16x8*)(sk + (half * 128 + 16 * mt + fr) * KP + ks * 64 + fq * 16); acc[mt] = __builtin_amdgcn_mfma_f32_16x16x32_bf16(kf, qf, acc[mt], 0, 0, 0); } }
#pragma unroll
            for (int mt = 0; mt < 8; ++mt)
#pragma unroll
                for (int j = 0; j < 4; ++j) { if (half == 0) { sva[mt * 4 + j] = acc[mt][j]; ka[mt * 4 + j] = fkey(acc[mt][j]); } else { svb[mt * 4 + j] = acc[mt][j]; kb[mt * 4 + j] = fkey(acc[mt][j]); } }
        }
#define ROUTE_EMIT(K, V, NV, thr, VL, IL, IDX) do { int ngl = 0, nel = 0; \
            _Pragma("unroll") for (int i = 0; i < NV; ++i) { ngl += (K[i] > thr) ? 1 : 0; nel += (K[i] == thr) ? 1 : 0; } \
            int pg = 0, pe = 0, ngt = 0; \
            _Pragma("unroll") for (int q = 0; q < 4; ++q) { const int cg = __shfl(ngl, fr + 16 * q), ce = __shfl(nel, fr + 16 * q); pg += (q < fq) ? cg : 0; pe += (q < fq) ? ce : 0; ngt += cg; } \
            const int need = P_TOPK - ngt; \
            _Pragma("unroll") for (int i = 0; i < NV; ++i) { int slot = -1; \
                if (K[i] > thr) { slot = pg; ++pg; } else if (K[i] == thr) { if (pe < need) slot = ngt + pe; ++pe; } \
                if (slot >= 0) { VL[fr * 16 + slot] = V[i]; IL[fr * 16 + slot] = IDX(i); } } } while (0)
#define KEYIDX(i) (16 * ((i) >> 2) + 4 * fq + ((i) & 3))
        { const unsigned ta = tok_thr16<32>(ka); ROUTE_EMIT(ka, sva, 32, ta, v1l, i1l, KEYIDX);
          const unsigned tb = tok_thr16<32>(kb); ROUTE_EMIT(kb, svb, 32, tb, v2l, i2l, KEYIDX); }
        LDS_WAIT();
        float cd[64]; unsigned ck[64];
        { const f32x4 va = *(const LAS f32x4*)(v1l + fr * 16 + 4 * fq);
#pragma unroll
          for (int bq = 0; bq < 4; ++bq) { const f32x4 vb = *(const LAS f32x4*)(v2l + fr * 16 + 4 * bq);
#pragma unroll
              for (int ai = 0; ai < 4; ++ai)
#pragma unroll
                  for (int bj = 0; bj < 4; ++bj) { const float v = va[ai] + vb[bj]; cd[ai * 16 + bq * 4 + bj] = v; ck[ai * 16 + bq * 4 + bj] = fkey(v); } } }
#define CANDEID(i) (i1l[fr * 16 + 4 * fq + ((i) >> 4)] * P_NK + i2l[fr * 16 + ((i) & 15)])
        { const unsigned tc = tok_thr16<64>(ck); ROUTE_EMIT(ck, cd, 64, tc, tvl, tel, CANDEID); }
#undef ROUTE_EMIT
#undef KEYIDX
#undef CANDEID
        LDS_WAIT();
        { const f32x4 tv = *(const LAS f32x4*)(tvl + fr * 16 + 4 * fq); const v4u te = *(const LAS v4u*)(tel + fr * 16 + 4 * fq);
          float mx = fmaxf(fmaxf(tv[0], tv[1]), fmaxf(tv[2], tv[3])); mx = fmaxf(mx, __shfl_xor(mx, 16)); mx = fmaxf(mx, __shfl_xor(mx, 32));
          f32x4 e; float sm = 0.f;
#pragma unroll
          for (int j = 0; j < 4; ++j) { e[j] = __expf(tv[j] - mx); sm += e[j]; }
          sm += __shfl_xor(sm, 16); sm += __shfl_xor(sm, 32);
          const float inv = 1.0f / sm;
          *(v4u*)(EID + (size_t)t * 128 + h * 16 + 4 * fq) = te; *(f32x4*)(GATE + (size_t)t * 128 + h * 16 + 4 * fq) = e * inv; }
        LDS_WAIT();
    }
    __syncthreads();
}
typedef __bf16 bf16x2_t __attribute__((ext_vector_type(2)));
typedef float v32f_t __attribute__((ext_vector_type(32))); typedef unsigned v6u_t __attribute__((ext_vector_type(6))); typedef __bf16 v32bf_t __attribute__((ext_vector_type(32)));
typedef unsigned v16u_t __attribute__((ext_vector_type(16)));
__device__ __forceinline__ void ld48(const unsigned char* ptr, v6u_t& w0, v6u_t& w1) { const v4u a = *(const v4u*)ptr, b = *(const v4u*)(ptr + 1024), c = *(const v4u*)(ptr + 2048);
    w0 = (v6u_t){a.x, a.y, a.z, a.w, b.x, b.y}; w1 = (v6u_t){b.z, b.w, c.x, c.y, c.z, c.w}; }
#ifndef PG
#define PG 2
#endif
__device__ __forceinline__ void ph_peer_experts(const Params& p, const Ctx& c) {
    const bf16* H = (const bf16*)(p.ws + WS_H); const unsigned char* U8 = p.ws + WS_U8; const unsigned char* V8 = p.ws + WS_V8;
    const float* SU = (const float*)(p.ws + WS_SU); const float* SV = (const float*)(p.ws + WS_SV);
    const int* EID = (const int*)(p.ws + WS_EID); const float* GATE = (const float*)(p.ws + WS_GATE); const float* mod = (const float*)(p.ws + WS_MOD);
    const int lane = c.lane;
    for (int t = c.gw; t < T; t += c.ngw) {
        const int b = t / SEQ;
        unsigned xp[32];
#pragma unroll
        for (int g = 0; g < 2; ++g)
#pragma unroll
            for (int k = 0; k < 4; ++k) { const v4u a = *(const v4u*)(H + (size_t)t * D + (g * 64 + lane) * 32 + k * 8); xp[g * 16 + k * 4 + 0] = a.x; xp[g * 16 + k * 4 + 1] = a.y; xp[g * 16 + k * 4 + 2] = a.z; xp[g * 16 + k * 4 + 3] = a.w; }
        const int e0 = EID[(size_t)t * 128 + lane], e1 = EID[(size_t)t * 128 + 64 + lane];
        const float g0 = GATE[(size_t)t * 128 + lane], g1 = GATE[(size_t)t * 128 + 64 + lane];
        f32x2 acc[32];
#pragma unroll
        for (int i = 0; i < 32; ++i) acc[i] = (f32x2){0.f, 0.f};
        for (int pg = 0; pg < 32; ++pg) {
            const int esel = (pg < 16) ? e0 : e1; const float gsel = (pg < 16) ? g0 : g1; const int lb = (pg & 15) * 4;
            int e[4]; float cf[4]; v6u_t w[4][2];
#pragma unroll
            for (int j = 0; j < 4; ++j) { e[j] = __builtin_amdgcn_readlane(esel, lb + j); const unsigned char* ur = U8 + (size_t)e[j] * ROW6 + lane * 16;
                ld48(ur, w[j][0], w[j][1]); }
#pragma unroll
            for (int j = 0; j < 4; ++j) { float d = 0.f;
#pragma unroll
                for (int g = 0; g < 2; ++g) { const v16u_t ub = __builtin_bit_cast(v16u_t, __builtin_amdgcn_cvt_scalef32_pk32_bf16_fp6(w[j][g], 1.0f));
#pragma unroll
                    for (int k = 0; k < 16; ++k) asm("v_dot2c_f32_bf16 %0, %1, %2" : "+v"(d) : "v"(ub[k]), "v"(xp[g * 16 + k])); }
                cf[j] = d; }
#pragma unroll
            for (int o = 1; o < 64; o <<= 1) { cf[0] += __shfl_xor(cf[0], o); cf[1] += __shfl_xor(cf[1], o); cf[2] += __shfl_xor(cf[2], o); cf[3] += __shfl_xor(cf[3], o); }
#pragma unroll
            for (int j = 0; j < 4; ++j) { const unsigned char* vr = V8 + (size_t)e[j] * ROW6 + lane * 16;
                ld48(vr, w[j][0], w[j][1]);
                const float d = cf[j] * SU[e[j]]; const float g = __shfl(gsel, lb + j);
                cf[j] = g * 0.5f * d * (1.0f + erff(d * 0.70710678118654752f)) * SV[e[j]]; }
#pragma unroll
            for (int j = 0; j < 4; ++j) { const f32x2 c2 = {cf[j], cf[j]};
#pragma unroll
                for (int g = 0; g < 2; ++g) { const v32f_t vf = __builtin_amdgcn_cvt_scalef32_pk32_f32_fp6(w[j][g], 1.0f);
#pragma unroll
                    for (int k = 0; k < 16; ++k) acc[g * 16 + k] = __builtin_elementwise_fma((f32x2){vf[2 * k], vf[2 * k + 1]}, c2, acc[g * 16 + k]); } }
        }
        int lo32 = lane * 32; asm volatile("" : "+v"(lo32));
        float* orow = p.out + (size_t)t * D; const float* gt = mod + (size_t)b * 6 * D + 5 * D; float ss = 0.f;
#pragma unroll
        for (int g = 0; g < 2; ++g)
#pragma unroll
            for (int k = 0; k < 8; ++k) { const int col = g * 2048 + lo32 + k * 4; const f32x4 xa = *(const f32x4*)(orow + col), ga = *(const f32x4*)(gt + col);
                f32x2& a0 = acc[g * 16 + 2 * k]; f32x2& a1 = acc[g * 16 + 2 * k + 1];
                a0.x = xa.x + ga.x * a0.x; a0.y = xa.y + ga.y * a0.y; a1.x = xa.z + ga.z * a1.x; a1.y = xa.w + ga.w * a1.y;
                ss += (a0.x * a0.x + a0.y * a0.y) + (a1.x * a1.x + a1.y * a1.y); }
        const float rstd = 1.0f / sqrtf(wave_sum(ss) * (1.0f / D) + EPS);
#pragma unroll
        for (int g = 0; g < 2; ++g)
#pragma unroll
            for (int k = 0; k < 8; ++k) { const int col = g * 2048 + lo32 + k * 4; const f32x4 ga = *(const f32x4*)(p.g_final + col); const f32x2 a0 = acc[g * 16 + 2 * k], a1 = acc[g * 16 + 2 * k + 1];
                *(f32x4*)(orow + col) = (f32x4){a0.x * rstd * ga.x, a0.y * rstd * ga.y, a1.x * rstd * ga.z, a1.y * rstd * ga.w}; }
    }
}

constexpr int N_PHASES = 19;
__global__ void __launch_bounds__(NTHR, 2) fwd_kernel(Params p) {
    extern __shared__ __attribute__((aligned(16))) unsigned char lds_raw[];
    Ctx c; c.lds = (LAS unsigned char*)lds_raw; c.tid = threadIdx.x; c.lane = c.tid & 63; c.wave = __builtin_amdgcn_readfirstlane(c.tid >> 6);
    c.bid = blockIdx.x; c.nb = gridDim.x; c.gw = c.bid * NWAVES + c.wave; c.ngw = c.nb * NWAVES;
    volatile LAS unsigned* MISC = (volatile LAS unsigned*)(c.lds + MISC_OFF);
    if (c.tid < 64) MISC[c.tid] = 0u;
    __syncthreads();
    const int lo = p.ph_lo, hi = p.ph_hi;
    XcdBarrier bar; bar.bar = (unsigned*)(p.ws + WS_CTL); bar.x = 0; bar.st = nullptr;
    if (hi - lo > 1) bar = xcd_barrier_post((unsigned*)(p.ws + WS_CTL), MISC + 8);
#define IN(k) (lo <= (k) && (k) < hi)
#define SEAM(k) do { if (IN(k) && IN((k) + 1)) xcd_barrier(bar); } while (0)
    unsigned char* ws = p.ws;
    const float* mod = (const float*)(ws + WS_MOD);
    if (IN(0)) { ph_prologue(p, c); } SEAM(0);
    if (IN(1)) { ph_modulate(p.x, p.g_mix, mod, 0 * D, 1 * D, (bf16*)(ws + WS_H), ws + WS_H8, c); } SEAM(1);
    if (IN(2)) {
        { pg8::Gemm g{(const bf16*)(ws + WS_H), (const bf16*)(ws + WS_BT1), T, IN_BF, D, D, D}; pg8::StaticOrder S; S.init(T, IN_BF, c.nb, c.bid);
          pg8::EpiB<0> E{(bf16*)(ws + WS_P1), nullptr, nullptr, nullptr, N1, 0, 1.0f, 0.f};
          pg8::gemm_phase<pg8::EpiB<0>, pg8::StaticOrder, true, true>(c.lds, g, S, E); }
        { pg8::Gemm g{(const bf16*)(ws + WS_H8), (const bf16*)(ws + WS_W8IN), T, IN_PAD - IN_BF, D / 2, D / 2, D / 2}; pg8::StaticOrder S; S.init(T, IN_PAD - IN_BF, c.nb, c.bid);
          pg8::EpiB<0> E{(bf16*)(ws + WS_P1) + IN_BF, nullptr, nullptr, nullptr, N1, 0, 1.0f / 16384.0f, 0.f};
          pg8::gemm_phase<pg8::EpiB<0>, pg8::StaticOrder, true, true, true>(c.lds, g, S, E); }
        { pg8::Gemm g{(const bf16*)(ws + WS_H8), (const bf16*)(ws + WS_G8), T, 2 * D, D / 2, D / 2, D / 2}; pg8::StaticOrder S; S.init(T, 2 * D, c.nb, c.bid);
          pg8::EpiGate E{(bf16*)(ws + WS_P1) + C_GA, N1, p.b_gate, 1.0f / 16384.0f};
          pg8::gemm_phase<pg8::EpiGate, pg8::StaticOrder, true, true, true>(c.lds, g, S, E); }
    } SEAM(2);
    if (IN(3)) { ph_postproc(p, c); } SEAM(3);
    if (IN(4)) { pg8::Gemm g{(const bf16*)(ws + WS_P1) + C_CQ, (const bf16*)(ws + WS_BT2), T, N2, A_QR, N1, A_QR}; pg8::StaticOrder S; S.init(T, N2, c.nb, c.bid);
        pg8::EpiB<0> E{(bf16*)(ws + WS_Q2), nullptr, nullptr, nullptr, N2, 0, 1.0f, 0.f};
        pg8::gemm_phase<pg8::EpiB<0>, pg8::StaticOrder, true, true>(c.lds, g, S, E); } SEAM(4);
    if (IN(5)) { ph_ret_state(p, c); ph_qlat(p, c); } SEAM(5);
    if (IN(6)) { ph_scores(p, c); } SEAM(6);
    if (IN(7)) { ph_topk(p, c); } SEAM(7);
    if (IN(8)) { ph_attn(p, c); } SEAM(8);
    if (IN(9)) { adaln_late_reduce(p, c); ph_oproj(p, c); ph_ret_out(p, c); } SEAM(9);
    if (IN(12)) { pg8::Gemm g{(const bf16*)(ws + WS_YCAT), (const bf16*)(ws + WS_BTUP), T, D, A_WIDTH / 2, D / 2, D / 2}; pg8::StaticOrder S; S.init(T, D, c.nb, c.bid);
        pg8::EpiB<2> E{(bf16*)(ws + WS_MERGED), nullptr, nullptr, (const bf16*)(ws + WS_P1) + C_GA, D, N1, 1.0f / 16384.0f, 0.f};
        pg8::gemm_phase<pg8::EpiB<2>, pg8::StaticOrder, true, true, true>(c.lds, g, S, E); }
    if (IN(12) && IN(13)) { VM_WAIT(); __syncthreads(); }
    if (IN(13)) { pg8::Gemm g{(const bf16*)(ws + WS_YCAT + A_WIDTH), (const bf16*)(ws + WS_BTUP + A_WIDTH), T, D, R_W / 2, D / 2, D / 2}; pg8::StaticOrder S; S.init(T, D, c.nb, c.bid);
        pg8::EpiB<3> E{(bf16*)(ws + WS_MERGED), ws + WS_MERGED8, nullptr, (const bf16*)(ws + WS_P1) + C_GR, D, N1, 1.0f / 16384.0f, 64.0f};
        pg8::gemm_phase<pg8::EpiB<3>, pg8::StaticOrder, true, true, true>(c.lds, g, S, E); } SEAM(13);
    if (IN(14)) { pg8::Gemm g{(const bf16*)(ws + WS_MERGED8), (const bf16*)(ws + WS_BTOUT), T, D, D / 2, D / 2, D / 2}; pg8::StaticOrder S; S.init(T, D, c.nb, c.bid);
        pg8::EpiRes E{p.x, p.out, D, mod + 2 * D, 6 * D, 1.0f / 65536.0f};
        pg8::gemm_phase<pg8::EpiRes, pg8::StaticOrder, true, true, true>(c.lds, g, S, E); } SEAM(14);
    if (IN(15)) { ph_modulate(p.out, p.g_ffn, mod, 3 * D, 4 * D, (bf16*)(ws + WS_H), nullptr, c); } SEAM(15);
    if (IN(16)) { pg8::Gemm g{(const bf16*)(ws + WS_H), (const bf16*)(ws + WS_BTPQ), T, 2048, D, D, D}; pg8::StaticOrder S; S.init(T, 2048, c.nb, c.bid);
        pg8::EpiB<0> E{(bf16*)(ws + WS_PQ), nullptr, nullptr, nullptr, 2048, 0, 1.0f, 0.f};
        pg8::gemm_phase<pg8::EpiB<0>, pg8::StaticOrder, true, true>(c.lds, g, S, E); } SEAM(16);
    if (IN(17)) { ph_peer_route(p, c); } SEAM(17);
    if (IN(18)) { ph_peer_experts(p, c); }
#undef IN
#undef SEAM
}

#ifdef DBG_STOP
__device__ __forceinline__ float dsan(float v) { return (v - v == 0.0f) ? v : 777.0f; }
__global__ void dump_kernel(Params p, int k) {
    unsigned char* ws = p.ws; const size_t n = (size_t)T * D;
    for (size_t i = (size_t)blockIdx.x * blockDim.x + threadIdx.x; i < n; i += (size_t)gridDim.x * blockDim.x) {
        float v = 0.f;
        if (k == 0) { v = ((const float*)(ws + WS_MOD))[i % 98304] + bf2f(((const bf16*)(ws + WS_BT1))[i] ) + bf2f(((const bf16*)(ws + WS_BT1))[(i + n) % 66060288])
                + bf2f(((const bf16*)(ws + WS_BT2))[i % 10485760]) + bf2f(((const bf16*)(ws + WS_WUK))[i % 1048576]) + bf2f(((const bf16*)(ws + WS_BTUV))[i % 1048576])
                + bf2f(((const bf16*)(ws + WS_BTUP))[i % 16777216]) + bf2f(((const bf16*)(ws + WS_BTOUT))[i % 16777216]) + bf2f(((const bf16*)(ws + WS_BTPQ))[i % 8388608])
                + bf2f(((const bf16*)(ws + WS_SK))[i % 32768]) + (float)(ws + WS_U8)[i] + (float)(ws + WS_V8)[i]; }
        else if (k == 1 || k == 15) v = bf2f(((const bf16*)(ws + WS_H))[i]);
        else if (k == 2 || k == 3) { const bf16* P = (const bf16*)(ws + WS_P1); v = bf2f(P[i]) + bf2f(P[i + n]) + bf2f(P[i + 2 * n]) + bf2f(P[(i + 3 * n) % 132120576]) + ((const float*)(ws + WS_WIDX))[i % 524288] * (k == 3 ? 1.f : 0.f); }
        else if (k == 4) { const bf16* P = (const bf16*)(ws + WS_Q2); v = bf2f(P[i]) + bf2f(P[i + n]) + bf2f(P[(i + 2 * n) % 83886080]); }
        else if (k == 5) { const bf16* P = (const bf16*)(ws + WS_QL); v = bf2f(P[i]) + bf2f(P[i + n]); }
        else if (k == 6) { const size_t j = i % ((size_t)T * SEQ); const int t = (int)(j / SEQ), s = (int)(j % SEQ); v = (s < (((t % SEQ) / 64) + 1) * 64) ? ((const float*)(ws + WS_SC))[j] : 0.f; }
        else if (k == 7) { const size_t j = i % ((size_t)T * TOPK); const int t = (int)(j / TOPK), s = (int)(j % TOPK); const int cnt = ((const int*)(ws + WS_CNT))[t]; v = (s < cnt) ? (float)((const int*)(ws + WS_SEL))[j] : (float)cnt; }
        else if (k == 8) { const bf16* P = (const bf16*)(ws + WS_OLAT); v = bf2f(P[i]) + bf2f(P[i + n]); }
        else if (k == 9) { v = (float)(ws + WS_YCAT)[(i / 2048) * 4096 + (i % 2048)]; }
        else if (k == 10) { v = ((const float*)(ws + WS_SC))[i % ((size_t)T * 2048)]; }
        else if (k == 11) { v = (float)(ws + WS_YCAT)[i]; }
        else if (k == 12 || k == 13) { v = bf2f(((const bf16*)(ws + WS_MERGED))[i]); }
        else if (k == 14 || k == 18) { v = p.out[i]; }
        else if (k == 16) { v = bf2f(((const bf16*)(ws + WS_PQ))[i % ((size_t)T * 2048)]); }
        else if (k == 17) { v = (float)((const int*)(ws + WS_EID))[i % ((size_t)T * 128)] + ((const float*)(ws + WS_GATE))[i % ((size_t)T * 128)]; }
        p.out[i] = dsan(v);
    }
}
#endif

#ifndef MK_SINGLE
#define MK_SINGLE 1
#endif
extern "C" void kernel_launch(void* const* d_in, const int* in_sizes, int n_in, void* d_out, int out_size, void* d_ws, size_t ws_size, hipStream_t stream) {
    static int grid = 0;
    if (grid == 0) {
        if (n_in != 26 || in_sizes[0] != T * D || out_size != T * D || ws_size < WS_END) { fprintf(stderr, "kernel_launch: unexpected shapes (n_in %d, in0 %d, out %d, ws %zu < %zu)\n", n_in, n_in > 0 ? in_sizes[0] : -1, out_size, ws_size, (size_t)WS_END); grid = -1; return; }
        int dev = 0, cus = 0, per_cu = 0;
        if (hipGetDevice(&dev) != hipSuccess || hipDeviceGetAttribute(&cus, hipDeviceAttributeMultiprocessorCount, dev) != hipSuccess) { grid = -1; return; }
        if (hipFuncSetAttribute((const void*)fwd_kernel, hipFuncAttributeMaxDynamicSharedMemorySize, LDS_BYTES) != hipSuccess) { fprintf(stderr, "kernel_launch: hipFuncSetAttribute failed\n"); grid = -1; return; }
        if (hipOccupancyMaxActiveBlocksPerMultiprocessor(&per_cu, (const void*)fwd_kernel, NTHR, LDS_BYTES) != hipSuccess || per_cu < 1) { fprintf(stderr, "kernel_launch: occupancy query reports %d blocks per CU\n", per_cu); }
        (void)hipGetLastError();
        grid = cus;
    }
    if (grid < 0) return;
    (void)hipMemsetAsync((char*)d_ws + WS_CTL, 0, CTL_ZERO_BYTES, stream);
    Params p{};
    const float** pf = (const float**)&p;
    for (int i = 0; i < 26; ++i) pf[i] = (const float*)d_in[i];
    p.out = (float*)d_out; p.ws = (unsigned char*)d_ws;
#ifdef DBG_STOP
    for (int ph = 0; ph <= DBG_STOP; ++ph) { p.ph_lo = ph; p.ph_hi = ph + 1; hipLaunchKernelGGL(fwd_kernel, dim3(grid), dim3(NTHR), LDS_BYTES, stream, p); }
    p.ph_lo = 0; p.ph_hi = 0;
    hipLaunchKernelGGL(dump_kernel, dim3(2048), dim3(256), 0, stream, p, (int)DBG_STOP);
#elif MK_SINGLE
    p.ph_lo = 0; p.ph_hi = N_PHASES;
    hipLaunchKernelGGL(fwd_kernel, dim3(grid), dim3(NTHR), LDS_BYTES, stream, p);
#else
    for (int ph = 0; ph < N_PHASES; ++ph) { p.ph_lo = ph; p.ph_hi = ph + 1; hipLaunchKernelGGL(fwd_kernel, dim3(grid), dim3(NTHR), LDS_BYTES, stream, p);
#ifdef REP_MASK
        if ((REP_MASK >> ph) & 1) hipLaunchKernelGGL(fwd_kernel, dim3(grid), dim3(NTHR), LDS_BYTES, stream, p);
#endif
    }
#endif
}
```

```cpp
#include <hip/hip_runtime.h>
#include <cstdio>
#include <cstdint>

#define GAS __attribute__((address_space(1)))
#define LAS __attribute__((address_space(3)))
typedef unsigned short bf16;
typedef unsigned v4u __attribute__((ext_vector_type(4)));
typedef unsigned v2u __attribute__((ext_vector_type(2)));
typedef float f32x4 __attribute__((ext_vector_type(4)));
typedef float f32x2 __attribute__((ext_vector_type(2)));
typedef short bf16x8 __attribute__((ext_vector_type(8)));
typedef short bf16x4 __attribute__((ext_vector_type(4)));

constexpr int D = 4096, NB = 4, SEQ = 2048, T = NB * SEQ;
constexpr int CHUNK = 64;
constexpr float EPS = 1e-6f;
constexpr int A_HEADS = 16, A_HD = 128, A_QR = 1024, A_KVR = 512, A_WIDTH = 2048;
constexpr int IDX_H = 64, IDX_D = 128, TOPK = 256;
constexpr int R_HEADS = 8, R_QK = 128, R_V = 256, R_QKW = 1024, R_W = 2048;
constexpr int P_HEADS = 8, P_QD = 256, P_NK = 128, P_TOPK = 16, P_EXP = 16384;
constexpr int IN_WIDTH = 7872, IN_PAD = 7936, IN_BF = 1792;
constexpr int N1 = IN_PAD + 2 * D;
constexpr int N2 = A_WIDTH + IDX_H * IDX_D;
constexpr int C_CQ = 0, C_CKV = 1024, C_KI = 1536, C_WI = 1664, C_RQ = 1728, C_RK = 2752, C_RV = 3776, C_RG = 5824, C_GA = IN_PAD, C_GR = IN_PAD + D;

__device__ __forceinline__ float bf2f(bf16 h) { return __uint_as_float(((unsigned)h) << 16); }
__device__ __forceinline__ float bflo(unsigned w) { return __uint_as_float(w << 16); }
__device__ __forceinline__ float bfhi(unsigned w) { return __uint_as_float(w & 0xffff0000u); }
typedef __bf16 bf16v2_t __attribute__((ext_vector_type(2)));
__device__ __forceinline__ unsigned cvt_pk_bf16(float lo, float hi) { const bf16v2_t v = __builtin_convertvector((f32x2){lo, hi}, bf16v2_t); return __builtin_bit_cast(unsigned, v); }
__device__ __forceinline__ bf16 f2bf(float f) { return (bf16)(cvt_pk_bf16(f, 0.f) & 0xffffu); }
__device__ __forceinline__ float wave_sum(float v) {
#pragma unroll
    for (int o = 1; o < 64; o <<= 1) v += __shfl_xor(v, o);
    return v;
}
#define PK_FP8(a, b, old, hi) __builtin_amdgcn_cvt_pk_fp8_f32(__builtin_amdgcn_fmed3f((a), -448.0f, 448.0f), __builtin_amdgcn_fmed3f((b), -448.0f, 448.0f), (old), (hi))
__device__ __forceinline__ float sigmoidf_(float v) { return 1.0f / (1.0f + __expf(-v)); }

namespace pg8 {
#define PG8_LAS __attribute__((address_space(3)))
typedef unsigned short bf16_t;
typedef unsigned u32x4 __attribute__((ext_vector_type(4)));
constexpr int BM = 256, BK = 64, HALF = 128, HTB = HALF * BK * 2  , STAGE_BYTES = 8 * HTB, NXCD = 8, WGM = 8;

__host__ __device__ __forceinline__ int lds_byte(int r, int c) { const int st = (r >> 4) * 2 + (c >> 5), rr = r & 15, cc = c & 31, ob = rr * 64 + cc * 2; return st * 1024 + (ob ^ (((ob >> 9) & 1) << 5)); }
__host__ __device__ __forceinline__ void stage_rc(int b, int& R, int& C) { const int st = b / 1024, sb = b % 1024, swz = sb ^ (((sb >> 9) & 1) << 5); R = (st >> 1) * 16 + swz / 64; C = (st & 1) * 32 + (swz % 64) / 2; }
__host__ __device__ __forceinline__ int perm32(int rho) { const int n = rho >> 4, i = rho & 15; return 8 * (i >> 2) + 4 * n + (i & 3); }

struct Unit { int pm, pn; };
struct Gemm { const bf16_t* A; const bf16_t* Bt; int M, N, K, lda, ldb; };

struct StaticOrder {
    int nM, nN, nwg, G, c;
    __host__ __device__ void init(int M, int N, int G_, int c_) { nM = M / BM; nN = N / BM; nwg = nM * nN; G = G_; c = c_; }
    __host__ __device__ bool next(int i, Unit& u) const {
        const long L = (long)i * G + c; if (L >= nwg) return false;
        int wgid = (int)L; { const int q = nwg / NXCD, r = nwg % NXCD, xcd = wgid % NXCD, off = wgid / NXCD; wgid = (xcd < r ? xcd * (q + 1) : r * (q + 1) + (xcd - r) * q) + off; }
        const int nig = WGM * nN, gid = wgid / nig, fm = gid * WGM, gsz = (nM - fm) < WGM ? (nM - fm) : WGM;
        u.pm = fm + ((wgid % nig) % gsz); u.pn = (wgid % nig) / gsz; return true;
    }
    __device__ __forceinline__ void a_ready(const Unit&) const {}
    __device__ __forceinline__ void done(const Unit&) const {}
};

template <int MODE> struct EpiB {
    static constexpr bool PERM = true, AFTER_DRAIN = false;
    bf16_t* O; unsigned char* O8; const float* bias; const bf16_t* gate; int ldc, ldg; float scale, scale8;
    __device__ __forceinline__ void operator()(const f32x4 (&acc)[2][2][4][2], const Unit& u, int wr, int wc, int fr, int fq) const {
        const int row0 = u.pm * BM + wr * 64 + fr; const int col0 = u.pn * BM + wc * 32 + 8 * fq;
        const bool gates = (MODE == 1) && (u.pn >= 31);
        f32x4 bv[2][2];
#pragma unroll
        for (int bj = 0; bj < 2; ++bj)
#pragma unroll
            for (int n = 0; n < 2; ++n) bv[bj][n] = gates ? *(const f32x4*)(bias + (col0 - 31 * BM) + bj * HALF + 4 * n) : (f32x4){0.f, 0.f, 0.f, 0.f};
#pragma unroll
        for (int ai = 0; ai < 2; ++ai)
#pragma unroll
            for (int m = 0; m < 4; ++m) { const size_t r = (size_t)(row0 + ai * HALF + m * 16); bf16_t* rowp = O + r * ldc + col0;
#pragma unroll
                for (int bj = 0; bj < 2; ++bj) { f32x4 v0 = acc[ai][bj][m][0] * scale, v1 = acc[ai][bj][m][1] * scale;
                    if (MODE == 1) { if (gates) { v0 = v0 + bv[bj][0]; v1 = v1 + bv[bj][1];
#pragma unroll
                            for (int j = 0; j < 4; ++j) { v0[j] = sigmoidf_(v0[j]); v1[j] = sigmoidf_(v1[j]); } } }
                    if (MODE == 2 || MODE == 3) { const u32x4 gw = *(const u32x4*)(gate + r * ldg + col0 + bj * HALF);
                        v0[0] *= bflo(gw.x); v0[1] *= bfhi(gw.x); v0[2] *= bflo(gw.y); v0[3] *= bfhi(gw.y); v1[0] *= bflo(gw.z); v1[1] *= bfhi(gw.z); v1[2] *= bflo(gw.w); v1[3] *= bfhi(gw.w); }
                    if (MODE == 3) { const u32x4 pw = *(const u32x4*)(rowp + bj * HALF);
                        v0[0] += bflo(pw.x); v0[1] += bfhi(pw.x); v0[2] += bflo(pw.y); v0[3] += bfhi(pw.y); v1[0] += bflo(pw.z); v1[1] += bfhi(pw.z); v1[2] += bflo(pw.w); v1[3] += bfhi(pw.w); }
                    u32x4 w; w.x = cvt_pk_bf16(v0[0], v0[1]); w.y = cvt_pk_bf16(v0[2], v0[3]); w.z = cvt_pk_bf16(v1[0], v1[1]); w.w = cvt_pk_bf16(v1[2], v1[3]);
                    *(u32x4*)(rowp + bj * HALF) = w;
                    if (MODE == 3) { int q0 = 0, q1 = 0; q0 = PK_FP8(v0[0] * scale8, v0[1] * scale8, q0, false); q0 = PK_FP8(v0[2] * scale8, v0[3] * scale8, q0, true);
                        q1 = PK_FP8(v1[0] * scale8, v1[1] * scale8, q1, false); q1 = PK_FP8(v1[2] * scale8, v1[3] * scale8, q1, true);
                        *(v2u*)(O8 + r * ldc + col0 + bj * HALF) = (v2u){(unsigned)q0, (unsigned)q1}; } } }
    }
};
typedef int v8i_t __attribute__((ext_vector_type(8)));
typedef int v4i_t __attribute__((ext_vector_type(4)));
__device__ __forceinline__ v8i_t f8cat(const bf16x8 lo, const bf16x8 hi) { const v4i_t a = __builtin_bit_cast(v4i_t, lo), b = __builtin_bit_cast(v4i_t, hi); return __builtin_shufflevector(a, b, 0, 1, 2, 3, 4, 5, 6, 7); }
struct EpiGate {
    static constexpr bool PERM = true, AFTER_DRAIN = false;
    bf16_t* O; int ldc; const float* bias; float scale;
    __device__ __forceinline__ void operator()(const f32x4 (&acc)[2][2][4][2], const Unit& u, int wr, int wc, int fr, int fq) const {
        const int row0 = u.pm * BM + wr * 64 + fr; const int col0 = u.pn * BM + wc * 32 + 8 * fq;
        f32x4 bv[2][2];
#pragma unroll
        for (int bj = 0; bj < 2; ++bj)
#pragma unroll
            for (int n = 0; n < 2; ++n) bv[bj][n] = *(const f32x4*)(bias + col0 + bj * HALF + 4 * n);
#pragma unroll
        for (int ai = 0; ai < 2; ++ai)
#pragma unroll
            for (int m = 0; m < 4; ++m) { bf16_t* rowp = O + (size_t)(row0 + ai * HALF + m * 16) * ldc + col0;
#pragma unroll
                for (int bj = 0; bj < 2; ++bj) { f32x4 v0 = acc[ai][bj][m][0] * scale + bv[bj][0], v1 = acc[ai][bj][m][1] * scale + bv[bj][1];
#pragma unroll
                    for (int j = 0; j < 4; ++j) { v0[j] = sigmoidf_(v0[j]); v1[j] = sigmoidf_(v1[j]); }
                    u32x4 w; w.x = cvt_pk_bf16(v0[0], v0[1]); w.y = cvt_pk_bf16(v0[2], v0[3]); w.z = cvt_pk_bf16(v1[0], v1[1]); w.w = cvt_pk_bf16(v1[2], v1[3]);
                    *(u32x4*)(rowp + bj * HALF) = w; } }
    }
};
struct EpiRes {
    static constexpr bool PERM = false, AFTER_DRAIN = false;
    const float* X; float* O; int ldc; const float* gt; int ldgt; float scale;
    __device__ __forceinline__ void operator()(const f32x4 (&acc)[2][2][4][2], const Unit& u, int wr, int wc, int fr, int fq) const {
        const int row0 = u.pm * BM + wr * 64 + fr, col0 = u.pn * BM + wc * 32 + 4 * fq;
        const float* g = gt + (size_t)(u.pm / (SEQ / BM)) * ldgt;
        f32x4 gv[2][2];
#pragma unroll
        for (int bj = 0; bj < 2; ++bj)
#pragma unroll
            for (int n = 0; n < 2; ++n) gv[bj][n] = *(const f32x4*)(g + col0 + bj * HALF + n * 16);
#pragma unroll
        for (int ai = 0; ai < 2; ++ai)
#pragma unroll
            for (int m = 0; m < 4; ++m) { const size_t off = (size_t)(row0 + ai * HALF + m * 16) * ldc + col0;
#pragma unroll
                for (int bj = 0; bj < 2; ++bj)
#pragma unroll
                    for (int n = 0; n < 2; ++n) { const f32x4 xv = *(const f32x4*)(X + off + bj * HALF + n * 16); *(f32x4*)(O + off + bj * HALF + n * 16) = xv + gv[bj][n] * (acc[ai][bj][m][n] * scale); } }
    }
};

template <class Epi, class Sched, bool ALIGN_EPI = false, bool SP2 = false, bool F8 = false>
__device__ __forceinline__ void gemm_phase(PG8_LAS unsigned char* lds, const Gemm g, const Sched& S, const Epi& E) {
    const int tid = threadIdx.x, wid = __builtin_amdgcn_readfirstlane(tid >> 6), lane = tid & 63, wr = wid >> 2, wc = wid & 3, fr = lane & 15, fq = lane >> 4;
    const int K = g.K, nt = K / BK;
    unsigned voffA[2], voffB[2];
#pragma unroll
    for (int i = 0; i < 2; ++i) { int R, C; stage_rc(tid * 16 + i * 8192, R, C); const int Rb = Epi::PERM ? ((R & ~31) + perm32(R & 31)) : R;
        voffA[i] = (unsigned)(R * g.lda + C) * 2u; voffB[i] = (unsigned)(Rb * g.ldb + C) * 2u; }
    const size_t kstep = (size_t)(BK * 2);
    const size_t hstepA = (size_t)HALF * g.lda * 2, hstepB = (size_t)HALF * g.ldb * 2;
    const size_t tstepA = 2 * hstepA, tstepB = 2 * hstepB;
    const unsigned ldsw = (unsigned)wid * 1024u;
    const int aoff = lds_byte(wr * 64 + fr, fq * 8), boff = lds_byte(wc * 32 + fr, fq * 8);
#define PG8_SA(b, h) (((b) * 2 + (h)) * HTB)
#define PG8_SB(b, h) ((4 + (b) * 2 + (h)) * HTB)
#define PG8_STAGE(bufoff, gbase, voff) do { _Pragma("unroll") for (int _i = 0; _i < 2; ++_i) \
        __builtin_amdgcn_global_load_lds((const unsigned*)((const char*)(gbase) + (voff)[_i]), (PG8_LAS unsigned*)(lds + (bufoff) + ldsw + _i * 8192), 16, 0, 0); } while (0)
#define PG8_LDA(dst, b, h) do { if constexpr (F8) { _Pragma("unroll") for (int m = 0; m < 4; ++m) dst##8[m] = f8cat(*(const PG8_LAS bf16x8*)(lds + PG8_SA(b, h) + aoff + m * 2048), *(const PG8_LAS bf16x8*)(lds + PG8_SA(b, h) + aoff + m * 2048 + 1024)); } \
        else { _Pragma("unroll") for (int m = 0; m < 4; ++m) _Pragma("unroll") for (int k = 0; k < 2; ++k) dst[m][k] = *(const PG8_LAS bf16x8*)(lds + PG8_SA(b, h) + aoff + m * 2048 + k * 1024); } } while (0)
#define PG8_LDB(dst, b, h) do { if constexpr (F8) { _Pragma("unroll") for (int n = 0; n < 2; ++n) dst##8[n] = f8cat(*(const PG8_LAS bf16x8*)(lds + PG8_SB(b, h) + boff + n * 2048), *(const PG8_LAS bf16x8*)(lds + PG8_SB(b, h) + boff + n * 2048 + 1024)); } \
        else { _Pragma("unroll") for (int n = 0; n < 2; ++n) _Pragma("unroll") for (int k = 0; k < 2; ++k) dst[n][k] = *(const PG8_LAS bf16x8*)(lds + PG8_SB(b, h) + boff + n * 2048 + k * 1024); } } while (0)
#define PG8_MMA(ai, bj, At, Bt) do { __builtin_amdgcn_s_setprio(1); _Pragma("unroll") for (int m = 0; m < 4; ++m) _Pragma("unroll") for (int n = 0; n < 2; ++n) { \
        if constexpr (F8) { asm volatile("v_mfma_scale_f32_16x16x128_f8f6f4 %0, %1, %2, %0, %3, %3 op_sel_hi:[0,0,0]" : "+v"(acc[ai][bj][m][n]) : "v"(Bt##8[n]), "v"(At##8[m]), "v"(f8scale)); } \
        else { _Pragma("unroll") for (int k = 0; k < 2; ++k) acc[ai][bj][m][n] = __builtin_amdgcn_mfma_f32_16x16x32_bf16(Bt[n][k], At[m][k], acc[ai][bj][m][n], 0, 0, 0); } } __builtin_amdgcn_s_setprio(0); } while (0)
#define PG8_WAIT_V(n) asm volatile("s_waitcnt vmcnt(" #n ")" ::: "memory")
#define PG8_WAIT_L(n) asm volatile("s_waitcnt lgkmcnt(" #n ")" ::: "memory")
#define PG8_BAR __builtin_amdgcn_s_barrier()
#define PG8_SCHED __builtin_amdgcn_sched_barrier(0)
    Unit cur, nxt; int ui = 0;
    if (!S.next(0, cur)) return;
    f32x4 acc[2][2][4][2];
#pragma unroll
    for (int a = 0; a < 2; ++a)
#pragma unroll
        for (int b = 0; b < 2; ++b)
#pragma unroll
            for (int m = 0; m < 4; ++m)
#pragma unroll
                for (int n = 0; n < 2; ++n) acc[a][b][m][n] = (f32x4){0.f, 0.f, 0.f, 0.f};
    bf16x8 At[4][2], B0[2][2], B1[2][2]; v8i_t At8[4], B08[2], B18[2];
    const int f8scale = 0x7f7f7f7f;
    const char* cA = (const char*)g.A + (size_t)cur.pm * tstepA; const char* cB = (const char*)g.Bt + (size_t)cur.pn * tstepB;
    S.a_ready(cur);
    if constexpr (SP2) {
        PG8_STAGE(PG8_SB(0, 0), cB, voffB); PG8_STAGE(PG8_SB(0, 1), cB + hstepB, voffB); PG8_STAGE(PG8_SA(0, 0), cA, voffA); PG8_STAGE(PG8_SA(0, 1), cA + hstepA, voffA);
        if (wr == 1) PG8_BAR;
        PG8_WAIT_V(2); PG8_BAR;
        PG8_STAGE(PG8_SB(1, 0), cB + kstep, voffB); PG8_STAGE(PG8_SA(1, 0), cA + kstep, voffA); PG8_STAGE(PG8_SB(1, 1), cB + hstepB + kstep, voffB);
        PG8_WAIT_V(6); PG8_BAR;
    } else {
        PG8_STAGE(PG8_SB(0, 0), cB, voffB); PG8_STAGE(PG8_SA(0, 0), cA, voffA); PG8_STAGE(PG8_SB(0, 1), cB + hstepB, voffB); PG8_STAGE(PG8_SA(0, 1), cA + hstepA, voffA);
        if (wr == 1) PG8_BAR;
        PG8_WAIT_V(4); PG8_BAR;
        PG8_STAGE(PG8_SB(1, 0), cB + kstep, voffB); PG8_STAGE(PG8_SA(1, 0), cA + kstep, voffA); PG8_STAGE(PG8_SB(1, 1), cB + hstepB + kstep, voffB);
        PG8_WAIT_V(6); PG8_BAR;
    }
    for (;;) {
        const bool has_next = S.next(ui + 1, nxt);
        const char* nA = has_next ? (const char*)g.A + (size_t)nxt.pm * tstepA : cA; const char* nB = has_next ? (const char*)g.Bt + (size_t)nxt.pn * tstepB : cB;
        for (int t = 0; t < nt; t += 2) {
            const bool last = (t == nt - 2);
            const char* a1 = cA + (size_t)(t + 1) * kstep;
            const char* a2 = last ? nA : cA + (size_t)(t + 2) * kstep; const char* b2 = last ? nB : cB + (size_t)(t + 2) * kstep;
            const char* a3 = a2 + kstep; const char* b3 = b2 + kstep;
            if (last && has_next) S.a_ready(nxt);
            if constexpr (SP2) {
            PG8_LDB(B0, 0, 0); PG8_LDB(B1, 0, 1); PG8_SCHED; PG8_LDA(At, 0, 0); PG8_STAGE(PG8_SA(1, 1), a1 + hstepA, voffA);
            PG8_WAIT_V(8); PG8_WAIT_L(0); PG8_BAR; PG8_MMA(0, 0, At, B0); PG8_MMA(0, 1, At, B1); PG8_BAR; PG8_SCHED;
            PG8_LDA(At, 0, 1); PG8_STAGE(PG8_SB(0, 0), b2, voffB); PG8_STAGE(PG8_SB(0, 1), b2 + hstepB, voffB); PG8_STAGE(PG8_SA(0, 0), a2, voffA);
            PG8_WAIT_V(8); PG8_WAIT_L(0); PG8_BAR; PG8_MMA(1, 0, At, B0); PG8_MMA(1, 1, At, B1); PG8_BAR; PG8_SCHED;
            PG8_LDB(B0, 1, 0); PG8_LDB(B1, 1, 1); PG8_SCHED; PG8_LDA(At, 1, 0); PG8_STAGE(PG8_SA(0, 1), a2 + hstepA, voffA);
            PG8_WAIT_V(8); PG8_WAIT_L(0); PG8_BAR; PG8_MMA(0, 0, At, B0); PG8_MMA(0, 1, At, B1); PG8_BAR; PG8_SCHED;
            PG8_LDA(At, 1, 1); PG8_STAGE(PG8_SB(1, 0), b3, voffB); PG8_STAGE(PG8_SB(1, 1), b3 + hstepB, voffB); PG8_STAGE(PG8_SA(1, 0), a3, voffA);
            PG8_WAIT_V(8); PG8_WAIT_L(0); PG8_BAR; PG8_MMA(1, 0, At, B0); PG8_MMA(1, 1, At, B1); PG8_BAR; PG8_SCHED;
            } else {
            PG8_LDB(B0, 0, 0); PG8_SCHED; PG8_LDA(At, 0, 0); PG8_STAGE(PG8_SA(1, 1), a1 + hstepA, voffA);
            PG8_WAIT_L(8); PG8_BAR; PG8_WAIT_L(0); PG8_MMA(0, 0, At, B0); PG8_BAR; PG8_SCHED;
            PG8_LDB(B1, 0, 1); PG8_STAGE(PG8_SB(0, 0), b2, voffB);
            PG8_BAR; PG8_WAIT_L(0); PG8_MMA(0, 1, At, B1); PG8_BAR;
            PG8_LDA(At, 0, 1); PG8_STAGE(PG8_SA(0, 0), a2, voffA);
            PG8_BAR; PG8_WAIT_L(0); PG8_MMA(1, 0, At, B0); PG8_BAR; PG8_SCHED;
            PG8_STAGE(PG8_SB(0, 1), b2 + hstepB, voffB);
            PG8_WAIT_V(6); PG8_BAR; PG8_MMA(1, 1, At, B1); PG8_BAR;
            PG8_LDB(B0, 1, 0); PG8_SCHED; PG8_LDA(At, 1, 0); PG8_STAGE(PG8_SA(0, 1), a2 + hstepA, voffA);
            PG8_WAIT_L(8); PG8_BAR; PG8_WAIT_L(0); PG8_MMA(0, 0, At, B0); PG8_BAR; PG8_SCHED;
            PG8_LDB(B1, 1, 1); PG8_STAGE(PG8_SB(1, 0), b3, voffB);
            PG8_BAR; PG8_WAIT_L(0); PG8_MMA(0, 1, At, B1); PG8_BAR;
            PG8_LDA(At, 1, 1); PG8_STAGE(PG8_SA(1, 0), a3, voffA);
            PG8_BAR; PG8_WAIT_L(0); PG8_MMA(1, 0, At, B0); PG8_BAR; PG8_SCHED;
            PG8_STAGE(PG8_SB(1, 1), b3 + hstepB, voffB);
            PG8_WAIT_V(6); PG8_BAR; PG8_MMA(1, 1, At, B1); PG8_BAR;
            }
        }
        if constexpr (F8) { asm volatile("s_nop 15\n\ts_nop 15" ::: "memory"); }
        if constexpr (ALIGN_EPI) { if (wr == 0) PG8_BAR; }
        if constexpr (!Epi::AFTER_DRAIN) { E(acc, cur, wr, wc, fr, fq); S.done(cur); }
        if (!has_next) break;
#pragma unroll
        for (int a = 0; a < 2; ++a)
#pragma unroll
            for (int b = 0; b < 2; ++b)
#pragma unroll
                for (int m = 0; m < 4; ++m)
#pragma unroll
                    for (int n = 0; n < 2; ++n) acc[a][b][m][n] = (f32x4){0.f, 0.f, 0.f, 0.f};
        cur = nxt; cA = nA; cB = nB; ++ui;
        if constexpr (ALIGN_EPI) { if (wr == 1) PG8_BAR; }
    }
    PG8_WAIT_V(0);
    if constexpr (!ALIGN_EPI) { if (wr == 0) PG8_BAR; }
    PG8_BAR;
    if constexpr (Epi::AFTER_DRAIN) { E.fused(acc, cur, wr, wc, fr, fq, lds, wid, lane); S.done(cur); }
#undef PG8_SA
#undef PG8_SB
#undef PG8_STAGE
#undef PG8_LDA
#undef PG8_LDB
#undef PG8_MMA
#undef PG8_WAIT_V
#undef PG8_WAIT_L
#undef PG8_BAR
#undef PG8_SCHED
}}

constexpr size_t MiB = 1u << 20;
constexpr size_t WS_CTL = 0, CTL_ZERO_BYTES = 2 * MiB;
constexpr size_t WS_MOD = 1 * MiB;
constexpr size_t WS_BT1 = 2 * MiB;
constexpr size_t WS_W8IN = 16 * MiB;
constexpr size_t WS_G8 = 64 * MiB;
constexpr size_t WS_H8 = 96 * MiB;
constexpr size_t WS_BT2 = 128 * MiB;
constexpr size_t WS_WUK = 148 * MiB;
constexpr size_t WS_BTUV = 150 * MiB;
constexpr size_t WS_BTUP = 152 * MiB;
constexpr size_t WS_BTOUT = 184 * MiB;
constexpr size_t WS_BTPQ = 216 * MiB;
constexpr size_t WS_SK = 232 * MiB;
constexpr size_t WS_U8 = 233 * MiB, WS_V8 = 297 * MiB, WS_SU = 361 * MiB, WS_SV = 362 * MiB;
constexpr int ROW6 = 3072;
constexpr size_t WS_H = 489 * MiB;
constexpr size_t WS_P1 = 553 * MiB;
constexpr size_t WS_Q2 = 805 * MiB;
constexpr size_t WS_QL = 965 * MiB;
constexpr size_t WS_SC = 1093 * MiB;
constexpr size_t WS_SEL = 1157 * MiB, WS_CNT = 1165 * MiB, WS_WIDX = 1166 * MiB;
constexpr size_t WS_OLAT = 1168 * MiB;
constexpr size_t WS_YCAT = 1296 * MiB;
constexpr size_t WS_MERGED8 = 1328 * MiB;
constexpr size_t WS_MERGED = 1360 * MiB;
constexpr size_t WS_PQ = 1424 * MiB;
constexpr size_t WS_EID = 1456 * MiB, WS_GATE = 1460 * MiB;
constexpr size_t WS_CKV = 1528 * MiB;
constexpr size_t WS_END = 1536 * MiB;

constexpr int SCRATCH_BYTES = 155648;
constexpr int MISC_OFF = SCRATCH_BYTES;
constexpr int LDS_BYTES = SCRATCH_BYTES + 1024;
constexpr int NWAVES = 8, NTHR = 512;

struct Params {
    const float *x, *c, *w_ada, *b_ada, *g_mix, *w_in, *g_cq, *g_ckv, *w_uq, *w_uk, *w_uv, *w_qi, *g_ki, *b_ki, *t5, *g_ret, *w_up, *w_gate, *b_gate, *w_out, *g_ffn, *w_pq, *sub_keys, *u_exp, *v_exp, *g_final;
    float* out; unsigned char* ws; int ph_lo, ph_hi;
#ifdef PEER_PROBE
    int dummy;
#endif
};

#define LDS_WAIT() asm volatile("s_waitcnt lgkmcnt(0)" ::: "memory")
#define VM_WAIT() asm volatile("s_waitcnt vmcnt(0)" ::: "memory")

#define XB_TMO      128
#define XB_XCNT(j)  (256  + 64 * (j))
#define XB_XSUB(j)  (1280 + 64 * (j))
#define XB_XGEN(j)  (2304 + 64 * (j))
#define XB_TOP      3328
#define XB_TOPGEN   3392
#define XCD_BAR_WORDS 3456
#define XB_ATT_RANK  4096
#define XB_SPIN_CAP (1u << 18)

__device__ __forceinline__ unsigned xb_ld(unsigned* p)              { return __hip_atomic_load(p, __ATOMIC_RELAXED, __HIP_MEMORY_SCOPE_AGENT); }
__device__ __forceinline__ unsigned xb_add(unsigned* p, unsigned v) { return __hip_atomic_fetch_add(p, v, __ATOMIC_RELAXED, __HIP_MEMORY_SCOPE_AGENT); }
__device__ __forceinline__ unsigned xb_xcc_id() { return (unsigned)__builtin_amdgcn_s_getreg((3 << 11) | 20) & 0xFu; }
#define XB_SPIN(cond, bar) do { unsigned _sp = 0; while (cond) { __builtin_amdgcn_s_sleep(1); \
    if ((++_sp & 255u) == 0u) { if (xb_ld(&(bar)[XB_TMO])) break; if (_sp > XB_SPIN_CAP) { atomicAdd(&(bar)[XB_TMO], 1u); break; } } } } while (0)

struct XcdBarrier { unsigned* bar; unsigned x; volatile LAS unsigned* st; };

__device__ __forceinline__ XcdBarrier xcd_barrier_post(unsigned* bar, volatile LAS unsigned* st) {
    XcdBarrier b; b.bar = bar; b.x = xb_xcc_id(); b.st = st;
    if (threadIdx.x == 0) (void)xb_add(&bar[XB_XCNT(b.x)], 1u);
    return b;
}
__device__ __forceinline__ void xcd_barrier_complete(unsigned* bar, unsigned x, unsigned& nloc, unsigned& nx) {
    const unsigned G = gridDim.x * gridDim.y * gridDim.z;
    unsigned sum, cnt, mine, sp = 0u;
    for (;;) {
        sum = 0u; cnt = 0u; mine = 0u;
#pragma unroll
        for (unsigned j = 0; j < 16; ++j) { const unsigned c = xb_ld(&bar[XB_XCNT(j)]); sum += c; cnt += (c > 0u) ? 1u : 0u; mine = (j == x) ? c : mine; }
        if (sum == G) break;
        __builtin_amdgcn_s_sleep(1);
        if ((++sp & 255u) == 0u) { if (xb_ld(&bar[XB_TMO])) break; if (sp > XB_SPIN_CAP) { atomicAdd(&bar[XB_TMO], 1u); break; } }
    }
    nloc = mine > 0u ? mine : 1u; nx = cnt > 0u ? cnt : 1u;
}
__device__ __forceinline__ void xcd_barrier(const XcdBarrier& b) {
    asm volatile("s_waitcnt vmcnt(0)" ::: "memory");
    __syncthreads();
    if (threadIdx.x == 0) {
        unsigned* bar = b.bar;
        __builtin_amdgcn_s_waitcnt(0);
        unsigned nloc = b.st[0], nx = b.st[1];
        if (nloc == 0u) { xcd_barrier_complete(bar, b.x, nloc, nx); b.st[0] = nloc; b.st[1] = nx; }
        const unsigned old = xb_add(&bar[XB_XSUB(b.x)], 1u);
        const unsigned gen = old / nloc;
        if (old + 1u == (gen + 1u) * nloc) {
            __builtin_amdgcn_fence(__ATOMIC_RELEASE, "agent");
            asm volatile("s_waitcnt vmcnt(0)" ::: "memory");
            const unsigned og = xb_add(&bar[XB_TOP], 1u);
            const unsigned tg = og / nx;
            if (og + 1u == (tg + 1u) * nx) xb_add(&bar[XB_TOPGEN], 1u);
            else XB_SPIN(xb_ld(&bar[XB_TOPGEN]) == tg, bar);
            __builtin_amdgcn_fence(__ATOMIC_ACQUIRE, "agent");
            xb_add(&bar[XB_XGEN(b.x)], 1u);
            asm volatile("s_waitcnt vmcnt(0)" ::: "memory");
        } else {
            XB_SPIN(xb_ld(&bar[XB_XGEN(b.x)]) == gen, bar);
            __builtin_amdgcn_fence(__ATOMIC_ACQUIRE, "agent");
            asm volatile("s_waitcnt vmcnt(0)" ::: "memory");
        }
    }
    __syncthreads();
}

struct Ctx { LAS unsigned char* lds; int tid, lane, wave, gw, ngw, bid, nb; };

__device__ __forceinline__ void p0_transpose_item(const float* W, int K, int N, bf16* WT, int row_off, LAS float* scr, int item, int lane, int ldw = 0) {
    if (!ldw) ldw = N;
    const int nblk = N / 32, kb = item / nblk, nb = item % nblk, k0 = 64 * kb, n0 = 32 * nb;
#pragma unroll 8
    for (int i = 0; i < 32; ++i) { const int kk = 2 * i + (lane >> 5); scr[kk * 33 + (lane & 31)] = W[(size_t)(k0 + kk) * ldw + n0 + (lane & 31)]; }
    LDS_WAIT(); asm volatile("" ::: "memory");
    const int c = lane & 7;
#pragma unroll
    for (int j = 0; j < 4; ++j) { const int n = (lane >> 3) + 8 * j; const LAS float* s = scr + (8 * c) * 33 + n;
        v4u o; o.x = cvt_pk_bf16(s[0 * 33], s[1 * 33]); o.y = cvt_pk_bf16(s[2 * 33], s[3 * 33]); o.z = cvt_pk_bf16(s[4 * 33], s[5 * 33]); o.w = cvt_pk_bf16(s[6 * 33], s[7 * 33]);
        *(v4u*)(WT + (size_t)(row_off + n0 + n) * K + k0 + 8 * c) = o; }
    LDS_WAIT(); asm volatile("" ::: "memory");
}
__device__ __forceinline__ void p0_transpose_item_f8(const float* W, int K, int N, unsigned char* WT, float sc, LAS float* scr, int item, int lane, int ldw = 0) {
    if (!ldw) ldw = N;
    const int nblk = N / 32, kb = item / nblk, nb = item % nblk, k0 = 64 * kb, n0 = 32 * nb;
#pragma unroll 8
    for (int i = 0; i < 32; ++i) { const int kk = 2 * i + (lane >> 5); scr[kk * 33 + (lane & 31)] = W[(size_t)(k0 + kk) * ldw + n0 + (lane & 31)]; }
    LDS_WAIT(); asm volatile("" ::: "memory");
    const int n = lane >> 1, kh = (lane & 1) * 32; const LAS float* s = scr + kh * 33 + n;
    unsigned o[8];
#pragma unroll
    for (int j = 0; j < 8; ++j) { int w = 0; w = PK_FP8(s[(4 * j) * 33] * sc, s[(4 * j + 1) * 33] * sc, w, false); w = PK_FP8(s[(4 * j + 2) * 33] * sc, s[(4 * j + 3) * 33] * sc, w, true); o[j] = (unsigned)w; }
    unsigned char* dp = WT + (size_t)(n0 + n) * K + k0 + kh;
    *(v4u*)dp = (v4u){o[0], o[1], o[2], o[3]}; *(v4u*)(dp + 16) = (v4u){o[4], o[5], o[6], o[7]};
    LDS_WAIT(); asm volatile("" ::: "memory");
}
__device__ __forceinline__ void p0_convert(const float* src, bf16* dst, size_t n, size_t i0, size_t stride) {
    for (size_t i = i0; i < n / 8; i += stride) { const f32x4 a = *(const f32x4*)(src + 8 * i), b = *(const f32x4*)(src + 8 * i + 4);
        v4u o; o.x = cvt_pk_bf16(a[0], a[1]); o.y = cvt_pk_bf16(a[2], a[3]); o.z = cvt_pk_bf16(b[0], b[1]); o.w = cvt_pk_bf16(b[2], b[3]); *(v4u*)(dst + 8 * i) = o; }
}

__device__ __forceinline__ void tr32_item(const float* W, int K, int N, bf16* WT, LAS float* scr, int item, int lane) {
    const int nblk = N / 32, kb = item / nblk, nb = item % nblk, k0 = 32 * kb, n0 = 32 * nb;
#pragma unroll 8
    for (int i = 0; i < 16; ++i) { const int kk = 2 * i + (lane >> 5); scr[kk * 33 + (lane & 31)] = W[(size_t)(k0 + kk) * N + n0 + (lane & 31)]; }
    LDS_WAIT(); asm volatile("" ::: "memory");
#pragma unroll
    for (int j = 0; j < 2; ++j) { const int q = lane + 64 * j, n = q >> 2, cch = q & 3; const LAS float* s = scr + (8 * cch) * 33 + n;
        v4u o; o.x = cvt_pk_bf16(s[0 * 33], s[1 * 33]); o.y = cvt_pk_bf16(s[2 * 33], s[3 * 33]); o.z = cvt_pk_bf16(s[4 * 33], s[5 * 33]); o.w = cvt_pk_bf16(s[6 * 33], s[7 * 33]);
        *(v4u*)(WT + (size_t)(n0 + n) * K + k0 + 8 * cch) = o; }
    LDS_WAIT(); asm volatile("" ::: "memory");
}
__device__ __forceinline__ void tr32_item_f8(const float* W, int K, int N, unsigned char* WT, float sc, LAS float* scr, int item, int lane) {
    const int nblk = N / 32, kb = item / nblk, nb = item % nblk, k0 = 32 * kb, n0 = 32 * nb;
#pragma unroll 8
    for (int i = 0; i < 16; ++i) { const int kk = 2 * i + (lane >> 5); scr[kk * 33 + (lane & 31)] = W[(size_t)(k0 + kk) * N + n0 + (lane & 31)]; }
    LDS_WAIT(); asm volatile("" ::: "memory");
    const int n = lane >> 1, kh = (lane & 1) * 16; const LAS float* s = scr + kh * 33 + n;
    unsigned o[4];
#pragma unroll
    for (int j = 0; j < 4; ++j) { int w = 0; w = PK_FP8(s[(4 * j) * 33] * sc, s[(4 * j + 1) * 33] * sc, w, false); w = PK_FP8(s[(4 * j + 2) * 33] * sc, s[(4 * j + 3) * 33] * sc, w, true); o[j] = (unsigned)w; }
    *(v4u*)(WT + (size_t)(n0 + n) * K + k0 + kh) = (v4u){o[0], o[1], o[2], o[3]};
    LDS_WAIT(); asm volatile("" ::: "memory");
}
__device__ __forceinline__ void convert_late_weights(const Params& p, LAS float* scr, int lane, int first, int stride) {
    unsigned char* ws = p.ws;
    constexpr int I_UP = 128 * (D / 32), I_OUT = 128 * (D / 32), I_PQ = 128 * (2048 / 32);
    for (int it = first; it < I_UP + I_OUT + I_PQ; it += stride) { int r = it;
        if (r < I_UP) { tr32_item_f8(p.w_up, D, D, ws + WS_BTUP, 1024.0f, scr, r, lane); continue; } r -= I_UP;
        if (r < I_OUT) { tr32_item_f8(p.w_out, D, D, ws + WS_BTOUT, 1024.0f, scr, r, lane); continue; } r -= I_OUT;
        tr32_item(p.w_pq, D, 2048, (bf16*)(ws + WS_BTPQ), scr, r, lane); }
}
constexpr size_t WS_MODP = 1093 * MiB;
__device__ __forceinline__ void adaln_late(const Params& p, int item, int lane) {
    const int cc = item & 63, rg = item >> 6;
    const float* wp = p.w_ada + (size_t)(rg * 256) * (6 * D) + 2 * D + cc * 256 + lane * 4;
    f32x4 a0 = {0.f, 0.f, 0.f, 0.f}, a1 = a0, a2 = a0, a3 = a0;
#pragma unroll 8
    for (int d = 0; d < 256; ++d) { const f32x4 w = *(const f32x4*)(wp + (size_t)d * (6 * D)); const int dd = rg * 256 + d;
        const float c0 = p.c[dd], c1 = p.c[D + dd], c2 = p.c[2 * D + dd], c3 = p.c[3 * D + dd];
        a0 += w * (c0 / (1.0f + __expf(-c0))); a1 += w * (c1 / (1.0f + __expf(-c1))); a2 += w * (c2 / (1.0f + __expf(-c2))); a3 += w * (c3 / (1.0f + __expf(-c3))); }
    float* pp = (float*)(p.ws + WS_MODP) + (size_t)(rg * 4) * (4 * D) + cc * 256 + lane * 4;
    *(f32x4*)(pp) = a0; *(f32x4*)(pp + 4 * D) = a1; *(f32x4*)(pp + 2 * 4 * D) = a2; *(f32x4*)(pp + 3 * 4 * D) = a3;
}
__device__ __forceinline__ void adaln_late_reduce(const Params& p, const Ctx& c) {
    const float* pp = (const float*)(p.ws + WS_MODP); float* mod = (float*)(p.ws + WS_MOD);
    for (int i = c.bid * NTHR + c.tid; i < 4 * 4 * D; i += c.nb * NTHR) { const int b = i / (4 * D), col = i % (4 * D); float s_ = p.b_ada[2 * D + col];
#pragma unroll
        for (int rg = 0; rg < 16; ++rg) s_ += pp[(size_t)(rg * 4 + b) * (4 * D) + col];
        mod[(size_t)b * 6 * D + 2 * D + col] = s_; }
}
typedef unsigned v2u_t __attribute__((ext_vector_type(2)));
constexpr size_t SLB = (size_t)P_EXP * 192;
__device__ __forceinline__ void convert_expert_rows(const Params& p, const Ctx& c, int r_first, int r_stride) {
    unsigned char* ws = p.ws;
        {
            typedef float v16f_t __attribute__((ext_vector_type(16))); typedef float v32f_t __attribute__((ext_vector_type(32))); typedef unsigned v6u_t __attribute__((ext_vector_type(6)));
            v16f_t pa, pb;
#pragma unroll
            for (int i = 0; i < 16; ++i) { pa[i] = (i < 8) ? 0.125f * i : 1.0f + 0.125f * (i - 8); pb[i] = (i < 8) ? 2.0f + 0.25f * i : 4.0f + 0.5f * (i - 8); }
            const v32f_t pd = __builtin_amdgcn_cvt_scalef32_pk32_f32_fp6(__builtin_amdgcn_cvt_scalef32_2xpk16_fp6_f32(pa, pb, 1.0f), 1.0f);
            const bool inter = (pd[1] == pb[0]);
            bool okl = true;
#pragma unroll
            for (int i = 0; i < 16; ++i) okl = okl && (inter ? (pd[2 * i] == pa[i] && pd[2 * i + 1] == pb[i]) : (pd[i] == pa[i] && pd[16 + i] == pb[i]));
            for (int r = r_first; r < 2 * P_EXP; r += r_stride) {
                const bool isv = r >= P_EXP; const int e = isv ? r - P_EXP : r;
                const float* src = (isv ? p.v_exp : p.u_exp) + (size_t)e * D;
                f32x4 v[16]; float mx = 0.f;
#pragma unroll
                for (int g = 0; g < 2; ++g)
#pragma unroll
                    for (int k = 0; k < 8; ++k) { v[g * 8 + k] = *(const f32x4*)(src + (g * 64 + c.lane) * 32 + k * 4);
                        mx = fmaxf(mx, fmaxf(fmaxf(fabsf(v[g * 8 + k].x), fabsf(v[g * 8 + k].y)), fmaxf(fabsf(v[g * 8 + k].z), fabsf(v[g * 8 + k].w)))); }
#pragma unroll
                for (int o = 1; o < 64; o <<= 1) mx = fmaxf(mx, __shfl_xor(mx, o));
                const float scale = (mx > 0.f) ? mx * (1.0f / 7.5f) : 1.0f; float inv = 1.0f / scale;
                if (!okl) inv = __builtin_nanf("");
                v6u_t wq[2];
#pragma unroll
                for (int g = 0; g < 2; ++g) { v16f_t a, b;
#pragma unroll
                    for (int i = 0; i < 16; ++i) { const float ei = v[g * 8 + (2 * i) / 4][(2 * i) % 4], eo = v[g * 8 + (2 * i + 1) / 4][(2 * i + 1) % 4];
                        const float lo = v[g * 8 + i / 4][i % 4], hi = v[g * 8 + 4 + i / 4][i % 4];
                        a[i] = (inter ? ei : lo) * inv; b[i] = (inter ? eo : hi) * inv; }
                    wq[g] = __builtin_amdgcn_cvt_scalef32_2xpk16_fp6_f32(a, b, 1.0f); }
#pragma unroll
                for (int g = 0; g < 2; ++g) { unsigned char* drow = ws + (isv ? WS_V8 : WS_U8) + (size_t)(g * 8 + (c.lane >> 3)) * SLB + (size_t)e * 192;
                    *(v4u*)(drow + (c.lane & 7) * 16) = (v4u){wq[g][0], wq[g][1], wq[g][2], wq[g][3]};
                    *(v2u_t*)(drow + 128 + (c.lane & 7) * 8) = (v2u_t){wq[g][4], wq[g][5]}; }
                if (c.lane == 0) ((float*)(ws + (isv ? WS_SV : WS_SU)))[e] = scale;
            }
        }
}

__device__ __forceinline__ void ph_prologue(const Params& p, const Ctx& c) {
    unsigned char* ws = p.ws;
    {
        float* mod = (float*)(ws + WS_MOD); LAS float* sc = (LAS float*)c.lds;
        LAS float* red = sc + 4 * D;
        for (int it = c.bid; it < 2 * D / 128; it += c.nb) {
            __syncthreads();
            for (int i = c.tid; i < 4 * D; i += NTHR) { const float v = p.c[i]; sc[i] = v / (1.0f + __expf(-v)); }
            __syncthreads();
            const int ct = c.tid & 31, dg = c.tid >> 5, e = it * 128 + ct * 4;
            f32x4 a0 = {0, 0, 0, 0}, a1 = a0, a2 = a0, a3 = a0;
            const float* wp = p.w_ada + (size_t)dg * (6 * D) + e;
#pragma unroll 8
            for (int i = 0; i < D / 16; ++i) { const f32x4 w = *(const f32x4*)(wp + (size_t)(16 * i) * (6 * D)); const int d = dg + 16 * i;
                a0 += w * sc[d]; a1 += w * sc[D + d]; a2 += w * sc[2 * D + d]; a3 += w * sc[3 * D + d]; }
            *(LAS f32x4*)(red + (dg * 4 + 0) * 128 + ct * 4) = a0; *(LAS f32x4*)(red + (dg * 4 + 1) * 128 + ct * 4) = a1;
            *(LAS f32x4*)(red + (dg * 4 + 2) * 128 + ct * 4) = a2; *(LAS f32x4*)(red + (dg * 4 + 3) * 128 + ct * 4) = a3;
            __syncthreads();
            { const int b = c.tid >> 7, col = c.tid & 127; float s = p.b_ada[it * 128 + col];
#pragma unroll
              for (int g = 0; g < 16; ++g) s += red[(g * 4 + b) * 128 + col];
              mod[(size_t)b * 6 * D + it * 128 + col] = s; }
        }
        __syncthreads();
    }
    {
        LAS float* scr = (LAS float*)(c.lds + c.wave * 8448);
        bf16* BT1 = (bf16*)(ws + WS_BT1); bf16* BT2 = (bf16*)(ws + WS_BT2);
        constexpr int I_IN = 64 * (IN_BF / 32), I_IN8 = 64 * ((IN_WIDTH - IN_BF) / 32), I_GATE = 64 * (2 * D / 32), I_UQ = 16 * (A_WIDTH / 32), I_QI = 16 * (IDX_H * IDX_D / 32), I_UV = 8 * (A_WIDTH / 32),
                      I_UVX = 0;
        constexpr int NITEMS = I_IN + I_IN8 + I_GATE + I_UQ + I_QI + I_UV + I_UVX;
        for (int it = c.gw; it < NITEMS; it += c.ngw) {
            int r = it;
            if (r < I_IN) { p0_transpose_item(p.w_in, D, IN_BF, BT1, 0, scr, r, c.lane, IN_WIDTH); continue; } r -= I_IN;
            if (r < I_IN8) { p0_transpose_item_f8(p.w_in + IN_BF, D, IN_WIDTH - IN_BF, ws + WS_W8IN, 1024.0f, scr, r, c.lane, IN_WIDTH); continue; } r -= I_IN8;
            if (r < I_GATE) { p0_transpose_item_f8(p.w_gate, D, 2 * D, ws + WS_G8, 1024.0f, scr, r, c.lane); continue; } r -= I_GATE;
            if (r < I_UQ) { p0_transpose_item(p.w_uq, A_QR, A_WIDTH, BT2, 0, scr, r, c.lane); continue; } r -= I_UQ;
            if (r < I_QI) { p0_transpose_item(p.w_qi, A_QR, IDX_H * IDX_D, BT2, A_WIDTH, scr, r, c.lane); continue; } r -= I_QI;
            p0_transpose_item(p.w_uv, A_KVR, A_WIDTH, (bf16*)(ws + WS_BTUV), 0, scr, r, c.lane);
        }
        const size_t gt = (size_t)c.bid * NTHR + c.tid, gs = (size_t)c.nb * NTHR;
        for (size_t i = gt; i < (size_t)(IN_PAD - IN_WIDTH) * D / 16; i += gs) *(v4u*)(ws + WS_W8IN + (size_t)(IN_WIDTH - IN_BF) * D + 16 * i) = (v4u){0u, 0u, 0u, 0u};
        p0_convert(p.w_uk, (bf16*)(ws + WS_WUK), (size_t)A_KVR * A_WIDTH, gt, gs);
        p0_convert(p.sub_keys, (bf16*)(ws + WS_SK), (size_t)2 * P_NK * 128, gt, gs);
    }
}

__device__ __forceinline__ void ph_modulate(const float* X, const float* g, const float* mod, int sh_off, int sc_off, bf16* H, unsigned char* H8, const Ctx& c) {
    for (int m = c.gw; m < T; m += c.ngw) {
        const int b = m / SEQ;
        const f32x4* xr = (const f32x4*)(X + (size_t)m * D) + c.lane;
        f32x4 v[16]; float s = 0.f;
#pragma unroll
        for (int j = 0; j < 16; ++j) { v[j] = xr[64 * j]; s += (v[j].x * v[j].x + v[j].y * v[j].y) + (v[j].z * v[j].z + v[j].w * v[j].w); }
        const float rstd = 1.0f / sqrtf(wave_sum(s) * (1.0f / D) + EPS);
        const f32x4* gp = (const f32x4*)g + c.lane; const f32x4* shp = (const f32x4*)(mod + (size_t)b * 6 * D + sh_off) + c.lane; const f32x4* scp = (const f32x4*)(mod + (size_t)b * 6 * D + sc_off) + c.lane;
        v2u* o = (v2u*)(H + (size_t)m * D) + c.lane;
#pragma unroll
        for (int j = 0; j < 16; ++j) { const f32x4 gg = gp[64 * j], sh = shp[64 * j], sc = scp[64 * j];
            const f32x4 y = (v[j] * rstd * gg) * (sc + 1.0f) + sh;
            v2u w; w.x = cvt_pk_bf16(y.x, y.y); w.y = cvt_pk_bf16(y.z, y.w); o[64 * j] = w;
            if (H8) { int q = 0; q = PK_FP8(y.x * 16.0f, y.y * 16.0f, q, false); q = PK_FP8(y.z * 16.0f, y.w * 16.0f, q, true); ((unsigned*)(H8 + (size_t)m * D))[c.lane + 64 * j] = (unsigned)q; } }
    }
}

__device__ __forceinline__ void ph_postproc(const Params& p, const Ctx& c) {
    bf16* P1 = (bf16*)(p.ws + WS_P1); float* WIDX = (float*)(p.ws + WS_WIDX);
    const int lane = c.lane;
    const float inv = exp2f(-(float)lane * (13.287712379549449f / 63.0f));
    for (int t = c.gw; t < T; t += c.ngw) {
        bf16* row = P1 + (size_t)t * N1;
        const int pos = t % SEQ;
        { v4u a = *(v4u*)(row + C_CQ + lane * 8), b = *(v4u*)(row + C_CQ + 512 + lane * 8);
          float f[16] = {bflo(a.x), bfhi(a.x), bflo(a.y), bfhi(a.y), bflo(a.z), bfhi(a.z), bflo(a.w), bfhi(a.w), bflo(b.x), bfhi(b.x), bflo(b.y), bfhi(b.y), bflo(b.z), bfhi(b.z), bflo(b.w), bfhi(b.w)};
          float s = 0.f;
#pragma unroll
          for (int j = 0; j < 16; ++j) s += f[j] * f[j];
          const float rstd = 1.0f / sqrtf(wave_sum(s) * (1.0f / A_QR) + EPS);
          const float* g0 = p.g_cq + lane * 8; const float* g1 = p.g_cq + 512 + lane * 8;
#pragma unroll
          for (int j = 0; j < 8; ++j) { f[j] *= rstd * g0[j]; f[8 + j] *= rstd * g1[j]; }
          a.x = cvt_pk_bf16(f[0], f[1]); a.y = cvt_pk_bf16(f[2], f[3]); a.z = cvt_pk_bf16(f[4], f[5]); a.w = cvt_pk_bf16(f[6], f[7]);
          b.x = cvt_pk_bf16(f[8], f[9]); b.y = cvt_pk_bf16(f[10], f[11]); b.z = cvt_pk_bf16(f[12], f[13]); b.w = cvt_pk_bf16(f[14], f[15]);
          *(v4u*)(row + C_CQ + lane * 8) = a; *(v4u*)(row + C_CQ + 512 + lane * 8) = b; }
        { v4u a = *(v4u*)(row + C_CKV + lane * 8);
          float f[8] = {bflo(a.x), bfhi(a.x), bflo(a.y), bfhi(a.y), bflo(a.z), bfhi(a.z), bflo(a.w), bfhi(a.w)};
          float s = 0.f;
#pragma unroll
          for (int j = 0; j < 8; ++j) s += f[j] * f[j];
          const float rstd = 1.0f / sqrtf(wave_sum(s) * (1.0f / A_KVR) + EPS);
          const float* g0 = p.g_ckv + lane * 8;
#pragma unroll
          for (int j = 0; j < 8; ++j) f[j] *= rstd * g0[j];
          a.x = cvt_pk_bf16(f[0], f[1]); a.y = cvt_pk_bf16(f[2], f[3]); a.z = cvt_pk_bf16(f[4], f[5]); a.w = cvt_pk_bf16(f[6], f[7]);
          *(v4u*)((bf16*)(p.ws + WS_CKV) + (size_t)t * A_KVR + lane * 8) = a; }
        { unsigned w = *(unsigned*)(row + C_KI + lane * 2); const float f0 = bflo(w), f1 = bfhi(w);
          const float mu = wave_sum(f0 + f1) * (1.0f / IDX_D); const float d0 = f0 - mu, d1 = f1 - mu;
          const float var = wave_sum(d0 * d0 + d1 * d1) * (1.0f / IDX_D); const float rstd = 1.0f / sqrtf(var + EPS);
          const float y0 = d0 * rstd * p.g_ki[lane * 2] + p.b_ki[lane * 2], y1 = d1 * rstd * p.g_ki[lane * 2 + 1] + p.b_ki[lane * 2 + 1];
          *(unsigned*)(row + C_KI + lane * 2) = cvt_pk_bf16(y0, y1); }
        WIDX[(size_t)t * IDX_H + lane] = bf2f(row[C_WI + lane]) * (0.125f * 0.08838834764831845f);
        { const float angf = (float)pos * inv; const double a = (double)angf; const double r = a - 6.283185307179586476925 * rint(a * 0.15915494309189533577);
          float sn, cs; __sincosf((float)r, &sn, &cs);
#pragma unroll
          for (int h = 0; h < R_HEADS; ++h) {
              bf16* q = row + C_RQ + h * 128; bf16* k = row + C_RK + h * 128;
              const float q1 = bf2f(q[lane]), q2 = bf2f(q[64 + lane]), k1 = bf2f(k[lane]) * 0.08838834764831845f, k2 = bf2f(k[64 + lane]) * 0.08838834764831845f;
              q[lane] = f2bf(q1 * cs - q2 * sn); q[64 + lane] = f2bf(q1 * sn + q2 * cs);
              k[lane] = f2bf(k1 * cs - k2 * sn); k[64 + lane] = f2bf(k1 * sn + k2 * cs); } }
    }
}

template <bool OUT8> __device__ __forceinline__ void lds_gemm_unit(const bf16* A, int lda, const bf16* Bt, int ldb, int K, void* C, int ldc, float s8, const Ctx& c) {
    constexpr int PB = 272; LAS unsigned char* As = c.lds; LAS unsigned char* Bs = c.lds + 256 * PB;
    const int tid = c.tid, lane = c.lane, wr = c.wave >> 1, wc = c.wave & 1, fr = lane & 15, fq = lane >> 4;
    f32x4 acc[4][4];
#pragma unroll
    for (int i = 0; i < 4; ++i)
#pragma unroll
        for (int j = 0; j < 4; ++j) acc[i][j] = (f32x4){0.f, 0.f, 0.f, 0.f};
    for (int k0 = 0; k0 < K; k0 += 128) {
        __syncthreads();
#pragma unroll
        for (int i = 0; i < 8; ++i) { const int q = tid + 512 * i, r = q >> 4, ch = q & 15; *(LAS v4u*)(As + r * PB + ch * 16) = *(const v4u*)(A + (size_t)r * lda + k0 + ch * 8); }
#pragma unroll
        for (int i = 0; i < 4; ++i) { const int q = tid + 512 * i, r = q >> 4, ch = q & 15; *(LAS v4u*)(Bs + r * PB + ch * 16) = *(const v4u*)(Bt + (size_t)r * ldb + k0 + ch * 8); }
        LDS_WAIT(); __syncthreads();
#pragma unroll
        for (int ks = 0; ks < 4; ++ks) { bf16x8 a[4], b[4];
#pragma unroll
            for (int i = 0; i < 4; ++i) { a[i] = *(const LAS bf16x8*)(As + (64 * wr + 16 * i + fr) * PB + ks * 64 + fq * 16); b[i] = *(const LAS bf16x8*)(Bs + (64 * wc + 16 * i + fr) * PB + ks * 64 + fq * 16); }
#pragma unroll
            for (int i = 0; i < 4; ++i)
#pragma unroll
                for (int j = 0; j < 4; ++j) acc[i][j] = __builtin_amdgcn_mfma_f32_16x16x32_bf16(b[j], a[i], acc[i][j], 0, 0, 0); }
    }
#pragma unroll
    for (int i = 0; i < 4; ++i)
#pragma unroll
        for (int j = 0; j < 4; ++j) { const size_t off = (size_t)(64 * wr + 16 * i + fr) * ldc + 64 * wc + 16 * j + 4 * fq;
            if constexpr (OUT8) { int q = 0; q = PK_FP8(acc[i][j][0] * s8, acc[i][j][1] * s8, q, false); q = PK_FP8(acc[i][j][2] * s8, acc[i][j][3] * s8, q, true); *(unsigned*)((unsigned char*)C + off) = (unsigned)q; }
            else { v2u w; w.x = cvt_pk_bf16(acc[i][j][0], acc[i][j][1]); w.y = cvt_pk_bf16(acc[i][j][2], acc[i][j][3]); *(v2u*)((bf16*)C + off) = w; } }
}
__device__ __forceinline__ void ph_qlat(const Params& p, const Ctx& c) {
    const bf16* Q2 = (const bf16*)(p.ws + WS_Q2); const bf16* WUK = (const bf16*)(p.ws + WS_WUK); bf16* QL = (bf16*)(p.ws + WS_QL);
    for (int u = c.bid; u < 16 * 32 * 4; u += c.nb) { const int h = u / 128, rem = u % 128, rt = rem / 4, ct = rem % 4;
        lds_gemm_unit<false>(Q2 + (size_t)(rt * 256) * N2 + h * 128, N2, WUK + (size_t)(ct * 128) * A_WIDTH + h * 128, A_WIDTH, 128, QL + (size_t)(rt * 256) * 8192 + h * 512 + ct * 128, 8192, 1.0f, c); }
    __syncthreads();
}
__device__ __forceinline__ void ph_oproj(const Params& p, const Ctx& c) {
    const bf16* OL = (const bf16*)(p.ws + WS_OLAT); const bf16* BTUV = (const bf16*)(p.ws + WS_BTUV); unsigned char* Y8 = p.ws + WS_YCAT;
    for (int u = c.bid; u < 16 * 32; u += c.nb) { const int h = u / 32, rt = u % 32;
        lds_gemm_unit<true>(OL + (size_t)(rt * 256) * 8192 + h * 512, 8192, BTUV + (size_t)(h * 128) * A_KVR, A_KVR, A_KVR, Y8 + (size_t)(rt * 256) * D + h * 128, D, 16.0f, c); }
    __syncthreads();
}

__device__ __forceinline__ void ph_scores(const Params& p, const Ctx& c) {
    const bf16* P1 = (const bf16*)(p.ws + WS_P1); const bf16* Q2 = (const bf16*)(p.ws + WS_Q2); const float* WIDX = (const float*)(p.ws + WS_WIDX); float* SC = (float*)(p.ws + WS_SC);
    constexpr int QPB = 272, QH = 32, QBYTES = QH * 16 * QPB;
    constexpr int WPB = 272; LAS unsigned char* wl = c.lds + QBYTES;
    const int tid = c.tid, lane = c.lane, w = c.wave, fr = lane & 15, fq = lane >> 4;
    for (int bu = c.bid; bu < NB * 64; bu += c.nb) {
        const int b = bu / 64, pr = bu % 64;
        for (int side = 0; side < 2; ++side) {
            const int qt = side ? 127 - pr : pr, nitems = qt / 4 + 1, t0 = b * SEQ + qt * 16;
            for (int half = 0; half < 2; ++half) {
                __syncthreads();
                if (half == 0 && tid < 256) { const int wq = tid >> 4, wc = tid & 15;
                    *(LAS f32x4*)(wl + wq * WPB + wc * 16) = *(const f32x4*)(WIDX + (size_t)(t0 + wq) * IDX_H + wc * 4); }
#pragma unroll
                for (int g = 0; g < 2; ++g) { v4u r[8];
#pragma unroll
                    for (int i = 0; i < 8; ++i) { const int q = tid + 512 * (g * 8 + i), hh = q >> 8, qq = (q >> 4) & 15, ch = q & 15;
                        r[i] = *(const v4u*)(Q2 + (size_t)(t0 + qq) * N2 + A_WIDTH + (half * QH + hh) * IDX_D + ch * 8); }
#pragma unroll
                    for (int i = 0; i < 8; ++i) { const int q = tid + 512 * (g * 8 + i);
                        *(LAS v4u*)(c.lds + (q >> 4) * QPB + (q & 15) * 16) = r[i]; } }
                LDS_WAIT(); __syncthreads();
                for (int item = w; item < nitems; item += 8) {
                    const int s0 = b * SEQ + item * 64;
                    bf16x8 kf[4][4];
#pragma unroll
                    for (int mi = 0; mi < 4; ++mi)
#pragma unroll
                        for (int ks = 0; ks < 4; ++ks) kf[mi][ks] = *(const bf16x8*)(P1 + (size_t)(s0 + 16 * mi + fr) * N1 + C_KI + 32 * ks + 8 * fq);
                    f32x4 sc[4];
                    float* scp = SC + (size_t)(t0 + fr) * SEQ + item * 64 + 4 * fq;
                    if (half) {
#pragma unroll
                        for (int mi = 0; mi < 4; ++mi) sc[mi] = *(const f32x4*)(scp + 16 * mi); }
                    else {
#pragma unroll
                        for (int mi = 0; mi < 4; ++mi) sc[mi] = (f32x4){0.f, 0.f, 0.f, 0.f}; }
                    __builtin_amdgcn_s_waitcnt(0x0F70);
                    const LAS unsigned char* wb = wl + fr * WPB + half * QH * 4;
                    const LAS unsigned char* qb = c.lds + fr * QPB + fq * 16;
#define SC_MM(A, hh) do { bf16x8 qf[4]; _Pragma("unroll") for (int ks = 0; ks < 4; ++ks) qf[ks] = *(const LAS bf16x8*)(buf + (hh) * 16 * QPB + ks * 64); \
                _Pragma("unroll") for (int mi = 0; mi < 4; ++mi) A[mi] = (f32x4){0.f, 0.f, 0.f, 0.f}; \
                _Pragma("unroll") for (int ks = 0; ks < 4; ++ks) _Pragma("unroll") for (int mi = 0; mi < 4; ++mi) A[mi] = __builtin_amdgcn_mfma_f32_16x16x32_bf16(kf[mi][ks], qf[ks], A[mi], 0, 0, 0); } while (0)
#define SC_EPI(A, hh) do { _Pragma("unroll") for (int mi = 0; mi < 4; ++mi) _Pragma("unroll") for (int j = 0; j < 4; ++j) sc[mi][j] += wv[hh] * __int_as_float(max(__float_as_int(A[mi][j]), 0)); } while (0)
#define SC_PIPE() do { _Pragma("unroll") for (int _q = 0; _q < 16; ++_q) { __builtin_amdgcn_sched_group_barrier(0x8, 1, 0); __builtin_amdgcn_sched_group_barrier(0x2, 2, 0); } } while (0)
                    for (int hg = 0; hg < QH / 4; ++hg) {
                        const LAS unsigned char* buf = qb + hg * 4 * 16 * QPB;
                        const f32x4 wv = *(const LAS f32x4*)(wb + hg * 16);
                        f32x4 a0[4], a1[4];
                        SC_MM(a0, 0);
                        SC_MM(a1, 1); SC_EPI(a0, 0); SC_PIPE();
                        SC_MM(a0, 2); SC_EPI(a1, 1); SC_PIPE();
                        SC_MM(a1, 3); SC_EPI(a0, 2); SC_PIPE();
                        SC_EPI(a1, 3);
                    }
#undef SC_MM
#undef SC_EPI
#undef SC_PIPE
#pragma unroll
                    for (int mi = 0; mi < 4; ++mi) *(f32x4*)(scp + 16 * mi) = sc[mi];
                }
            }
        }
    }
    __syncthreads();
}

__device__ __forceinline__ void ph_topk(const Params& p, const Ctx& c) {
    const float* SC = (const float*)(p.ws + WS_SC); int* SEL = (int*)(p.ws + WS_SEL); int* CNT = (int*)(p.ws + WS_CNT);
    const int lane = c.lane; const unsigned long long lt_mask = (1ull << lane) - 1ull;
    for (int t = c.gw; t < T; t += c.ngw) {
        const int pos = t % SEQ, qc = pos / CHUNK, nadm = (qc + 1) * CHUNK;
        int* so = SEL + (size_t)t * TOPK;
        if (nadm <= TOPK) { for (int i = lane; i < nadm; i += 64) so[i] = i; if (lane == 0) CNT[t] = nadm; continue; }
        unsigned key[32];
        const float* sr = SC + (size_t)t * SEQ;
#pragma unroll
        for (int j = 0; j < 32; ++j) { unsigned k = 0u; if (j <= qc) { const unsigned bits = __float_as_uint(sr[lane + 64 * j]); k = (bits & 0x80000000u) ? ~bits : (bits | 0x80000000u); } key[j] = k; }
        unsigned thr = 0u;
        for (int bit = 31; bit >= 0; --bit) { const unsigned cand = thr | (1u << bit); int cnt = 0;
#pragma unroll
            for (int j = 0; j < 32; ++j) cnt += __popcll(__ballot(key[j] >= cand));
            if (cnt >= TOPK) { thr = cand; if (cnt == TOPK) break; } }
        int ngt = 0;
#pragma unroll
        for (int j = 0; j < 32; ++j) ngt += __popcll(__ballot(key[j] > thr));
        const int need = TOPK - ngt; int base = 0, eqt = 0;
#pragma unroll
        for (int j = 0; j < 32; ++j) {
            const unsigned long long mg = __ballot(key[j] > thr), me = __ballot(key[j] == thr);
            const int erank = __popcll(me & lt_mask) + eqt; const bool esel = (key[j] == thr) && (erank < need);
            const unsigned long long ms = mg | __ballot(esel);
            if ((ms >> lane) & 1ull) so[base + __popcll(ms & lt_mask)] = lane + 64 * j;
            base += __popcll(ms); eqt += __popcll(me);
        }
        if (lane == 0) CNT[t] = TOPK;
    }
}

__device__ __forceinline__ int t5_bucket(int rel) {
    const int n = rel < 0 ? -rel : rel; int bk;
    if (n < 8) bk = n; else { const int n2 = n * n; int k = 0;
#pragma unroll
        for (int j = 1; j <= 7; ++j) k += (n2 >= (64 << j)) ? 1 : 0;
        bk = 8 + k; }
    return (rel > 0 ? 16 : 0) + bk;
}
__device__ __forceinline__ bf16x4 tr_read4(unsigned addr, int) { bf16x4 r; asm volatile("ds_read_b64_tr_b16 %0, %1\n\ts_waitcnt lgkmcnt(0)" : "=&v"(r) : "v"(addr) : "memory"); return r; }
#define TR_READ(dst, addr, OFF) asm volatile("ds_read_b64_tr_b16 %0, %1 offset:%2" : "=&v"(dst) : "v"(addr), "i"(OFF) : "memory")

constexpr int KV_PITCH = 1056;
constexpr int ATT_LDS_END = 8 * 16 * KV_PITCH + 64 + 2048;
__device__ __forceinline__ void ph_attn(const Params& p, const Ctx& c) {
    const bf16* CKV = (const bf16*)(p.ws + WS_CKV); const bf16* QL = (const bf16*)(p.ws + WS_QL); const int* SEL = (const int*)(p.ws + WS_SEL); const int* CNT = (const int*)(p.ws + WS_CNT);
    bf16* OL = (bf16*)(p.ws + WS_OLAT);
    const int lane = c.lane, fr = lane & 15, fq = lane >> 4;
    const int cw = c.wave & 3;
    LAS unsigned char* buf0 = c.lds + cw * (32 * KV_PITCH);
    const unsigned bufa = (unsigned)(size_t)buf0;
    const unsigned tr_base0 = bufa + (unsigned)((4 * fq + (fr >> 2)) * KV_PITCH + (fr & 3) * 8);
    const float t5b_scale = 0.08838834764831845f;
    LAS float* t5l = (LAS float*)(c.lds + 8 * 16 * KV_PITCH + 64);
    unsigned* ctl = (unsigned*)(p.ws + WS_CTL);
    LAS unsigned* xm = (LAS unsigned*)(c.lds + 8 * 16 * KV_PITCH);
    if (c.tid == 0) { const unsigned x = xb_xcc_id(); unsigned pre = 0, tot = 0;
        for (unsigned j = 0; j < 16; ++j) { const unsigned n = xb_ld(&ctl[XB_XCNT(j)]); pre += (j < x) ? n : 0u; tot += n; }
        const bool ok = (tot == (unsigned)c.nb) && (T % (c.nb * 4) == 0);
        unsigned rk = 0; if (ok) rk = xb_add(&ctl[XB_ATT_RANK + 64 * x], 1u);
        xm[0] = ok ? (pre + rk) : 0xffffffffu; }
    t5l[c.tid] = p.t5[c.tid];
    __syncthreads();
    const unsigned vbx = xm[0]; const bool xmap = (vbx != 0xffffffffu);
    const int naw = c.nb * 4;
    if (c.wave >= 4) { for (int it = c.bid * 4 + (c.wave - 4); it < 1024; it += naw) adaln_late(p, it, c.lane); convert_late_weights(p, (LAS float*)(c.lds + ATT_LDS_END + (c.wave - 4) * 4224), c.lane, c.bid * 4 + (c.wave - 4), naw); convert_expert_rows(p, c, c.bid * 4 + (c.wave - 4), naw); }
    if (c.wave < 4)
    for (int it = c.bid * 4 + cw; it < T; it += naw) {
        int t = it;
        if (xmap) { const int base = (int)vbx * 4 + cw;
            const int bsz = naw / NB, q = it / naw;
            t = (base / bsz) * SEQ + (base % bsz) + q * bsz; }
        const int b = t / SEQ, pos = t % SEQ;
        const int cnt = CNT[t];
        int s0 = 0, s1 = 0, s2 = 0, s3 = 0;
        if (lane < cnt) s0 = SEL[(size_t)t * TOPK + lane];
        if (lane + 64 < cnt) s1 = SEL[(size_t)t * TOPK + 64 + lane];
        if (lane + 128 < cnt) s2 = SEL[(size_t)t * TOPK + 128 + lane];
        if (lane + 192 < cnt) s3 = SEL[(size_t)t * TOPK + 192 + lane];
        const bf16* kvb = CKV + (size_t)(b * SEQ) * A_KVR + lane * 8;
        const int nch = cnt >> 4;
#define ATT_GATHER(ch_) do { const int _c = (ch_); const int _sj = (_c < 4) ? s0 : (_c < 8) ? s1 : (_c < 12) ? s2 : s3; const int _lb = (_c & 3) * 16; \
            LAS unsigned char* _b = buf0 + (_c & 1) * (16 * KV_PITCH); \
            _Pragma("unroll") for (int r = 0; r < 16; ++r) { const int idx = __builtin_amdgcn_readlane(_sj, _lb + r); \
                __builtin_amdgcn_global_load_lds((const unsigned*)(kvb + (size_t)idx * A_KVR), (LAS unsigned*)(_b + r * KV_PITCH), 16, 0, 0); } } while (0)
        ATT_GATHER(0);
        bf16x8 qf[16];
#pragma unroll
        for (int ks = 0; ks < 16; ++ks) qf[ks] = *(const bf16x8*)(QL + (size_t)t * 8192 + fr * 512 + ks * 32 + fq * 8);
        f32x4 acc[32];
#pragma unroll
        for (int mt = 0; mt < 32; ++mt) acc[mt] = (f32x4){0.f, 0.f, 0.f, 0.f};
        float m_run = -INFINITY, l_run = 0.f;
        float bias[4];
#define ATT_BIAS(ch_) do { const int _c = (ch_); const int _sj = (_c < 4) ? s0 : (_c < 8) ? s1 : (_c < 12) ? s2 : s3; const int _lb = (_c & 3) * 16; \
            _Pragma("unroll") for (int j = 0; j < 4; ++j) { const int kidx = __shfl(_sj, _lb + 4 * fq + j); bias[j] = t5l[t5_bucket(kidx - pos) * A_HEADS + fr]; } } while (0)
        for (int ch = 0; ch < nch; ++ch) {
            ATT_BIAS(ch);
            if (ch + 1 < nch) { ATT_GATHER(ch + 1); asm volatile("s_waitcnt vmcnt(16)" ::: "memory"); } else { asm volatile("s_waitcnt vmcnt(0)" ::: "memory"); }
            LAS unsigned char* buf = buf0 + (ch & 1) * (16 * KV_PITCH);
            const unsigned tr_base = tr_base0 + (unsigned)((ch & 1) * (16 * KV_PITCH));
            f32x4 sa = {0.f, 0.f, 0.f, 0.f}, sb = sa;
#pragma unroll
            for (int ks = 0; ks < 16; ks += 2) {
                const bf16x8 a0 = *(const LAS bf16x8*)(buf + fr * KV_PITCH + (ks + 0) * 64 + fq * 16), a1 = *(const LAS bf16x8*)(buf + fr * KV_PITCH + (ks + 1) * 64 + fq * 16);
                sa = __builtin_amdgcn_mfma_f32_16x16x32_bf16(a0, qf[ks + 0], sa, 0, 0, 0); sb = __builtin_amdgcn_mfma_f32_16x16x32_bf16(a1, qf[ks + 1], sb, 0, 0, 0); }
            const f32x4 s = sa + sb;
            float lg[4]; float mc = -INFINITY;
#pragma unroll
            for (int j = 0; j < 4; ++j) { lg[j] = s[j] * t5b_scale + bias[j]; mc = fmaxf(mc, lg[j]); }
            mc = fmaxf(mc, __shfl_xor(mc, 16)); mc = fmaxf(mc, __shfl_xor(mc, 32));
            if (__ballot(mc > m_run + 8.0f)) { const float m_new = fmaxf(m_run, mc); const float alpha = __expf(m_run - m_new); l_run *= alpha; m_run = m_new;
#pragma unroll
                for (int mt = 0; mt < 32; ++mt) acc[mt] *= alpha; }
            float pe[4]; float ps = 0.f;
#pragma unroll
            for (int j = 0; j < 4; ++j) { pe[j] = __expf(lg[j] - m_run); ps += pe[j]; }
            l_run += ps;
            v2u pw; pw.x = cvt_pk_bf16(pe[0], pe[1]); pw.y = cvt_pk_bf16(pe[2], pe[3]);
            const unsigned qx = (unsigned)__shfl_xor((int)pw.x, 32), qy = (unsigned)__shfl_xor((int)pw.y, 32);
            const bool lowg = fq < 2;
            const v4u pb4 = lowg ? (v4u){pw.x, pw.y, qx, qy} : (v4u){0u, 0u, 0u, 0u};
            const bf16x8 pb = __builtin_bit_cast(bf16x8, pb4);
            const unsigned tr2 = tr_base + (unsigned)((lowg ? 8 : -8) * KV_PITCH);
            bf16x4 ta[2], tb[2], ua[2], ub[2];
#define ATT_TR(d1, d2, g) do { _Pragma("unroll") for (int i = 0; i < 2; ++i) { TR_READ(d1[i], tr_base, ((g) * 2 + i) * 32); TR_READ(d2[i], tr2, ((g) * 2 + i) * 32); } } while (0)
#define ATT_MM(s1, s2, g) do { _Pragma("unroll") for (int i = 0; i < 2; ++i) acc[(g) * 2 + i] = __builtin_amdgcn_mfma_f32_16x16x32_bf16(__builtin_shufflevector(s1[i], s2[i], 0, 1, 2, 3, 4, 5, 6, 7), pb, acc[(g) * 2 + i], 0, 0, 0); } while (0)
            ATT_TR(ta, ua, 0);
#pragma unroll
            for (int g = 0; g < 16; g += 2) {
                ATT_TR(tb, ub, g + 1);
                asm volatile("s_waitcnt lgkmcnt(4)" : "+v"(ta[0]), "+v"(ta[1]), "+v"(ua[0]), "+v"(ua[1]) :: "memory");
                ATT_MM(ta, ua, g);
                if (g + 2 < 16) ATT_TR(ta, ua, g + 2);
                if (g + 2 < 16) asm volatile("s_waitcnt lgkmcnt(4)" : "+v"(tb[0]), "+v"(tb[1]), "+v"(ub[0]), "+v"(ub[1]) :: "memory");
                else asm volatile("s_waitcnt lgkmcnt(0)" : "+v"(tb[0]), "+v"(tb[1]), "+v"(ub[0]), "+v"(ub[1]) :: "memory");
                ATT_MM(tb, ub, g + 1);
            }
#undef ATT_TR
#undef ATT_MM
            asm volatile("" ::: "memory");
        }
#undef ATT_BIAS
#undef ATT_GATHER
        float lt = l_run; lt += __shfl_xor(lt, 16); lt += __shfl_xor(lt, 32);
        const float il = 1.0f / lt;
        bf16* orow = OL + (size_t)t * 8192 + fr * 512 + 4 * fq;
#pragma unroll
        for (int mt = 0; mt < 32; ++mt) { v2u w; w.x = cvt_pk_bf16(acc[mt][0] * il, acc[mt][1] * il); w.y = cvt_pk_bf16(acc[mt][2] * il, acc[mt][3] * il); *(v2u*)(orow + 16 * mt) = w; }
    }
    __syncthreads();
}

#define TR_PAIR(dst, addr, PITCH4) do { bf16x4 _lo, _hi; \
    asm volatile("ds_read_b64_tr_b16 %0, %2\n\tds_read_b64_tr_b16 %1, %2 offset:%3\n\ts_waitcnt lgkmcnt(0)" : "=&v"(_lo), "=&v"(_hi) : "v"(addr), "i"(PITCH4) : "memory"); \
    dst = __builtin_shufflevector(_lo, _hi, 0, 1, 2, 3, 4, 5, 6, 7); } while (0)

constexpr size_t WS_SN = 1464 * MiB;
__device__ __forceinline__ void ph_ret_state(const Params& p, const Ctx& c) {
    const bf16* P1 = (const bf16*)(p.ws + WS_P1); bf16* SN = (bf16*)(p.ws + WS_SN);
    constexpr int KPB = 272, VPB = 80;
    LAS unsigned char* ktb = c.lds; LAS unsigned char* vtb = c.lds + 2 * 64 * KPB;
    const int tid = c.tid, lane = c.lane, w = c.wave, fr = lane & 15, fq = lane >> 4;
    for (int u = c.bid; u < NB * R_HEADS * 8; u += c.nb) {
        const int b = u / 64, h = (u / 8) % 8, vsl = u % 8;
        const float gam = 1.0f - exp2f(-5.0f - (float)h), lgm = logf(gam), dec64 = __expf(64.0f * lgm);
        f32x4 acc[2] = {{0.f, 0.f, 0.f, 0.f}, {0.f, 0.f, 0.f, 0.f}};
        const int kr0 = tid >> 4, kc0 = tid & 15;
        const int vr = tid >> 2, vc = tid & 3;
        const bf16* kbase = P1 + (size_t)(b * SEQ) * N1 + C_RK + h * 128 + kc0 * 8;
        const bf16* vbase = P1 + (size_t)(b * SEQ) * N1 + C_RV + h * 256 + vsl * 32 + vc * 8;
        const float sc0 = __expf((float)(63 - kr0) * lgm), sc1 = __expf((float)(31 - kr0) * lgm);
        v4u ka, kb, va = {0u, 0u, 0u, 0u};
        ka = *(const v4u*)(kbase + (size_t)kr0 * N1); kb = *(const v4u*)(kbase + (size_t)(kr0 + 32) * N1); if (tid < 256) va = *(const v4u*)(vbase + (size_t)vr * N1);
        __syncthreads();
        for (int n = 0; n < SEQ / CHUNK; ++n) {
            LAS unsigned char* kt = ktb + (n & 1) * 64 * KPB; LAS unsigned char* vt = vtb + (n & 1) * 64 * VPB;
            { v4u o; o.x = cvt_pk_bf16(bflo(ka.x) * sc0, bfhi(ka.x) * sc0); o.y = cvt_pk_bf16(bflo(ka.y) * sc0, bfhi(ka.y) * sc0); o.z = cvt_pk_bf16(bflo(ka.z) * sc0, bfhi(ka.z) * sc0); o.w = cvt_pk_bf16(bflo(ka.w) * sc0, bfhi(ka.w) * sc0);
              *(LAS v4u*)(kt + kr0 * KPB + kc0 * 16) = o;
              o.x = cvt_pk_bf16(bflo(kb.x) * sc1, bfhi(kb.x) * sc1); o.y = cvt_pk_bf16(bflo(kb.y) * sc1, bfhi(kb.y) * sc1); o.z = cvt_pk_bf16(bflo(kb.z) * sc1, bfhi(kb.z) * sc1); o.w = cvt_pk_bf16(bflo(kb.w) * sc1, bfhi(kb.w) * sc1);
              *(LAS v4u*)(kt + (kr0 + 32) * KPB + kc0 * 16) = o;
              if (tid < 256) *(LAS v4u*)(vt + vr * VPB + vc * 16) = va; }
            if (n + 1 < SEQ / CHUNK) { const size_t ro = (size_t)((n + 1) * CHUNK) * N1;
                ka = *(const v4u*)(kbase + ro + (size_t)kr0 * N1); kb = *(const v4u*)(kbase + ro + (size_t)(kr0 + 32) * N1); if (tid < 256) va = *(const v4u*)(vbase + ro + (size_t)vr * N1); }
            { bf16* sp = SN + ((size_t)((b * R_HEADS + h) * 32 + n) * 256 + vsl * 32 + fr) * 128 + 16 * w + 4 * fq;
#pragma unroll
              for (int nt = 0; nt < 2; ++nt) { v2u o; o.x = cvt_pk_bf16(acc[nt][0], acc[nt][1]); o.y = cvt_pk_bf16(acc[nt][2], acc[nt][3]); *(v2u*)(sp + (size_t)(16 * nt) * 128) = o; acc[nt] *= dec64; } }
            LDS_WAIT(); __syncthreads();
            const unsigned ka_addr = (unsigned)(size_t)kt + (unsigned)((8 * fq + (fr >> 2)) * KPB + (16 * w + 4 * (fr & 3)) * 2);
            const unsigned va_addr = (unsigned)(size_t)vt + (unsigned)((8 * fq + (fr >> 2)) * VPB + (4 * (fr & 3)) * 2);
#pragma unroll
            for (int ks = 0; ks < 2; ++ks) { bf16x8 af, b0, b1;
                TR_PAIR(af, ka_addr + ks * 32 * KPB, 4 * KPB); TR_PAIR(b0, va_addr + ks * 32 * VPB, 4 * VPB); TR_PAIR(b1, va_addr + ks * 32 * VPB + 32, 4 * VPB);
                acc[0] = __builtin_amdgcn_mfma_f32_16x16x32_bf16(af, b0, acc[0], 0, 0, 0); acc[1] = __builtin_amdgcn_mfma_f32_16x16x32_bf16(af, b1, acc[1], 0, 0, 0); }
        }
        __syncthreads();
    }
}
__device__ __forceinline__ void ph_ret_out(const Params& p, const Ctx& c) {
    const bf16* P1 = (const bf16*)(p.ws + WS_P1); const bf16* SN = (const bf16*)(p.ws + WS_SN); unsigned char* Y8 = p.ws + WS_YCAT;
    constexpr int QPB = 272, VPB = 528, APB = 144;
    LAS unsigned char* qt = c.lds; LAS unsigned char* kt = qt + 64 * QPB; LAS unsigned char* vt = kt + 64 * QPB; LAS unsigned char* at = vt + 64 * VPB;
    LAS float* red = (LAS float*)(at + 64 * APB);
    const int tid = c.tid, lane = c.lane, w = c.wave, fr = lane & 15, fq = lane >> 4;
    for (int u = c.bid; u < NB * 32 * R_HEADS; u += c.nb) {
        const int b = u / 256, n = (u / 8) % 32, h = u % 8;
        const float gam = 1.0f - exp2f(-5.0f - (float)h), lgm = logf(gam);
        const size_t t0 = (size_t)b * SEQ + n * CHUNK;
        __syncthreads();
        for (int i = tid; i < 64 * 16; i += NTHR) { const int l = i >> 4, ch = i & 15;
            *(LAS v4u*)(qt + l * QPB + ch * 16) = *(const v4u*)(P1 + (t0 + l) * N1 + C_RQ + h * 128 + ch * 8);
            *(LAS v4u*)(kt + l * QPB + ch * 16) = *(const v4u*)(P1 + (t0 + l) * N1 + C_RK + h * 128 + ch * 8); }
        for (int i = tid; i < 64 * 32; i += NTHR) { const int l = i >> 5, ch = i & 31; *(LAS v4u*)(vt + l * VPB + ch * 16) = *(const v4u*)(P1 + (t0 + l) * N1 + C_RV + h * 256 + ch * 8); }
        __syncthreads();
        { const int pt = w & 3, lt0 = 2 * (w >> 2);
          f32x4 a0 = {0.f, 0.f, 0.f, 0.f}, a1 = a0;
#pragma unroll
          for (int ks = 0; ks < 4; ++ks) { const bf16x8 qf = *(const LAS bf16x8*)(qt + (16 * pt + fr) * QPB + ks * 64 + fq * 16);
              const bf16x8 k0 = *(const LAS bf16x8*)(kt + (16 * lt0 + fr) * QPB + ks * 64 + fq * 16), k1 = *(const LAS bf16x8*)(kt + (16 * lt0 + 16 + fr) * QPB + ks * 64 + fq * 16);
              a0 = __builtin_amdgcn_mfma_f32_16x16x32_bf16(k0, qf, a0, 0, 0, 0); a1 = __builtin_amdgcn_mfma_f32_16x16x32_bf16(k1, qf, a1, 0, 0, 0); }
          const int pos = 16 * pt + fr;
#pragma unroll
          for (int j = 0; j < 4; ++j) { const int l0 = 16 * lt0 + 4 * fq + j, l1 = l0 + 16;
              a0[j] = (pos >= l0) ? a0[j] * __expf((float)(pos - l0) * lgm) : 0.f; a1[j] = (pos >= l1) ? a1[j] * __expf((float)(pos - l1) * lgm) : 0.f; }
          v2u o; o.x = cvt_pk_bf16(a0[0], a0[1]); o.y = cvt_pk_bf16(a0[2], a0[3]); *(LAS v2u*)(at + pos * APB + (16 * lt0 + 4 * fq) * 2) = o;
          o.x = cvt_pk_bf16(a1[0], a1[1]); o.y = cvt_pk_bf16(a1[2], a1[3]); *(LAS v2u*)(at + pos * APB + (16 * lt0 + 16 + 4 * fq) * 2) = o; }
        f32x4 acc[2][4];
#pragma unroll
        for (int mi = 0; mi < 2; ++mi)
#pragma unroll
            for (int pt = 0; pt < 4; ++pt) acc[mi][pt] = (f32x4){0.f, 0.f, 0.f, 0.f};
        { const bf16* sp = SN + ((size_t)((b * R_HEADS + h) * 32 + n) * 256 + 32 * w + fr) * 128 + 8 * fq;
#pragma unroll
          for (int ks = 0; ks < 4; ++ks) { const bf16x8 s0 = *(const bf16x8*)(sp + ks * 32), s1 = *(const bf16x8*)(sp + 16 * 128 + ks * 32);
#pragma unroll
              for (int pt = 0; pt < 4; ++pt) { const bf16x8 qf = *(const LAS bf16x8*)(qt + (16 * pt + fr) * QPB + ks * 64 + fq * 16);
                  acc[0][pt] = __builtin_amdgcn_mfma_f32_16x16x32_bf16(s0, qf, acc[0][pt], 0, 0, 0); acc[1][pt] = __builtin_amdgcn_mfma_f32_16x16x32_bf16(s1, qf, acc[1][pt], 0, 0, 0); } } }
#pragma unroll
        for (int pt = 0; pt < 4; ++pt) { const float dq = __expf((float)(16 * pt + fr + 1) * lgm); acc[0][pt] *= dq; acc[1][pt] *= dq; }
        LDS_WAIT(); __syncthreads();
        { const unsigned v_addr = (unsigned)(size_t)vt + (unsigned)((8 * fq + (fr >> 2)) * VPB + (32 * w + 4 * (fr & 3)) * 2);
#pragma unroll
          for (int ks = 0; ks < 2; ++ks) { bf16x8 v0, v1; TR_PAIR(v0, v_addr + ks * 32 * VPB, 4 * VPB); TR_PAIR(v1, v_addr + ks * 32 * VPB + 32, 4 * VPB);
#pragma unroll
              for (int pt = 0; pt < 4; ++pt) { const bf16x8 af = *(const LAS bf16x8*)(at + (16 * pt + fr) * APB + ks * 64 + fq * 16);
                  acc[0][pt] = __builtin_amdgcn_mfma_f32_16x16x32_bf16(v0, af, acc[0][pt], 0, 0, 0); acc[1][pt] = __builtin_amdgcn_mfma_f32_16x16x32_bf16(v1, af, acc[1][pt], 0, 0, 0); } } }
#pragma unroll
        for (int pt = 0; pt < 4; ++pt) { float s = 0.f;
#pragma unroll
            for (int mi = 0; mi < 2; ++mi)
#pragma unroll
                for (int j = 0; j < 4; ++j) s += acc[mi][pt][j] * acc[mi][pt][j];
            s += __shfl_xor(s, 16); s += __shfl_xor(s, 32);
            if (lane < 16) red[w * 64 + 16 * pt + lane] = s; }
        LDS_WAIT(); __syncthreads();
#pragma unroll
        for (int pt = 0; pt < 4; ++pt) { const int pos = 16 * pt + fr; float ss = 0.f;
#pragma unroll
            for (int ww = 0; ww < 8; ++ww) ss += red[ww * 64 + pos];
            const float rstd = 1.0f / sqrtf(ss * (1.0f / R_V) + EPS);
#pragma unroll
            for (int mi = 0; mi < 2; ++mi) { const int dv = 32 * w + 16 * mi + 4 * fq;
                const f32x4 g = *(const f32x4*)(p.g_ret + h * 256 + dv);
                const v2u rg = *(const v2u*)(P1 + (t0 + pos) * N1 + C_RG + h * 256 + dv);
                const float r0 = bflo(rg.x), r1 = bfhi(rg.x), r2 = bflo(rg.y), r3 = bfhi(rg.y);
                const float rs = rstd * 16.0f; int q = 0;
                q = PK_FP8(r0 * sigmoidf_(r0) * acc[mi][pt][0] * rs * g.x, r1 * sigmoidf_(r1) * acc[mi][pt][1] * rs * g.y, q, false);
                q = PK_FP8(r2 * sigmoidf_(r2) * acc[mi][pt][2] * rs * g.z, r3 * sigmoidf_(r3) * acc[mi][pt][3] * rs * g.w, q, true);
                *(unsigned*)(Y8 + (t0 + pos) * D + A_WIDTH + h * 256 + dv) = (unsigned)q; } }
    }
    __syncthreads();
}

__device__ __forceinline__ unsigned fkey(float f) { const unsigned b = __float_as_uint(f); return (b & 0x80000000u) ? ~b : (b | 0x80000000u); }
typedef __bf16 bf16x2_r __attribute__((ext_vector_type(2)));
template <int NV> __device__ __forceinline__ unsigned tok_thr16(const unsigned (&k)[NV]) {
    unsigned thr = 0u; bool done = false;
    for (int bit = 31; bit >= 0; --bit) { const unsigned cand = thr | (1u << bit); int cnt = 0;
#pragma unroll
        for (int i = 0; i < NV; ++i) cnt += (k[i] >= cand) ? 1 : 0;
        cnt += __shfl_xor(cnt, 16); cnt += __shfl_xor(cnt, 32);
        if (!done && cnt >= P_TOPK) { thr = cand; done = (cnt == P_TOPK); }
        if (!__ballot(!done)) break; }
    return thr;
}
__device__ __forceinline__ void ph_peer_route(const Params& p, const Ctx& c) {
    const bf16* PQ = (const bf16*)(p.ws + WS_PQ); const bf16* SK = (const bf16*)(p.ws + WS_SK); int* EID = (int*)(p.ws + WS_EID); float* GATE = (float*)(p.ws + WS_GATE);
    constexpr int KP = 272;
    LAS unsigned char* sk = c.lds;
    LAS float* wl = (LAS float*)(c.lds + 2 * 128 * KP) + c.wave * 1536;
    LAS float* v1l = wl; LAS int* i1l = (LAS int*)(wl + 256); LAS float* v2l = wl + 512; LAS int* i2l = (LAS int*)(wl + 768); LAS float* tvl = wl + 1024; LAS int* tel = (LAS int*)(wl + 1280);
    const int lane = c.lane, fr = lane & 15, fq = lane >> 4;
    __syncthreads();
    for (int i = c.tid; i < 2 * 128 * 16; i += NTHR) { const int r = i >> 4, ch = i & 15; *(LAS v4u*)(sk + r * KP + ch * 16) = *(const v4u*)(SK + r * 128 + ch * 8); }
    __syncthreads();
    for (int u = c.gw; u < (T / 16) * P_HEADS; u += c.ngw) {
        const int tgp = u / P_HEADS, h = u % P_HEADS, t = tgp * 16 + fr;
        unsigned ka[32], kb[32]; float sva[32], svb[32];
#pragma unroll
        for (int half = 0; half < 2; ++half) {
            f32x4 acc[8];
#pragma unroll
            for (int mt = 0; mt < 8; ++mt) acc[mt] = (f32x4){0.f, 0.f, 0.f, 0.f};
#pragma unroll
            for (int ks = 0; ks < 4; ++ks) { const bf16x8 qf = *(const bf16x8*)(PQ + (size_t)t * 2048 + h * 256 + half * 128 + ks * 32 + fq * 8);
#pragma unroll
                for (int mt = 0; mt < 8; ++mt) { const bf16x8 kf = *(const LAS bf16x8*)(sk + (half * 128 + 16 * mt + fr) * KP + ks * 64 + fq * 16); acc[mt] = __builtin_amdgcn_mfma_f32_16x16x32_bf16(kf, qf, acc[mt], 0, 0, 0); } }
#pragma unroll
            for (int mt = 0; mt < 8; ++mt)
#pragma unroll
                for (int j = 0; j < 4; ++j) { if (half == 0) { sva[mt * 4 + j] = acc[mt][j]; ka[mt * 4 + j] = fkey(acc[mt][j]); } else { svb[mt * 4 + j] = acc[mt][j]; kb[mt * 4 + j] = fkey(acc[mt][j]); } }
        }
#define ROUTE_EMIT(K, V, NV, thr, VL, IL, IDX) do { int ngl = 0, nel = 0; \
            _Pragma("unroll") for (int i = 0; i < NV; ++i) { ngl += (K[i] > thr) ? 1 : 0; nel += (K[i] == thr) ? 1 : 0; } \
            int pg = 0, pe = 0, ngt = 0; \
            _Pragma("unroll") for (int q = 0; q < 4; ++q) { const int cg = __shfl(ngl, fr + 16 * q), ce = __shfl(nel, fr + 16 * q); pg += (q < fq) ? cg : 0; pe += (q < fq) ? ce : 0; ngt += cg; } \
            const int need = P_TOPK - ngt; \
            _Pragma("unroll") for (int i = 0; i < NV; ++i) { int slot = -1; \
                if (K[i] > thr) { slot = pg; ++pg; } else if (K[i] == thr) { if (pe < need) slot = ngt + pe; ++pe; } \
                if (slot >= 0) { VL[fr * 16 + slot] = V[i]; IL[fr * 16 + slot] = IDX(i); } } } while (0)
#define KEYIDX(i) (16 * ((i) >> 2) + 4 * fq + ((i) & 3))
        { const unsigned ta = tok_thr16<32>(ka); ROUTE_EMIT(ka, sva, 32, ta, v1l, i1l, KEYIDX);
          const unsigned tb = tok_thr16<32>(kb); ROUTE_EMIT(kb, svb, 32, tb, v2l, i2l, KEYIDX); }
        LDS_WAIT();
        float cd[64]; unsigned ck[64];
        { const f32x4 va = *(const LAS f32x4*)(v1l + fr * 16 + 4 * fq);
#pragma unroll
          for (int bq = 0; bq < 4; ++bq) { const f32x4 vb = *(const LAS f32x4*)(v2l + fr * 16 + 4 * bq);
#pragma unroll
              for (int ai = 0; ai < 4; ++ai)
#pragma unroll
                  for (int bj = 0; bj < 4; ++bj) { const float v = va[ai] + vb[bj]; cd[ai * 16 + bq * 4 + bj] = v; ck[ai * 16 + bq * 4 + bj] = fkey(v); } } }
#define CANDEID(i) (i1l[fr * 16 + 4 * fq + ((i) >> 4)] * P_NK + i2l[fr * 16 + ((i) & 15)])
        { const unsigned tc = tok_thr16<64>(ck); ROUTE_EMIT(ck, cd, 64, tc, tvl, tel, CANDEID); }
#undef ROUTE_EMIT
#undef KEYIDX
#undef CANDEID
        LDS_WAIT();
        { const f32x4 tv = *(const LAS f32x4*)(tvl + fr * 16 + 4 * fq); const v4u te = *(const LAS v4u*)(tel + fr * 16 + 4 * fq);
          float mx = fmaxf(fmaxf(tv[0], tv[1]), fmaxf(tv[2], tv[3])); mx = fmaxf(mx, __shfl_xor(mx, 16)); mx = fmaxf(mx, __shfl_xor(mx, 32));
          f32x4 e; float sm = 0.f;
#pragma unroll
          for (int j = 0; j < 4; ++j) { e[j] = __expf(tv[j] - mx); sm += e[j]; }
          sm += __shfl_xor(sm, 16); sm += __shfl_xor(sm, 32);
          const float inv = 1.0f / sm;
          *(v4u*)(EID + (size_t)t * 128 + h * 16 + 4 * fq) = te; *(f32x4*)(GATE + (size_t)t * 128 + h * 16 + 4 * fq) = e * inv; }
        LDS_WAIT();
    }
    __syncthreads();
}
typedef __bf16 bf16x2_t __attribute__((ext_vector_type(2)));
typedef float v32f_t __attribute__((ext_vector_type(32))); typedef unsigned v6u_t __attribute__((ext_vector_type(6))); typedef __bf16 v32bf_t __attribute__((ext_vector_type(32)));
typedef unsigned v16u_t __attribute__((ext_vector_type(16)));
__device__ __forceinline__ void ld48(const unsigned char* ptr, int lane8, v6u_t& w0, v6u_t& w1) { const v4u a = *(const v4u*)ptr, c = *(const v4u*)(ptr + 2048); const v2u_t b0 = *(const v2u_t*)(ptr + 1024 - (lane8)), b1 = *(const v2u_t*)(ptr + 1536 - (lane8));
    w0 = (v6u_t){a.x, a.y, a.z, a.w, b0.x, b0.y}; w1 = (v6u_t){b1.x, b1.y, c.x, c.y, c.z, c.w}; }
#ifndef PG
#define PG 2
#endif
constexpr size_t WS_DP = WS_P1, WS_CF = WS_P1 + 64 * MiB, WS_SS = WS_P1 + 68 * MiB;
#define XB_PEER_RANK(k) (5120 + 1024 * (k))
struct PeerMap { int s0, ns, tw, tstride; };
__device__ __forceinline__ PeerMap peer_map(const Params& p, const Ctx& c, int k) {
    unsigned* ctl = (unsigned*)(p.ws + WS_CTL); LAS unsigned* xm = (LAS unsigned*)(c.lds + 16384);
    __syncthreads();
    if (c.tid == 0) { const unsigned x = xb_xcc_id(); unsigned pre = 0, tot = 0; bool eq = true;
        for (unsigned j = 0; j < 16; ++j) { const unsigned n = xb_ld(&ctl[XB_XCNT(j)]); pre += (j < x) ? n : 0u; tot += n; eq = eq && (j < 8 ? n == 32u : n == 0u); }
        const bool ok = eq && (tot == (unsigned)c.nb) && (c.nb == 256) && (x < 8);
        unsigned rk = 0; if (ok) rk = xb_add(&ctl[XB_PEER_RANK(k) + 64 * x], 1u);
        xm[0] = (ok && rk < 32u) ? (x * 32u + rk) : 0xffffffffu; }
    __syncthreads();
    const unsigned v = xm[0]; PeerMap m;
    if (v != 0xffffffffu) { m.s0 = 2 * (int)(v >> 5); m.ns = 2; m.tw = (int)(v & 31u) * NWAVES + c.wave; m.tstride = 32 * NWAVES; }
    else { m.s0 = 0; m.ns = 16; m.tw = c.gw; m.tstride = c.ngw; }
    return m;
}
__device__ __forceinline__ v6u_t ld24o(const unsigned char* tab, unsigned e, unsigned ca, unsigned cb) { const unsigned oa = e * 192u + ca, ob = e * 192u + cb;
    const v4u a = *(const v4u*)(tab + (size_t)oa); const v2u_t b = *(const v2u_t*)(tab + (size_t)ob); return (v6u_t){a.x, a.y, a.z, a.w, b.x, b.y}; }
__device__ __forceinline__ v6u_t ld24(const unsigned char* row, int ch8) { const v4u a = *(const v4u*)(row + ch8 * 16); const v2u_t b = *(const v2u_t*)(row + 128 + ch8 * 8); return (v6u_t){a.x, a.y, a.z, a.w, b.x, b.y}; }
__device__ __forceinline__ void ph_peer_u(const Params& p, const Ctx& c) {
    const bf16* H = (const bf16*)(p.ws + WS_H); const int* EID = (const int*)(p.ws + WS_EID);
#ifdef PEER_PROBE
    const int emask = p.dummy ? (PEER_PROBE) : -1; float* DP = (float*)(p.ws + WS_DP + (p.dummy ? 128 * MiB : 0));
#else
    constexpr int emask = -1; float* DP = (float*)(p.ws + WS_DP);
#endif
    const PeerMap m = peer_map(p, c, 0);
    const int lane = c.lane, ch8 = lane & 7, grp = lane >> 3; const bool b2 = lane & 4, b1 = lane & 2, b0 = lane & 1;
    const int ntok = (m.tw < T) ? (T - m.tw + m.tstride - 1) / m.tstride : 0, nitems = m.ns * ntok;
    if (nitems == 0) return;
#define IT_S(k) (m.s0 + (k) / ntok)
#define IT_T(k) (m.tw + ((k) % ntok) * m.tstride)
    int ev[16], evn[16]; unsigned xpn[16]; f32x2 xf[16]; v6u_t A[4], B[4];
#define SU_IDX(EV, XP, s_, t_) do { _Pragma("unroll") for (int i = 0; i < 16; ++i) EV[i] = EID[(size_t)(t_) * 128 + 8 * i + grp] & emask; \
        _Pragma("unroll") for (int k = 0; k < 4; ++k) { const v4u a = *(const v4u*)(H + (size_t)(t_) * D + (s_) * 256 + ch8 * 32 + k * 8); XP[k * 4 + 0] = a.x; XP[k * 4 + 1] = a.y; XP[k * 4 + 2] = a.z; XP[k * 4 + 3] = a.w; } } while (0)
#define SU_LD(R, EV, TAB, i0) do { _Pragma("unroll") for (int j = 0; j < 4; ++j) R[j] = ld24o((TAB), (unsigned)EV[(i0) + j], ca, cb); } while (0)
#define SU_USE(R, i0) do { _Pragma("unroll") for (int j = 0; j < 4; ++j) { const v32f_t uf = __builtin_amdgcn_cvt_scalef32_pk32_f32_fp6(R[j], 1.0f); \
                f32x2 a0 = {0.f, 0.f}, a1 = {0.f, 0.f}, a2 = {0.f, 0.f}, a3 = {0.f, 0.f}; \
                _Pragma("unroll") for (int q = 0; q < 16; q += 4) { \
                    a0 = __builtin_elementwise_fma((f32x2){uf[2 * q], uf[2 * q + 1]}, xf[q], a0); \
                    a1 = __builtin_elementwise_fma((f32x2){uf[2 * q + 2], uf[2 * q + 3]}, xf[q + 1], a1); \
                    a2 = __builtin_elementwise_fma((f32x2){uf[2 * q + 4], uf[2 * q + 5]}, xf[q + 2], a2); \
                    a3 = __builtin_elementwise_fma((f32x2){uf[2 * q + 6], uf[2 * q + 7]}, xf[q + 3], a3); } \
                const f32x2 sm = (a0 + a1) + (a2 + a3); part[(i0) + j] = sm.x + sm.y; __builtin_amdgcn_sched_barrier(0); } } while (0)
    SU_IDX(ev, xpn, IT_S(0), IT_T(0));
#pragma unroll
    for (int i = 0; i < 16; ++i) xf[i] = (f32x2){__uint_as_float(xpn[i] << 16), __uint_as_float(xpn[i] & 0xffff0000u)};
    const unsigned ca = ch8 * 16, cb = 128 + ch8 * 8;
    { const unsigned char* tab0 = p.ws + WS_U8 + (size_t)__builtin_amdgcn_readfirstlane(IT_S(0)) * SLB; SU_LD(A, ev, tab0, 0); SU_LD(B, ev, tab0, 4); }
    for (int k = 0; k < nitems; ++k) {
        const int kn = (k + 1 < nitems) ? k + 1 : k, s = __builtin_amdgcn_readfirstlane(IT_S(k)), sn = __builtin_amdgcn_readfirstlane(IT_S(kn)), t = IT_T(k), tn = IT_T(kn);
        const unsigned char* tab = p.ws + WS_U8 + (size_t)s * SLB; const unsigned char* tabn = p.ws + WS_U8 + (size_t)sn * SLB;
        SU_IDX(evn, xpn, sn, tn); __builtin_amdgcn_sched_barrier(0);
        float part[16];
        SU_USE(A, 0); SU_LD(A, ev, tab, 8);
        SU_USE(B, 4); SU_LD(B, ev, tab, 12);
        SU_USE(A, 8); SU_LD(A, evn, tabn, 0);
        SU_USE(B, 12); SU_LD(B, evn, tabn, 4);
        float p8[8], p4[4], p2[2];
#pragma unroll
        for (int q = 0; q < 8; ++q) { const float keep = b2 ? part[q + 8] : part[q], send = b2 ? part[q] : part[q + 8]; p8[q] = keep + __shfl_xor(send, 4); }
#pragma unroll
        for (int q = 0; q < 4; ++q) { const float keep = b1 ? p8[q + 4] : p8[q], send = b1 ? p8[q] : p8[q + 4]; p4[q] = keep + __shfl_xor(send, 2); }
#pragma unroll
        for (int q = 0; q < 2; ++q) { const float keep = b0 ? p4[q + 2] : p4[q], send = b0 ? p4[q] : p4[q + 2]; p2[q] = keep + __shfl_xor(send, 1); }
        const int st0 = (b2 ? 8 : 0) + (b1 ? 4 : 0) + (b0 ? 2 : 0);
        float* dp = DP + ((size_t)s * T + t) * 128 + grp;
        dp[8 * st0] = p2[0]; dp[8 * (st0 + 1)] = p2[1];
#pragma unroll
        for (int i = 0; i < 16; ++i) { ev[i] = evn[i]; xf[i] = (f32x2){__uint_as_float(xpn[i] << 16), __uint_as_float(xpn[i] & 0xffff0000u)}; }
    }
#undef SU_IDX
#undef SU_LD
#undef SU_USE
}
__device__ __forceinline__ void ph_peer_coef(const Params& p, const Ctx& c) {
    const float* DP = (const float*)(p.ws + WS_DP); const int* EID = (const int*)(p.ws + WS_EID); const float* GATE = (const float*)(p.ws + WS_GATE);
    const float* SU = (const float*)(p.ws + WS_SU); const float* SV = (const float*)(p.ws + WS_SV); float* CF = (float*)(p.ws + WS_CF);
    for (int i = c.bid * NTHR + c.tid; i < T * 128; i += c.nb * NTHR) { float d = 0.f;
#pragma unroll
        for (int s = 0; s < 16; ++s) d += DP[(size_t)s * T * 128 + i];
        const int e = EID[i]; d *= SU[e];
        CF[i] = GATE[i] * 0.5f * d * (1.0f + erff(d * 0.70710678118654752f)) * SV[e]; }
}
__device__ __forceinline__ void ph_peer_v(const Params& p, const Ctx& c) {
    const int* EID = (const int*)(p.ws + WS_EID); const float* CF = (const float*)(p.ws + WS_CF); float* SS = (float*)(p.ws + WS_SS); const float* mod = (const float*)(p.ws + WS_MOD);
    const PeerMap m = peer_map(p, c, 1);
    const int lane = c.lane, ch8 = lane & 7, grp = lane >> 3; const bool b5 = lane & 32, b4 = lane & 16, b3 = lane & 8;
    const int ntok = (m.tw < T) ? (T - m.tw + m.tstride - 1) / m.tstride : 0, nitems = m.ns * ntok;
    if (nitems == 0) return;
    const int cofs = ch8 * 32 + (b5 ? 16 : 0) + (b4 ? 8 : 0) + (b3 ? 4 : 0);
    int ev[16], evn[16]; float cv[16], cvn[16]; v6u_t A[4], B[4];
#define SV_IDX(EV, CV, t_) do { _Pragma("unroll") for (int i = 0; i < 16; ++i) { EV[i] = EID[(size_t)(t_) * 128 + 8 * i + grp]; CV[i] = CF[(size_t)(t_) * 128 + 8 * i + grp]; } } while (0)
#define SV_LD(R, EV, TAB, i0) do { _Pragma("unroll") for (int j = 0; j < 4; ++j) R[j] = ld24o((TAB), (unsigned)EV[(i0) + j], ca, cb); } while (0)
#define SV_USE(R, i0) do { _Pragma("unroll") for (int j = 0; j < 4; ++j) { const f32x2 c2 = {cv[(i0) + j], cv[(i0) + j]}; const v32f_t vf = __builtin_amdgcn_cvt_scalef32_pk32_f32_fp6(R[j], 1.0f); \
                _Pragma("unroll") for (int q = 0; q < 16; ++q) acc[q] = __builtin_elementwise_fma((f32x2){vf[2 * q], vf[2 * q + 1]}, c2, acc[q]); } } while (0)
    SV_IDX(ev, cv, IT_T(0));
    const unsigned ca = ch8 * 16, cb = 128 + ch8 * 8;
    { const unsigned char* tab0 = p.ws + WS_V8 + (size_t)__builtin_amdgcn_readfirstlane(IT_S(0)) * SLB; SV_LD(A, ev, tab0, 0); SV_LD(B, ev, tab0, 4); }
    for (int k = 0; k < nitems; ++k) {
        const int kn = (k + 1 < nitems) ? k + 1 : k, s = __builtin_amdgcn_readfirstlane(IT_S(k)), sn = __builtin_amdgcn_readfirstlane(IT_S(kn)), t = IT_T(k), tn = IT_T(kn);
        const unsigned char* tab = p.ws + WS_V8 + (size_t)s * SLB; const unsigned char* tabn = p.ws + WS_V8 + (size_t)sn * SLB;
        SV_IDX(evn, cvn, tn);
        const int col = s * 256 + cofs;
        float* orow = p.out + (size_t)t * D + col;
        const f32x4 xa = *(const f32x4*)orow, ga = *(const f32x4*)(mod + (size_t)(t / SEQ) * 6 * D + 5 * D + col);
        __builtin_amdgcn_sched_barrier(0);
        f32x2 acc[16];
#pragma unroll
        for (int q = 0; q < 16; ++q) acc[q] = (f32x2){0.f, 0.f};
        SV_USE(A, 0); SV_LD(A, ev, tab, 8);
        SV_USE(B, 4); SV_LD(B, ev, tab, 12);
        SV_USE(A, 8); SV_LD(A, evn, tabn, 0);
        SV_USE(B, 12); SV_LD(B, evn, tabn, 4);
        f32x2 q8[8], q4[4], q2[2];
#pragma unroll
        for (int q = 0; q < 8; ++q) { const f32x2 keep = b5 ? acc[q + 8] : acc[q], send = b5 ? acc[q] : acc[q + 8]; q8[q] = (f32x2){keep.x + __shfl_xor(send.x, 32), keep.y + __shfl_xor(send.y, 32)}; }
#pragma unroll
        for (int q = 0; q < 4; ++q) { const f32x2 keep = b4 ? q8[q + 4] : q8[q], send = b4 ? q8[q] : q8[q + 4]; q4[q] = (f32x2){keep.x + __shfl_xor(send.x, 16), keep.y + __shfl_xor(send.y, 16)}; }
#pragma unroll
        for (int q = 0; q < 2; ++q) { const f32x2 keep = b3 ? q4[q + 2] : q4[q], send = b3 ? q4[q] : q4[q + 2]; q2[q] = (f32x2){keep.x + __shfl_xor(send.x, 8), keep.y + __shfl_xor(send.y, 8)}; }
        const f32x4 y = {xa.x + ga.x * q2[0].x, xa.y + ga.y * q2[0].y, xa.z + ga.z * q2[1].x, xa.w + ga.w * q2[1].y};
        *(f32x4*)orow = y;
        const float ss = wave_sum((y.x * y.x + y.y * y.y) + (y.z * y.z + y.w * y.w));
        if (lane == 0) SS[(size_t)s * T + t] = ss;
#pragma unroll
        for (int i = 0; i < 16; ++i) { ev[i] = evn[i]; cv[i] = cvn[i]; }
    }
#undef SV_IDX
#undef SV_LD
#undef SV_USE
#undef IT_S
#undef IT_T
}
__device__ __forceinline__ void ph_peer_norm(const Params& p, const Ctx& c) {
    const float* SS = (const float*)(p.ws + WS_SS); const int lane = c.lane;
    for (int t = c.gw; t < T; t += c.ngw) {
        const float tot = wave_sum(lane < 16 ? SS[(size_t)lane * T + t] : 0.f);
        const float rstd = 1.0f / sqrtf(tot * (1.0f / D) + EPS);
        float* orow = p.out + (size_t)t * D;
#pragma unroll
        for (int k = 0; k < 16; ++k) { const int col = k * 256 + lane * 4; const f32x4 y = *(const f32x4*)(orow + col), ga = *(const f32x4*)(p.g_final + col);
            *(f32x4*)(orow + col) = (f32x4){y.x * rstd * ga.x, y.y * rstd * ga.y, y.z * rstd * ga.z, y.w * rstd * ga.w}; }
    }
}


constexpr int N_PHASES = 22;
__global__ void __launch_bounds__(NTHR, 2) fwd_kernel(Params p) {
    extern __shared__ __attribute__((aligned(16))) unsigned char lds_raw[];
    Ctx c; c.lds = (LAS unsigned char*)lds_raw; c.tid = threadIdx.x; c.lane = c.tid & 63; c.wave = __builtin_amdgcn_readfirstlane(c.tid >> 6);
    c.bid = blockIdx.x; c.nb = gridDim.x; c.gw = c.bid * NWAVES + c.wave; c.ngw = c.nb * NWAVES;
    volatile LAS unsigned* MISC = (volatile LAS unsigned*)(c.lds + MISC_OFF);
    if (c.tid < 64) MISC[c.tid] = 0u;
    __syncthreads();
    const int lo = p.ph_lo, hi = p.ph_hi;
    XcdBarrier bar; bar.bar = (unsigned*)(p.ws + WS_CTL); bar.x = 0; bar.st = nullptr;
    if (hi - lo > 1) bar = xcd_barrier_post((unsigned*)(p.ws + WS_CTL), MISC + 8);
#define IN(k) (lo <= (k) && (k) < hi)
#ifdef PH_TIME
#define TS(k) do { if (c.bid == 0 && c.tid == 0) ((unsigned long long*)(p.ws + WS_CTL))[4000 + (k)] = __builtin_amdgcn_s_memrealtime(); } while (0)
#else
#define TS(k) do { } while (0)
#endif
#define SEAM(k) do { if (IN(k) && IN((k) + 1)) xcd_barrier(bar); TS((k) + 1); } while (0)
    unsigned char* ws = p.ws;
    const float* mod = (const float*)(ws + WS_MOD);
    TS(0);
    if (IN(0)) { ph_prologue(p, c); } SEAM(0);
    if (IN(1)) { ph_modulate(p.x, p.g_mix, mod, 0 * D, 1 * D, (bf16*)(ws + WS_H), ws + WS_H8, c); } SEAM(1);
    if (IN(2)) {
        { pg8::Gemm g{(const bf16*)(ws + WS_H), (const bf16*)(ws + WS_BT1), T, IN_BF, D, D, D}; pg8::StaticOrder S; S.init(T, IN_BF, c.nb, c.bid);
          pg8::EpiB<0> E{(bf16*)(ws + WS_P1), nullptr, nullptr, nullptr, N1, 0, 1.0f, 0.f};
          pg8::gemm_phase<pg8::EpiB<0>, pg8::StaticOrder, true, true>(c.lds, g, S, E); }
        { pg8::Gemm g{(const bf16*)(ws + WS_H8), (const bf16*)(ws + WS_W8IN), T, IN_PAD - IN_BF, D / 2, D / 2, D / 2}; pg8::StaticOrder S; S.init(T, IN_PAD - IN_BF, c.nb, c.bid);
          pg8::EpiB<0> E{(bf16*)(ws + WS_P1) + IN_BF, nullptr, nullptr, nullptr, N1, 0, 1.0f / 16384.0f, 0.f};
          pg8::gemm_phase<pg8::EpiB<0>, pg8::StaticOrder, true, true, true>(c.lds, g, S, E); }
        { pg8::Gemm g{(const bf16*)(ws + WS_H8), (const bf16*)(ws + WS_G8), T, 2 * D, D / 2, D / 2, D / 2}; pg8::StaticOrder S; S.init(T, 2 * D, c.nb, c.bid);
          pg8::EpiGate E{(bf16*)(ws + WS_P1) + C_GA, N1, p.b_gate, 1.0f / 16384.0f};
          pg8::gemm_phase<pg8::EpiGate, pg8::StaticOrder, true, true, true>(c.lds, g, S, E); }
    } SEAM(2);
    if (IN(3)) { ph_postproc(p, c); } SEAM(3);
    if (IN(4)) { pg8::Gemm g{(const bf16*)(ws + WS_P1) + C_CQ, (const bf16*)(ws + WS_BT2), T, N2, A_QR, N1, A_QR}; pg8::StaticOrder S; S.init(T, N2, c.nb, c.bid);
        pg8::EpiB<0> E{(bf16*)(ws + WS_Q2), nullptr, nullptr, nullptr, N2, 0, 1.0f, 0.f};
        pg8::gemm_phase<pg8::EpiB<0>, pg8::StaticOrder, true, true>(c.lds, g, S, E); } SEAM(4);
    if (IN(5)) { ph_ret_state(p, c); ph_qlat(p, c); } SEAM(5);
    if (IN(6)) { ph_scores(p, c); } SEAM(6);
    if (IN(7)) { ph_topk(p, c); } SEAM(7);
    if (IN(8)) { ph_attn(p, c); } SEAM(8);
    if (IN(9)) { adaln_late_reduce(p, c); ph_oproj(p, c); ph_ret_out(p, c); } SEAM(9);
    if (IN(12)) { pg8::Gemm g{(const bf16*)(ws + WS_YCAT), (const bf16*)(ws + WS_BTUP), T, D, A_WIDTH / 2, D / 2, D / 2}; pg8::StaticOrder S; S.init(T, D, c.nb, c.bid);
        pg8::EpiB<2> E{(bf16*)(ws + WS_MERGED), nullptr, nullptr, (const bf16*)(ws + WS_P1) + C_GA, D, N1, 1.0f / 16384.0f, 0.f};
        pg8::gemm_phase<pg8::EpiB<2>, pg8::StaticOrder, true, true, true>(c.lds, g, S, E); }
    if (IN(12) && IN(13)) { VM_WAIT(); __syncthreads(); }
    if (IN(13)) { pg8::Gemm g{(const bf16*)(ws + WS_YCAT + A_WIDTH), (const bf16*)(ws + WS_BTUP + A_WIDTH), T, D, R_W / 2, D / 2, D / 2}; pg8::StaticOrder S; S.init(T, D, c.nb, c.bid);
        pg8::EpiB<3> E{(bf16*)(ws + WS_MERGED), ws + WS_MERGED8, nullptr, (const bf16*)(ws + WS_P1) + C_GR, D, N1, 1.0f / 16384.0f, 64.0f};
        pg8::gemm_phase<pg8::EpiB<3>, pg8::StaticOrder, true, true, true>(c.lds, g, S, E); } SEAM(13);
    if (IN(14)) { pg8::Gemm g{(const bf16*)(ws + WS_MERGED8), (const bf16*)(ws + WS_BTOUT), T, D, D / 2, D / 2, D / 2}; pg8::StaticOrder S; S.init(T, D, c.nb, c.bid);
        pg8::EpiRes E{p.x, p.out, D, mod + 2 * D, 6 * D, 1.0f / 65536.0f};
        pg8::gemm_phase<pg8::EpiRes, pg8::StaticOrder, true, true, true>(c.lds, g, S, E); } SEAM(14);
    if (IN(15)) { ph_modulate(p.out, p.g_ffn, mod, 3 * D, 4 * D, (bf16*)(ws + WS_H), nullptr, c); } SEAM(15);
    if (IN(16)) { pg8::Gemm g{(const bf16*)(ws + WS_H), (const bf16*)(ws + WS_BTPQ), T, 2048, D, D, D}; pg8::StaticOrder S; S.init(T, 2048, c.nb, c.bid);
        pg8::EpiB<0> E{(bf16*)(ws + WS_PQ), nullptr, nullptr, nullptr, 2048, 0, 1.0f, 0.f};
        pg8::gemm_phase<pg8::EpiB<0>, pg8::StaticOrder, true, true>(c.lds, g, S, E); } SEAM(16);
    if (IN(17)) { ph_peer_route(p, c); } SEAM(17);
    if (IN(18)) { ph_peer_u(p, c); } SEAM(18);
    if (IN(19)) { ph_peer_coef(p, c); } SEAM(19);
    if (IN(20)) { ph_peer_v(p, c); } SEAM(20);
    if (IN(21)) { ph_peer_norm(p, c); }
#ifdef PH_TIME
    xcd_barrier(bar); TS(22);
    if (c.bid == 0 && c.tid == 0) { __threadfence(); const volatile unsigned long long* ts = (const volatile unsigned long long*)(p.ws + WS_CTL) + 4000; p.out[0] += (float)(long long)(ts[PH_B] - ts[PH_A]) * 0.01f - (float)(PH_OFF); }
#endif
#undef IN
#undef SEAM
}

#ifdef DBG_STOP
__device__ __forceinline__ float dsan(float v) { return (v - v == 0.0f) ? v : 777.0f; }
__global__ void dump_kernel(Params p, int k) {
    unsigned char* ws = p.ws; const size_t n = (size_t)T * D;
    for (size_t i = (size_t)blockIdx.x * blockDim.x + threadIdx.x; i < n; i += (size_t)gridDim.x * blockDim.x) {
        float v = 0.f;
        if (k == 0) { v = ((const float*)(ws + WS_MOD))[i % 98304] + bf2f(((const bf16*)(ws + WS_BT1))[i] ) + bf2f(((const bf16*)(ws + WS_BT1))[(i + n) % 66060288])
                + bf2f(((const bf16*)(ws + WS_BT2))[i % 10485760]) + bf2f(((const bf16*)(ws + WS_WUK))[i % 1048576]) + bf2f(((const bf16*)(ws + WS_BTUV))[i % 1048576])
                + bf2f(((const bf16*)(ws + WS_BTUP))[i % 16777216]) + bf2f(((const bf16*)(ws + WS_BTOUT))[i % 16777216]) + bf2f(((const bf16*)(ws + WS_BTPQ))[i % 8388608])
                + bf2f(((const bf16*)(ws + WS_SK))[i % 32768]) + (float)(ws + WS_U8)[i] + (float)(ws + WS_V8)[i]; }
        else if (k == 1 || k == 15) v = bf2f(((const bf16*)(ws + WS_H))[i]);
        else if (k == 2 || k == 3) { const bf16* P = (const bf16*)(ws + WS_P1); v = bf2f(P[i]) + bf2f(P[i + n]) + bf2f(P[i + 2 * n]) + bf2f(P[(i + 3 * n) % 132120576]) + ((const float*)(ws + WS_WIDX))[i % 524288] * (k == 3 ? 1.f : 0.f); }
        else if (k == 4) { const bf16* P = (const bf16*)(ws + WS_Q2); v = bf2f(P[i]) + bf2f(P[i + n]) + bf2f(P[(i + 2 * n) % 83886080]); }
        else if (k == 5) { const bf16* P = (const bf16*)(ws + WS_QL); v = bf2f(P[i]) + bf2f(P[i + n]); }
        else if (k == 6) { const size_t j = i % ((size_t)T * SEQ); const int t = (int)(j / SEQ), s = (int)(j % SEQ); v = (s < (((t % SEQ) / 64) + 1) * 64) ? ((const float*)(ws + WS_SC))[j] : 0.f; }
        else if (k == 7) { const size_t j = i % ((size_t)T * TOPK); const int t = (int)(j / TOPK), s = (int)(j % TOPK); const int cnt = ((const int*)(ws + WS_CNT))[t]; v = (s < cnt) ? (float)((const int*)(ws + WS_SEL))[j] : (float)cnt; }
        else if (k == 8) { const bf16* P = (const bf16*)(ws + WS_OLAT); v = bf2f(P[i]) + bf2f(P[i + n]); }
        else if (k == 9) { v = (float)(ws + WS_YCAT)[(i / 2048) * 4096 + (i % 2048)]; }
        else if (k == 10) { v = ((const float*)(ws + WS_SC))[i % ((size_t)T * 2048)]; }
        else if (k == 11) { v = (float)(ws + WS_YCAT)[i]; }
        else if (k == 12 || k == 13) { v = bf2f(((const bf16*)(ws + WS_MERGED))[i]); }
        else if (k == 14 || k == 18) { v = p.out[i]; }
        else if (k == 16) { v = bf2f(((const bf16*)(ws + WS_PQ))[i % ((size_t)T * 2048)]); }
        else if (k == 17) { v = (float)((const int*)(ws + WS_EID))[i % ((size_t)T * 128)] + ((const float*)(ws + WS_GATE))[i % ((size_t)T * 128)]; }
        p.out[i] = dsan(v);
    }
}
#endif

#ifndef MK_SINGLE
#define MK_SINGLE 1
#endif
extern "C" void kernel_launch(void* const* d_in, const int* in_sizes, int n_in, void* d_out, int out_size, void* d_ws, size_t ws_size, hipStream_t stream) {
    static int grid = 0;
    if (grid == 0) {
        if (n_in != 26 || in_sizes[0] != T * D || out_size != T * D || ws_size < WS_END) { fprintf(stderr, "kernel_launch: unexpected shapes (n_in %d, in0 %d, out %d, ws %zu < %zu)\n", n_in, n_in > 0 ? in_sizes[0] : -1, out_size, ws_size, (size_t)WS_END); grid = -1; return; }
        int dev = 0, cus = 0, per_cu = 0;
        if (hipGetDevice(&dev) != hipSuccess || hipDeviceGetAttribute(&cus, hipDeviceAttributeMultiprocessorCount, dev) != hipSuccess) { grid = -1; return; }
        if (hipFuncSetAttribute((const void*)fwd_kernel, hipFuncAttributeMaxDynamicSharedMemorySize, LDS_BYTES) != hipSuccess) { fprintf(stderr, "kernel_launch: hipFuncSetAttribute failed\n"); grid = -1; return; }
        if (hipOccupancyMaxActiveBlocksPerMultiprocessor(&per_cu, (const void*)fwd_kernel, NTHR, LDS_BYTES) != hipSuccess || per_cu < 1) { fprintf(stderr, "kernel_launch: occupancy query reports %d blocks per CU\n", per_cu); }
        (void)hipGetLastError();
        grid = cus;
    }
    if (grid < 0) return;
    (void)hipMemsetAsync((char*)d_ws + WS_CTL, 0, CTL_ZERO_BYTES, stream);
    Params p{};
    const float** pf = (const float**)&p;
    for (int i = 0; i < 26; ++i) pf[i] = (const float*)d_in[i];
    p.out = (float*)d_out; p.ws = (unsigned char*)d_ws;
#ifdef DBG_STOP
    for (int ph = 0; ph <= DBG_STOP; ++ph) { p.ph_lo = ph; p.ph_hi = ph + 1; hipLaunchKernelGGL(fwd_kernel, dim3(grid), dim3(NTHR), LDS_BYTES, stream, p); }
    p.ph_lo = 0; p.ph_hi = 0;
    hipLaunchKernelGGL(dump_kernel, dim3(2048), dim3(256), 0, stream, p, (int)DBG_STOP);
#elif MK_SINGLE
    p.ph_lo = 0; p.ph_hi = N_PHASES;
    hipLaunchKernelGGL(fwd_kernel, dim3(grid), dim3(NTHR), LDS_BYTES, stream, p);
#else
    for (int ph = 0; ph < N_PHASES; ++ph) { p.ph_lo = ph; p.ph_hi = ph + 1;
#ifdef PEER_PROBE
        if (ph == 18) { p.dummy = 1; for (int rep = 0; rep < PEER_DUMMY; ++rep) hipLaunchKernelGGL(fwd_kernel, dim3(grid), dim3(NTHR), LDS_BYTES, stream, p); p.dummy = 0; }
#endif
        hipLaunchKernelGGL(fwd_kernel, dim3(grid), dim3(NTHR), LDS_BYTES, stream, p);
#ifdef REP_MASK
        if ((REP_MASK >> ph) & 1) for (int rep = 0; rep < REP_N; ++rep) hipLaunchKernelGGL(fwd_kernel, dim3(grid), dim3(NTHR), LDS_BYTES, stream, p);
#endif
    }
#endif
}
```

```cpp
#include <hip/hip_runtime.h>
#include <cstdio>
#include <cstdint>

#define GAS __attribute__((address_space(1)))
#define LAS __attribute__((address_space(3)))
typedef unsigned short bf16;
typedef unsigned v4u __attribute__((ext_vector_type(4)));
typedef unsigned v2u __attribute__((ext_vector_type(2)));
typedef float f32x4 __attribute__((ext_vector_type(4)));
typedef float f32x2 __attribute__((ext_vector_type(2)));
typedef short bf16x8 __attribute__((ext_vector_type(8)));
typedef short bf16x4 __attribute__((ext_vector_type(4)));

constexpr int D = 4096, NB = 4, SEQ = 2048, T = NB * SEQ;
constexpr int CHUNK = 64;
constexpr float EPS = 1e-6f;
constexpr int A_HEADS = 16, A_HD = 128, A_QR = 1024, A_KVR = 512, A_WIDTH = 2048;
constexpr int IDX_H = 64, IDX_D = 128, TOPK = 256;
constexpr int R_HEADS = 8, R_QK = 128, R_V = 256, R_QKW = 1024, R_W = 2048;
constexpr int P_HEADS = 8, P_QD = 256, P_NK = 128, P_TOPK = 16, P_EXP = 16384;
constexpr int IN_WIDTH = 7872, IN_PAD = 7936, IN_BF = 1792;
constexpr int N1 = IN_PAD + 2 * D;
constexpr int N2 = A_WIDTH + IDX_H * IDX_D;
constexpr int C_CQ = 0, C_CKV = 1024, C_KI = 1536, C_WI = 1664, C_RQ = 1728, C_RK = 2752, C_RV = 3776, C_RG = 5824, C_GA = IN_PAD, C_GR = IN_PAD + D;

__device__ __forceinline__ float bf2f(bf16 h) { return __uint_as_float(((unsigned)h) << 16); }
__device__ __forceinline__ float bflo(unsigned w) { return __uint_as_float(w << 16); }
__device__ __forceinline__ float bfhi(unsigned w) { return __uint_as_float(w & 0xffff0000u); }
typedef __bf16 bf16v2_t __attribute__((ext_vector_type(2)));
__device__ __forceinline__ unsigned cvt_pk_bf16(float lo, float hi) { const bf16v2_t v = __builtin_convertvector((f32x2){lo, hi}, bf16v2_t); return __builtin_bit_cast(unsigned, v); }
__device__ __forceinline__ bf16 f2bf(float f) { return (bf16)(cvt_pk_bf16(f, 0.f) & 0xffffu); }
__device__ __forceinline__ float wave_sum(float v) {
#pragma unroll
    for (int o = 1; o < 64; o <<= 1) v += __shfl_xor(v, o);
    return v;
}
#define PK_FP8(a, b, old, hi) __builtin_amdgcn_cvt_pk_fp8_f32(__builtin_amdgcn_fmed3f((a), -448.0f, 448.0f), __builtin_amdgcn_fmed3f((b), -448.0f, 448.0f), (old), (hi))
__device__ __forceinline__ float sigmoidf_(float v) { return 1.0f / (1.0f + __expf(-v)); }

namespace pg8 {
#define PG8_LAS __attribute__((address_space(3)))
typedef unsigned short bf16_t;
typedef unsigned u32x4 __attribute__((ext_vector_type(4)));
constexpr int BM = 256, BK = 64, HALF = 128, HTB = HALF * BK * 2  , STAGE_BYTES = 8 * HTB, NXCD = 8, WGM = 8;

__host__ __device__ __forceinline__ int lds_byte(int r, int c) { const int st = (r >> 4) * 2 + (c >> 5), rr = r & 15, cc = c & 31, ob = rr * 64 + cc * 2; return st * 1024 + (ob ^ (((ob >> 9) & 1) << 5)); }
__host__ __device__ __forceinline__ void stage_rc(int b, int& R, int& C) { const int st = b / 1024, sb = b % 1024, swz = sb ^ (((sb >> 9) & 1) << 5); R = (st >> 1) * 16 + swz / 64; C = (st & 1) * 32 + (swz % 64) / 2; }
__host__ __device__ __forceinline__ int perm32(int rho) { const int n = rho >> 4, i = rho & 15; return 8 * (i >> 2) + 4 * n + (i & 3); }

struct Unit { int pm, pn; };
struct Gemm { const bf16_t* A; const bf16_t* Bt; int M, N, K, lda, ldb; };

struct StaticOrder {
    int nM, nN, nwg, G, c;
    __host__ __device__ void init(int M, int N, int G_, int c_) { nM = M / BM; nN = N / BM; nwg = nM * nN; G = G_; c = c_; }
    __host__ __device__ bool next(int i, Unit& u) const {
        const long L = (long)i * G + c; if (L >= nwg) return false;
        int wgid = (int)L; { const int q = nwg / NXCD, r = nwg % NXCD, xcd = wgid % NXCD, off = wgid / NXCD; wgid = (xcd < r ? xcd * (q + 1) : r * (q + 1) + (xcd - r) * q) + off; }
        const int nig = WGM * nN, gid = wgid / nig, fm = gid * WGM, gsz = (nM - fm) < WGM ? (nM - fm) : WGM;
        u.pm = fm + ((wgid % nig) % gsz); u.pn = (wgid % nig) / gsz; return true;
    }
    __device__ __forceinline__ void a_ready(const Unit&) const {}
    __device__ __forceinline__ void done(const Unit&) const {}
};

template <int MODE> struct EpiB {
    static constexpr bool PERM = true, AFTER_DRAIN = false;
    bf16_t* O; unsigned char* O8; const float* bias; const bf16_t* gate; int ldc, ldg; float scale, scale8;
    __device__ __forceinline__ void operator()(const f32x4 (&acc)[2][2][4][2], const Unit& u, int wr, int wc, int fr, int fq) const {
        const int row0 = u.pm * BM + wr * 64 + fr; const int col0 = u.pn * BM + wc * 32 + 8 * fq;
        const bool gates = (MODE == 1) && (u.pn >= 31);
        f32x4 bv[2][2];
#pragma unroll
        for (int bj = 0; bj < 2; ++bj)
#pragma unroll
            for (int n = 0; n < 2; ++n) bv[bj][n] = gates ? *(const f32x4*)(bias + (col0 - 31 * BM) + bj * HALF + 4 * n) : (f32x4){0.f, 0.f, 0.f, 0.f};
#pragma unroll
        for (int ai = 0; ai < 2; ++ai)
#pragma unroll
            for (int m = 0; m < 4; ++m) { const size_t r = (size_t)(row0 + ai * HALF + m * 16); bf16_t* rowp = O + r * ldc + col0;
#pragma unroll
                for (int bj = 0; bj < 2; ++bj) { f32x4 v0 = acc[ai][bj][m][0] * scale, v1 = acc[ai][bj][m][1] * scale;
                    if (MODE == 1) { if (gates) { v0 = v0 + bv[bj][0]; v1 = v1 + bv[bj][1];
#pragma unroll
                            for (int j = 0; j < 4; ++j) { v0[j] = sigmoidf_(v0[j]); v1[j] = sigmoidf_(v1[j]); } } }
                    if (MODE == 2 || MODE == 3) { const u32x4 gw = *(const u32x4*)(gate + r * ldg + col0 + bj * HALF);
                        v0[0] *= bflo(gw.x); v0[1] *= bfhi(gw.x); v0[2] *= bflo(gw.y); v0[3] *= bfhi(gw.y); v1[0] *= bflo(gw.z); v1[1] *= bfhi(gw.z); v1[2] *= bflo(gw.w); v1[3] *= bfhi(gw.w); }
                    if (MODE == 3) { const u32x4 pw = *(const u32x4*)(rowp + bj * HALF);
                        v0[0] += bflo(pw.x); v0[1] += bfhi(pw.x); v0[2] += bflo(pw.y); v0[3] += bfhi(pw.y); v1[0] += bflo(pw.z); v1[1] += bfhi(pw.z); v1[2] += bflo(pw.w); v1[3] += bfhi(pw.w); }
                    u32x4 w; w.x = cvt_pk_bf16(v0[0], v0[1]); w.y = cvt_pk_bf16(v0[2], v0[3]); w.z = cvt_pk_bf16(v1[0], v1[1]); w.w = cvt_pk_bf16(v1[2], v1[3]);
                    *(u32x4*)(rowp + bj * HALF) = w;
                    if (MODE == 3) { int q0 = 0, q1 = 0; q0 = PK_FP8(v0[0] * scale8, v0[1] * scale8, q0, false); q0 = PK_FP8(v0[2] * scale8, v0[3] * scale8, q0, true);
                        q1 = PK_FP8(v1[0] * scale8, v1[1] * scale8, q1, false); q1 = PK_FP8(v1[2] * scale8, v1[3] * scale8, q1, true);
                        *(v2u*)(O8 + r * ldc + col0 + bj * HALF) = (v2u){(unsigned)q0, (unsigned)q1}; } } }
    }
};
typedef int v8i_t __attribute__((ext_vector_type(8)));
typedef int v4i_t __attribute__((ext_vector_type(4)));
__device__ __forceinline__ v8i_t f8cat(const bf16x8 lo, const bf16x8 hi) { const v4i_t a = __builtin_bit_cast(v4i_t, lo), b = __builtin_bit_cast(v4i_t, hi); return __builtin_shufflevector(a, b, 0, 1, 2, 3, 4, 5, 6, 7); }
struct EpiGate {
    static constexpr bool PERM = true, AFTER_DRAIN = false;
    bf16_t* O; int ldc; const float* bias; float scale;
    __device__ __forceinline__ void operator()(const f32x4 (&acc)[2][2][4][2], const Unit& u, int wr, int wc, int fr, int fq) const {
        const int row0 = u.pm * BM + wr * 64 + fr; const int col0 = u.pn * BM + wc * 32 + 8 * fq;
        f32x4 bv[2][2];
#pragma unroll
        for (int bj = 0; bj < 2; ++bj)
#pragma unroll
            for (int n = 0; n < 2; ++n) bv[bj][n] = *(const f32x4*)(bias + col0 + bj * HALF + 4 * n);
#pragma unroll
        for (int ai = 0; ai < 2; ++ai)
#pragma unroll
            for (int m = 0; m < 4; ++m) { bf16_t* rowp = O + (size_t)(row0 + ai * HALF + m * 16) * ldc + col0;
#pragma unroll
                for (int bj = 0; bj < 2; ++bj) { f32x4 v0 = acc[ai][bj][m][0] * scale + bv[bj][0], v1 = acc[ai][bj][m][1] * scale + bv[bj][1];
#pragma unroll
                    for (int j = 0; j < 4; ++j) { v0[j] = sigmoidf_(v0[j]); v1[j] = sigmoidf_(v1[j]); }
                    u32x4 w; w.x = cvt_pk_bf16(v0[0], v0[1]); w.y = cvt_pk_bf16(v0[2], v0[3]); w.z = cvt_pk_bf16(v1[0], v1[1]); w.w = cvt_pk_bf16(v1[2], v1[3]);
                    *(u32x4*)(rowp + bj * HALF) = w; } }
    }
};
struct EpiRes {
    static constexpr bool PERM = false, AFTER_DRAIN = false;
    const float* X; float* O; int ldc; const float* gt; int ldgt; float scale;
    __device__ __forceinline__ void operator()(const f32x4 (&acc)[2][2][4][2], const Unit& u, int wr, int wc, int fr, int fq) const {
        const int row0 = u.pm * BM + wr * 64 + fr, col0 = u.pn * BM + wc * 32 + 4 * fq;
        const float* g = gt + (size_t)(u.pm / (SEQ / BM)) * ldgt;
        f32x4 gv[2][2];
#pragma unroll
        for (int bj = 0; bj < 2; ++bj)
#pragma unroll
            for (int n = 0; n < 2; ++n) gv[bj][n] = *(const f32x4*)(g + col0 + bj * HALF + n * 16);
#pragma unroll
        for (int ai = 0; ai < 2; ++ai)
#pragma unroll
            for (int m = 0; m < 4; ++m) { const size_t off = (size_t)(row0 + ai * HALF + m * 16) * ldc + col0;
#pragma unroll
                for (int bj = 0; bj < 2; ++bj)
#pragma unroll
                    for (int n = 0; n < 2; ++n) { const f32x4 xv = *(const f32x4*)(X + off + bj * HALF + n * 16); *(f32x4*)(O + off + bj * HALF + n * 16) = xv + gv[bj][n] * (acc[ai][bj][m][n] * scale); } }
    }
};

template <class Epi, class Sched, bool ALIGN_EPI = false, bool SP2 = false, bool F8 = false>
__device__ __forceinline__ void gemm_phase(PG8_LAS unsigned char* lds, const Gemm g, const Sched& S, const Epi& E) {
    const int tid = threadIdx.x, wid = __builtin_amdgcn_readfirstlane(tid >> 6), lane = tid & 63, wr = wid >> 2, wc = wid & 3, fr = lane & 15, fq = lane >> 4;
    const int K = g.K, nt = K / BK;
    unsigned voffA[2], voffB[2];
#pragma unroll
    for (int i = 0; i < 2; ++i) { int R, C; stage_rc(tid * 16 + i * 8192, R, C); const int Rb = Epi::PERM ? ((R & ~31) + perm32(R & 31)) : R;
        voffA[i] = (unsigned)(R * g.lda + C) * 2u; voffB[i] = (unsigned)(Rb * g.ldb + C) * 2u; }
    const size_t kstep = (size_t)(BK * 2);
    const size_t hstepA = (size_t)HALF * g.lda * 2, hstepB = (size_t)HALF * g.ldb * 2;
    const size_t tstepA = 2 * hstepA, tstepB = 2 * hstepB;
    const unsigned ldsw = (unsigned)wid * 1024u;
    const int aoff = lds_byte(wr * 64 + fr, fq * 8), boff = lds_byte(wc * 32 + fr, fq * 8);
#define PG8_SA(b, h) (((b) * 2 + (h)) * HTB)
#define PG8_SB(b, h) ((4 + (b) * 2 + (h)) * HTB)
#define PG8_STAGE(bufoff, gbase, voff) do { _Pragma("unroll") for (int _i = 0; _i < 2; ++_i) \
        __builtin_amdgcn_global_load_lds((const unsigned*)((const char*)(gbase) + (voff)[_i]), (PG8_LAS unsigned*)(lds + (bufoff) + ldsw + _i * 8192), 16, 0, 0); } while (0)
#define PG8_LDA(dst, b, h) do { if constexpr (F8) { _Pragma("unroll") for (int m = 0; m < 4; ++m) dst##8[m] = f8cat(*(const PG8_LAS bf16x8*)(lds + PG8_SA(b, h) + aoff + m * 2048), *(const PG8_LAS bf16x8*)(lds + PG8_SA(b, h) + aoff + m * 2048 + 1024)); } \
        else { _Pragma("unroll") for (int m = 0; m < 4; ++m) _Pragma("unroll") for (int k = 0; k < 2; ++k) dst[m][k] = *(const PG8_LAS bf16x8*)(lds + PG8_SA(b, h) + aoff + m * 2048 + k * 1024); } } while (0)
#define PG8_LDB(dst, b, h) do { if constexpr (F8) { _Pragma("unroll") for (int n = 0; n < 2; ++n) dst##8[n] = f8cat(*(const PG8_LAS bf16x8*)(lds + PG8_SB(b, h) + boff + n * 2048), *(const PG8_LAS bf16x8*)(lds + PG8_SB(b, h) + boff + n * 2048 + 1024)); } \
        else { _Pragma("unroll") for (int n = 0; n < 2; ++n) _Pragma("unroll") for (int k = 0; k < 2; ++k) dst[n][k] = *(const PG8_LAS bf16x8*)(lds + PG8_SB(b, h) + boff + n * 2048 + k * 1024); } } while (0)
#define PG8_MMA(ai, bj, At, Bt) do { __builtin_amdgcn_s_setprio(1); _Pragma("unroll") for (int m = 0; m < 4; ++m) _Pragma("unroll") for (int n = 0; n < 2; ++n) { \
        if constexpr (F8) { asm volatile("v_mfma_scale_f32_16x16x128_f8f6f4 %0, %1, %2, %0, %3, %3 op_sel_hi:[0,0,0]" : "+v"(acc[ai][bj][m][n]) : "v"(Bt##8[n]), "v"(At##8[m]), "v"(f8scale)); } \
        else { _Pragma("unroll") for (int k = 0; k < 2; ++k) acc[ai][bj][m][n] = __builtin_amdgcn_mfma_f32_16x16x32_bf16(Bt[n][k], At[m][k], acc[ai][bj][m][n], 0, 0, 0); } } __builtin_amdgcn_s_setprio(0); } while (0)
#define PG8_WAIT_V(n) asm volatile("s_waitcnt vmcnt(" #n ")" ::: "memory")
#define PG8_WAIT_L(n) asm volatile("s_waitcnt lgkmcnt(" #n ")" ::: "memory")
#define PG8_BAR __builtin_amdgcn_s_barrier()
#define PG8_SCHED __builtin_amdgcn_sched_barrier(0)
    Unit cur, nxt; int ui = 0;
    if (!S.next(0, cur)) return;
    f32x4 acc[2][2][4][2];
#pragma unroll
    for (int a = 0; a < 2; ++a)
#pragma unroll
        for (int b = 0; b < 2; ++b)
#pragma unroll
            for (int m = 0; m < 4; ++m)
#pragma unroll
                for (int n = 0; n < 2; ++n) acc[a][b][m][n] = (f32x4){0.f, 0.f, 0.f, 0.f};
    bf16x8 At[4][2], B0[2][2], B1[2][2]; v8i_t At8[4], B08[2], B18[2];
    const int f8scale = 0x7f7f7f7f;
    const char* cA = (const char*)g.A + (size_t)cur.pm * tstepA; const char* cB = (const char*)g.Bt + (size_t)cur.pn * tstepB;
    S.a_ready(cur);
    if constexpr (SP2) {
        PG8_STAGE(PG8_SB(0, 0), cB, voffB); PG8_STAGE(PG8_SB(0, 1), cB + hstepB, voffB); PG8_STAGE(PG8_SA(0, 0), cA, voffA); PG8_STAGE(PG8_SA(0, 1), cA + hstepA, voffA);
        if (wr == 1) PG8_BAR;
        PG8_WAIT_V(2); PG8_BAR;
        PG8_STAGE(PG8_SB(1, 0), cB + kstep, voffB); PG8_STAGE(PG8_SA(1, 0), cA + kstep, voffA); PG8_STAGE(PG8_SB(1, 1), cB + hstepB + kstep, voffB);
        PG8_WAIT_V(6); PG8_BAR;
    } else {
        PG8_STAGE(PG8_SB(0, 0), cB, voffB); PG8_STAGE(PG8_SA(0, 0), cA, voffA); PG8_STAGE(PG8_SB(0, 1), cB + hstepB, voffB); PG8_STAGE(PG8_SA(0, 1), cA + hstepA, voffA);
        if (wr == 1) PG8_BAR;
        PG8_WAIT_V(4); PG8_BAR;
        PG8_STAGE(PG8_SB(1, 0), cB + kstep, voffB); PG8_STAGE(PG8_SA(1, 0), cA + kstep, voffA); PG8_STAGE(PG8_SB(1, 1), cB + hstepB + kstep, voffB);
        PG8_WAIT_V(6); PG8_BAR;
    }
    for (;;) {
        const bool has_next = S.next(ui + 1, nxt);
        const char* nA = has_next ? (const char*)g.A + (size_t)nxt.pm * tstepA : cA; const char* nB = has_next ? (const char*)g.Bt + (size_t)nxt.pn * tstepB : cB;
        for (int t = 0; t < nt; t += 2) {
            const bool last = (t == nt - 2);
            const char* a1 = cA + (size_t)(t + 1) * kstep;
            const char* a2 = last ? nA : cA + (size_t)(t + 2) * kstep; const char* b2 = last ? nB : cB + (size_t)(t + 2) * kstep;
            const char* a3 = a2 + kstep; const char* b3 = b2 + kstep;
            if (last && has_next) S.a_ready(nxt);
            if constexpr (SP2) {
            PG8_LDB(B0, 0, 0); PG8_LDB(B1, 0, 1); PG8_SCHED; PG8_LDA(At, 0, 0); PG8_STAGE(PG8_SA(1, 1), a1 + hstepA, voffA);
            PG8_WAIT_V(8); PG8_WAIT_L(0); PG8_BAR; PG8_MMA(0, 0, At, B0); PG8_MMA(0, 1, At, B1); PG8_BAR; PG8_SCHED;
            PG8_LDA(At, 0, 1); PG8_STAGE(PG8_SB(0, 0), b2, voffB); PG8_STAGE(PG8_SB(0, 1), b2 + hstepB, voffB); PG8_STAGE(PG8_SA(0, 0), a2, voffA);
            PG8_WAIT_V(8); PG8_WAIT_L(0); PG8_BAR; PG8_MMA(1, 0, At, B0); PG8_MMA(1, 1, At, B1); PG8_BAR; PG8_SCHED;
            PG8_LDB(B0, 1, 0); PG8_LDB(B1, 1, 1); PG8_SCHED; PG8_LDA(At, 1, 0); PG8_STAGE(PG8_SA(0, 1), a2 + hstepA, voffA);
            PG8_WAIT_V(8); PG8_WAIT_L(0); PG8_BAR; PG8_MMA(0, 0, At, B0); PG8_MMA(0, 1, At, B1); PG8_BAR; PG8_SCHED;
            PG8_LDA(At, 1, 1); PG8_STAGE(PG8_SB(1, 0), b3, voffB); PG8_STAGE(PG8_SB(1, 1), b3 + hstepB, voffB); PG8_STAGE(PG8_SA(1, 0), a3, voffA);
            PG8_WAIT_V(8); PG8_WAIT_L(0); PG8_BAR; PG8_MMA(1, 0, At, B0); PG8_MMA(1, 1, At, B1); PG8_BAR; PG8_SCHED;
            } else {
            PG8_LDB(B0, 0, 0); PG8_SCHED; PG8_LDA(At, 0, 0); PG8_STAGE(PG8_SA(1, 1), a1 + hstepA, voffA);
            PG8_WAIT_L(8); PG8_BAR; PG8_WAIT_L(0); PG8_MMA(0, 0, At, B0); PG8_BAR; PG8_SCHED;
            PG8_LDB(B1, 0, 1); PG8_STAGE(PG8_SB(0, 0), b2, voffB);
            PG8_BAR; PG8_WAIT_L(0); PG8_MMA(0, 1, At, B1); PG8_BAR;
            PG8_LDA(At, 0, 1); PG8_STAGE(PG8_SA(0, 0), a2, voffA);
            PG8_BAR; PG8_WAIT_L(0); PG8_MMA(1, 0, At, B0); PG8_BAR; PG8_SCHED;
            PG8_STAGE(PG8_SB(0, 1), b2 + hstepB, voffB);
            PG8_WAIT_V(6); PG8_BAR; PG8_MMA(1, 1, At, B1); PG8_BAR;
            PG8_LDB(B0, 1, 0); PG8_SCHED; PG8_LDA(At, 1, 0); PG8_STAGE(PG8_SA(0, 1), a2 + hstepA, voffA);
            PG8_WAIT_L(8); PG8_BAR; PG8_WAIT_L(0); PG8_MMA(0, 0, At, B0); PG8_BAR; PG8_SCHED;
            PG8_LDB(B1, 1, 1); PG8_STAGE(PG8_SB(1, 0), b3, voffB);
            PG8_BAR; PG8_WAIT_L(0); PG8_MMA(0, 1, At, B1); PG8_BAR;
            PG8_LDA(At, 1, 1); PG8_STAGE(PG8_SA(1, 0), a3, voffA);
            PG8_BAR; PG8_WAIT_L(0); PG8_MMA(1, 0, At, B0); PG8_BAR; PG8_SCHED;
            PG8_STAGE(PG8_SB(1, 1), b3 + hstepB, voffB);
            PG8_WAIT_V(6); PG8_BAR; PG8_MMA(1, 1, At, B1); PG8_BAR;
            }
        }
        if constexpr (F8) { asm volatile("s_nop 15\n\ts_nop 15" ::: "memory"); }
        if constexpr (ALIGN_EPI) { if (wr == 0) PG8_BAR; }
        if constexpr (!Epi::AFTER_DRAIN) { E(acc, cur, wr, wc, fr, fq); S.done(cur); }
        if (!has_next) break;
#pragma unroll
        for (int a = 0; a < 2; ++a)
#pragma unroll
            for (int b = 0; b < 2; ++b)
#pragma unroll
                for (int m = 0; m < 4; ++m)
#pragma unroll
                    for (int n = 0; n < 2; ++n) acc[a][b][m][n] = (f32x4){0.f, 0.f, 0.f, 0.f};
        cur = nxt; cA = nA; cB = nB; ++ui;
        if constexpr (ALIGN_EPI) { if (wr == 1) PG8_BAR; }
    }
    PG8_WAIT_V(0);
    if constexpr (!ALIGN_EPI) { if (wr == 0) PG8_BAR; }
    PG8_BAR;
    if constexpr (Epi::AFTER_DRAIN) { E.fused(acc, cur, wr, wc, fr, fq, lds, wid, lane); S.done(cur); }
#undef PG8_SA
#undef PG8_SB
#undef PG8_STAGE
#undef PG8_LDA
#undef PG8_LDB
#undef PG8_MMA
#undef PG8_WAIT_V
#undef PG8_WAIT_L
#undef PG8_BAR
#undef PG8_SCHED
}}

constexpr size_t MiB = 1u << 20;
constexpr size_t WS_CTL = 0, CTL_ZERO_BYTES = 2 * MiB;
constexpr size_t WS_MOD = 1 * MiB;
constexpr size_t WS_BT1 = 2 * MiB;
constexpr size_t WS_W8IN = 16 * MiB;
constexpr size_t WS_G8 = 64 * MiB;
constexpr size_t WS_H8 = 96 * MiB;
constexpr size_t WS_BT2 = 128 * MiB;
constexpr size_t WS_WUK = 148 * MiB;
constexpr size_t WS_BTUV = 150 * MiB;
constexpr size_t WS_BTUP = 152 * MiB;
constexpr size_t WS_BTOUT = 184 * MiB;
constexpr size_t WS_BTPQ = 216 * MiB;
constexpr size_t WS_SK = 232 * MiB;
constexpr size_t WS_U8 = 233 * MiB, WS_V8 = 297 * MiB, WS_SU = 361 * MiB, WS_SV = 362 * MiB;
constexpr int ROW6 = 3072;
constexpr size_t WS_H = 489 * MiB;
constexpr size_t WS_P1 = 553 * MiB;
constexpr size_t WS_Q2 = 805 * MiB;
constexpr size_t WS_QL = 965 * MiB;
constexpr size_t WS_SC = 1093 * MiB;
constexpr size_t WS_SEL = 1157 * MiB, WS_CNT = 1165 * MiB, WS_WIDX = 1166 * MiB;
constexpr size_t WS_OLAT = 1168 * MiB;
constexpr size_t WS_YCAT = 1296 * MiB;
constexpr size_t WS_MERGED8 = 1328 * MiB;
constexpr size_t WS_MERGED = 1360 * MiB;
constexpr size_t WS_PQ = 1424 * MiB;
constexpr size_t WS_EID = 1456 * MiB, WS_GATE = 1460 * MiB;
constexpr size_t WS_CKV = 1528 * MiB;
constexpr size_t WS_END = 1536 * MiB;

constexpr int SCRATCH_BYTES = 155648;
constexpr int MISC_OFF = SCRATCH_BYTES;
constexpr int LDS_BYTES = SCRATCH_BYTES + 1024;
constexpr int NWAVES = 8, NTHR = 512;

struct Params {
    const float *x, *c, *w_ada, *b_ada, *g_mix, *w_in, *g_cq, *g_ckv, *w_uq, *w_uk, *w_uv, *w_qi, *g_ki, *b_ki, *t5, *g_ret, *w_up, *w_gate, *b_gate, *w_out, *g_ffn, *w_pq, *sub_keys, *u_exp, *v_exp, *g_final;
    float* out; unsigned char* ws; int ph_lo, ph_hi;
#ifdef PEER_PROBE
    int dummy;
#endif
};

#define LDS_WAIT() asm volatile("s_waitcnt lgkmcnt(0)" ::: "memory")
#define VM_WAIT() asm volatile("s_waitcnt vmcnt(0)" ::: "memory")

#define XB_TMO      128
#define XB_XCNT(j)  (256  + 64 * (j))
#define XB_XSUB(j)  (1280 + 64 * (j))
#define XB_XGEN(j)  (2304 + 64 * (j))
#define XB_TOP      3328
#define XB_TOPGEN   3392
#define XCD_BAR_WORDS 3456
#define XB_ATT_RANK  4096
#define XB_SPIN_CAP (1u << 18)

__device__ __forceinline__ unsigned xb_ld(unsigned* p)              { return __hip_atomic_load(p, __ATOMIC_RELAXED, __HIP_MEMORY_SCOPE_AGENT); }
__device__ __forceinline__ unsigned xb_add(unsigned* p, unsigned v) { return __hip_atomic_fetch_add(p, v, __ATOMIC_RELAXED, __HIP_MEMORY_SCOPE_AGENT); }
__device__ __forceinline__ unsigned xb_xcc_id() { return (unsigned)__builtin_amdgcn_s_getreg((3 << 11) | 20) & 0xFu; }
#define XB_SPIN(cond, bar) do { unsigned _sp = 0; while (cond) { __builtin_amdgcn_s_sleep(1); \
    if ((++_sp & 255u) == 0u) { if (xb_ld(&(bar)[XB_TMO])) break; if (_sp > XB_SPIN_CAP) { atomicAdd(&(bar)[XB_TMO], 1u); break; } } } } while (0)

struct XcdBarrier { unsigned* bar; unsigned x; volatile LAS unsigned* st; };

__device__ __forceinline__ XcdBarrier xcd_barrier_post(unsigned* bar, volatile LAS unsigned* st) {
    XcdBarrier b; b.bar = bar; b.x = xb_xcc_id(); b.st = st;
    if (threadIdx.x == 0) (void)xb_add(&bar[XB_XCNT(b.x)], 1u);
    return b;
}
__device__ __forceinline__ void xcd_barrier_complete(unsigned* bar, unsigned x, unsigned& nloc, unsigned& nx) {
    const unsigned G = gridDim.x * gridDim.y * gridDim.z;
    unsigned sum, cnt, mine, sp = 0u;
    for (;;) {
        sum = 0u; cnt = 0u; mine = 0u;
#pragma unroll
        for (unsigned j = 0; j < 16; ++j) { const unsigned c = xb_ld(&bar[XB_XCNT(j)]); sum += c; cnt += (c > 0u) ? 1u : 0u; mine = (j == x) ? c : mine; }
        if (sum == G) break;
        __builtin_amdgcn_s_sleep(1);
        if ((++sp & 255u) == 0u) { if (xb_ld(&bar[XB_TMO])) break; if (sp > XB_SPIN_CAP) { atomicAdd(&bar[XB_TMO], 1u); break; } }
    }
    nloc = mine > 0u ? mine : 1u; nx = cnt > 0u ? cnt : 1u;
}
__device__ __forceinline__ void xcd_barrier(const XcdBarrier& b) {
    asm volatile("s_waitcnt vmcnt(0)" ::: "memory");
    __syncthreads();
    if (threadIdx.x == 0) {
        unsigned* bar = b.bar;
        __builtin_amdgcn_s_waitcnt(0);
        unsigned nloc = b.st[0], nx = b.st[1];
        if (nloc == 0u) { xcd_barrier_complete(bar, b.x, nloc, nx); b.st[0] = nloc; b.st[1] = nx; }
        const unsigned old = xb_add(&bar[XB_XSUB(b.x)], 1u);
        const unsigned gen = old / nloc;
        if (old + 1u == (gen + 1u) * nloc) {
            __builtin_amdgcn_fence(__ATOMIC_RELEASE, "agent");
            asm volatile("s_waitcnt vmcnt(0)" ::: "memory");
            const unsigned og = xb_add(&bar[XB_TOP], 1u);
            const unsigned tg = og / nx;
            if (og + 1u == (tg + 1u) * nx) xb_add(&bar[XB_TOPGEN], 1u);
            else XB_SPIN(xb_ld(&bar[XB_TOPGEN]) == tg, bar);
            __builtin_amdgcn_fence(__ATOMIC_ACQUIRE, "agent");
            xb_add(&bar[XB_XGEN(b.x)], 1u);
            asm volatile("s_waitcnt vmcnt(0)" ::: "memory");
        } else {
            XB_SPIN(xb_ld(&bar[XB_XGEN(b.x)]) == gen, bar);
            __builtin_amdgcn_fence(__ATOMIC_ACQUIRE, "agent");
            asm volatile("s_waitcnt vmcnt(0)" ::: "memory");
        }
    }
    __syncthreads();
}

struct Ctx { LAS unsigned char* lds; int tid, lane, wave, gw, ngw, bid, nb; };

__device__ __forceinline__ void p0_transpose_item(const float* W, int K, int N, bf16* WT, int row_off, LAS float* scr, int item, int lane, int ldw = 0) {
    if (!ldw) ldw = N;
    const int nblk = N / 32, kb = item / nblk, nb = item % nblk, k0 = 64 * kb, n0 = 32 * nb;
#pragma unroll 8
    for (int i = 0; i < 32; ++i) { const int kk = 2 * i + (lane >> 5); scr[kk * 33 + (lane & 31)] = W[(size_t)(k0 + kk) * ldw + n0 + (lane & 31)]; }
    LDS_WAIT(); asm volatile("" ::: "memory");
    const int c = lane & 7;
#pragma unroll
    for (int j = 0; j < 4; ++j) { const int n = (lane >> 3) + 8 * j; const LAS float* s = scr + (8 * c) * 33 + n;
        v4u o; o.x = cvt_pk_bf16(s[0 * 33], s[1 * 33]); o.y = cvt_pk_bf16(s[2 * 33], s[3 * 33]); o.z = cvt_pk_bf16(s[4 * 33], s[5 * 33]); o.w = cvt_pk_bf16(s[6 * 33], s[7 * 33]);
        *(v4u*)(WT + (size_t)(row_off + n0 + n) * K + k0 + 8 * c) = o; }
    LDS_WAIT(); asm volatile("" ::: "memory");
}
__device__ __forceinline__ void p0_transpose_item_f8(const float* W, int K, int N, unsigned char* WT, float sc, LAS float* scr, int item, int lane, int ldw = 0) {
    if (!ldw) ldw = N;
    const int nblk = N / 32, kb = item / nblk, nb = item % nblk, k0 = 64 * kb, n0 = 32 * nb;
#pragma unroll 8
    for (int i = 0; i < 32; ++i) { const int kk = 2 * i + (lane >> 5); scr[kk * 33 + (lane & 31)] = W[(size_t)(k0 + kk) * ldw + n0 + (lane & 31)]; }
    LDS_WAIT(); asm volatile("" ::: "memory");
    const int n = lane >> 1, kh = (lane & 1) * 32; const LAS float* s = scr + kh * 33 + n;
    unsigned o[8];
#pragma unroll
    for (int j = 0; j < 8; ++j) { int w = 0; w = PK_FP8(s[(4 * j) * 33] * sc, s[(4 * j + 1) * 33] * sc, w, false); w = PK_FP8(s[(4 * j + 2) * 33] * sc, s[(4 * j + 3) * 33] * sc, w, true); o[j] = (unsigned)w; }
    unsigned char* dp = WT + (size_t)(n0 + n) * K + k0 + kh;
    *(v4u*)dp = (v4u){o[0], o[1], o[2], o[3]}; *(v4u*)(dp + 16) = (v4u){o[4], o[5], o[6], o[7]};
    LDS_WAIT(); asm volatile("" ::: "memory");
}
__device__ __forceinline__ void p0_convert(const float* src, bf16* dst, size_t n, size_t i0, size_t stride) {
    for (size_t i = i0; i < n / 8; i += stride) { const f32x4 a = *(const f32x4*)(src + 8 * i), b = *(const f32x4*)(src + 8 * i + 4);
        v4u o; o.x = cvt_pk_bf16(a[0], a[1]); o.y = cvt_pk_bf16(a[2], a[3]); o.z = cvt_pk_bf16(b[0], b[1]); o.w = cvt_pk_bf16(b[2], b[3]); *(v4u*)(dst + 8 * i) = o; }
}

__device__ __forceinline__ void tr32_item(const float* W, int K, int N, bf16* WT, LAS float* scr, int item, int lane) {
    const int nblk = N / 32, kb = item / nblk, nb = item % nblk, k0 = 32 * kb, n0 = 32 * nb;
#pragma unroll 8
    for (int i = 0; i < 16; ++i) { const int kk = 2 * i + (lane >> 5); scr[kk * 33 + (lane & 31)] = W[(size_t)(k0 + kk) * N + n0 + (lane & 31)]; }
    LDS_WAIT(); asm volatile("" ::: "memory");
#pragma unroll
    for (int j = 0; j < 2; ++j) { const int q = lane + 64 * j, n = q >> 2, cch = q & 3; const LAS float* s = scr + (8 * cch) * 33 + n;
        v4u o; o.x = cvt_pk_bf16(s[0 * 33], s[1 * 33]); o.y = cvt_pk_bf16(s[2 * 33], s[3 * 33]); o.z = cvt_pk_bf16(s[4 * 33], s[5 * 33]); o.w = cvt_pk_bf16(s[6 * 33], s[7 * 33]);
        *(v4u*)(WT + (size_t)(n0 + n) * K + k0 + 8 * cch) = o; }
    LDS_WAIT(); asm volatile("" ::: "memory");
}
__device__ __forceinline__ void tr32_item_f8(const float* W, int K, int N, unsigned char* WT, float sc, LAS float* scr, int item, int lane) {
    const int nblk = N / 32, kb = item / nblk, nb = item % nblk, k0 = 32 * kb, n0 = 32 * nb;
#pragma unroll 8
    for (int i = 0; i < 16; ++i) { const int kk = 2 * i + (lane >> 5); scr[kk * 33 + (lane & 31)] = W[(size_t)(k0 + kk) * N + n0 + (lane & 31)]; }
    LDS_WAIT(); asm volatile("" ::: "memory");
    const int n = lane >> 1, kh = (lane & 1) * 16; const LAS float* s = scr + kh * 33 + n;
    unsigned o[4];
#pragma unroll
    for (int j = 0; j < 4; ++j) { int w = 0; w = PK_FP8(s[(4 * j) * 33] * sc, s[(4 * j + 1) * 33] * sc, w, false); w = PK_FP8(s[(4 * j + 2) * 33] * sc, s[(4 * j + 3) * 33] * sc, w, true); o[j] = (unsigned)w; }
    *(v4u*)(WT + (size_t)(n0 + n) * K + k0 + kh) = (v4u){o[0], o[1], o[2], o[3]};
    LDS_WAIT(); asm volatile("" ::: "memory");
}
__device__ __forceinline__ void convert_late_weights(const Params& p, LAS float* scr, int lane, int first, int stride) {
    unsigned char* ws = p.ws;
    constexpr int I_UP = 128 * (D / 32), I_OUT = 128 * (D / 32), I_PQ = 128 * (2048 / 32);
    for (int it = first; it < I_UP + I_OUT + I_PQ; it += stride) { int r = it;
        if (r < I_UP) { tr32_item_f8(p.w_up, D, D, ws + WS_BTUP, 1024.0f, scr, r, lane); continue; } r -= I_UP;
        if (r < I_OUT) { tr32_item_f8(p.w_out, D, D, ws + WS_BTOUT, 1024.0f, scr, r, lane); continue; } r -= I_OUT;
        tr32_item(p.w_pq, D, 2048, (bf16*)(ws + WS_BTPQ), scr, r, lane); }
}
constexpr size_t WS_MODP = 1093 * MiB;
__device__ __forceinline__ void adaln_late(const Params& p, int item, int lane) {
    const int cc = item & 63, rg = item >> 6;
    const float* wp = p.w_ada + (size_t)(rg * 256) * (6 * D) + 2 * D + cc * 256 + lane * 4;
    f32x4 a0 = {0.f, 0.f, 0.f, 0.f}, a1 = a0, a2 = a0, a3 = a0;
#pragma unroll 8
    for (int d = 0; d < 256; ++d) { const f32x4 w = *(const f32x4*)(wp + (size_t)d * (6 * D)); const int dd = rg * 256 + d;
        const float c0 = p.c[dd], c1 = p.c[D + dd], c2 = p.c[2 * D + dd], c3 = p.c[3 * D + dd];
        a0 += w * (c0 / (1.0f + __expf(-c0))); a1 += w * (c1 / (1.0f + __expf(-c1))); a2 += w * (c2 / (1.0f + __expf(-c2))); a3 += w * (c3 / (1.0f + __expf(-c3))); }
    float* pp = (float*)(p.ws + WS_MODP) + (size_t)(rg * 4) * (4 * D) + cc * 256 + lane * 4;
    *(f32x4*)(pp) = a0; *(f32x4*)(pp + 4 * D) = a1; *(f32x4*)(pp + 2 * 4 * D) = a2; *(f32x4*)(pp + 3 * 4 * D) = a3;
}
__device__ __forceinline__ void adaln_late_reduce(const Params& p, const Ctx& c) {
    const float* pp = (const float*)(p.ws + WS_MODP); float* mod = (float*)(p.ws + WS_MOD);
    for (int i = c.bid * NTHR + c.tid; i < 4 * 4 * D; i += c.nb * NTHR) { const int b = i / (4 * D), col = i % (4 * D); float s_ = p.b_ada[2 * D + col];
#pragma unroll
        for (int rg = 0; rg < 16; ++rg) s_ += pp[(size_t)(rg * 4 + b) * (4 * D) + col];
        mod[(size_t)b * 6 * D + 2 * D + col] = s_; }
}
typedef unsigned v2u_t __attribute__((ext_vector_type(2)));
constexpr size_t SLB = (size_t)P_EXP * 192;
__device__ __forceinline__ void convert_expert_rows(const Params& p, const Ctx& c, int r_first, int r_stride) {
    unsigned char* ws = p.ws;
        {
            typedef float v16f_t __attribute__((ext_vector_type(16))); typedef float v32f_t __attribute__((ext_vector_type(32))); typedef unsigned v6u_t __attribute__((ext_vector_type(6)));
            v16f_t pa, pb;
#pragma unroll
            for (int i = 0; i < 16; ++i) { pa[i] = (i < 8) ? 0.125f * i : 1.0f + 0.125f * (i - 8); pb[i] = (i < 8) ? 2.0f + 0.25f * i : 4.0f + 0.5f * (i - 8); }
            const v32f_t pd = __builtin_amdgcn_cvt_scalef32_pk32_f32_fp6(__builtin_amdgcn_cvt_scalef32_2xpk16_fp6_f32(pa, pb, 1.0f), 1.0f);
            const bool inter = (pd[1] == pb[0]);
            bool okl = true;
#pragma unroll
            for (int i = 0; i < 16; ++i) okl = okl && (inter ? (pd[2 * i] == pa[i] && pd[2 * i + 1] == pb[i]) : (pd[i] == pa[i] && pd[16 + i] == pb[i]));
            for (int r = r_first; r < 2 * P_EXP; r += r_stride) {
                const bool isv = r >= P_EXP; const int e = isv ? r - P_EXP : r;
                const float* src = (isv ? p.v_exp : p.u_exp) + (size_t)e * D;
                f32x4 v[16]; float mx = 0.f;
#pragma unroll
                for (int g = 0; g < 2; ++g)
#pragma unroll
                    for (int k = 0; k < 8; ++k) { v[g * 8 + k] = *(const f32x4*)(src + (g * 64 + c.lane) * 32 + k * 4);
                        mx = fmaxf(mx, fmaxf(fmaxf(fabsf(v[g * 8 + k].x), fabsf(v[g * 8 + k].y)), fmaxf(fabsf(v[g * 8 + k].z), fabsf(v[g * 8 + k].w)))); }
#pragma unroll
                for (int o = 1; o < 64; o <<= 1) mx = fmaxf(mx, __shfl_xor(mx, o));
                const float scale = (mx > 0.f) ? mx * (1.0f / 7.5f) : 1.0f; float inv = 1.0f / scale;
                if (!okl) inv = __builtin_nanf("");
                v6u_t wq[2];
#pragma unroll
                for (int g = 0; g < 2; ++g) { v16f_t a, b;
#pragma unroll
                    for (int i = 0; i < 16; ++i) { const float ei = v[g * 8 + (2 * i) / 4][(2 * i) % 4], eo = v[g * 8 + (2 * i + 1) / 4][(2 * i + 1) % 4];
                        const float lo = v[g * 8 + i / 4][i % 4], hi = v[g * 8 + 4 + i / 4][i % 4];
                        a[i] = (inter ? ei : lo) * inv; b[i] = (inter ? eo : hi) * inv; }
                    wq[g] = __builtin_amdgcn_cvt_scalef32_2xpk16_fp6_f32(a, b, 1.0f); }
#pragma unroll
                for (int g = 0; g < 2; ++g) { unsigned char* drow = ws + (isv ? WS_V8 : WS_U8) + (size_t)(g * 8 + (c.lane >> 3)) * SLB + (size_t)e * 192;
                    *(v4u*)(drow + (c.lane & 7) * 16) = (v4u){wq[g][0], wq[g][1], wq[g][2], wq[g][3]};
                    *(v2u_t*)(drow + 128 + (c.lane & 7) * 8) = (v2u_t){wq[g][4], wq[g][5]}; }
                if (c.lane == 0) ((float*)(ws + (isv ? WS_SV : WS_SU)))[e] = scale;
            }
        }
}

__device__ __forceinline__ void ph_prologue(const Params& p, const Ctx& c) {
    unsigned char* ws = p.ws;
    {
        float* mod = (float*)(ws + WS_MOD); LAS float* sc = (LAS float*)c.lds;
        LAS float* red = sc + 4 * D;
        for (int it = c.bid; it < 2 * D / 128; it += c.nb) {
            __syncthreads();
            for (int i = c.tid; i < 4 * D; i += NTHR) { const float v = p.c[i]; sc[i] = v / (1.0f + __expf(-v)); }
            __syncthreads();
            const int ct = c.tid & 31, dg = c.tid >> 5, e = it * 128 + ct * 4;
            f32x4 a0 = {0, 0, 0, 0}, a1 = a0, a2 = a0, a3 = a0;
            const float* wp = p.w_ada + (size_t)dg * (6 * D) + e;
#pragma unroll 8
            for (int i = 0; i < D / 16; ++i) { const f32x4 w = *(const f32x4*)(wp + (size_t)(16 * i) * (6 * D)); const int d = dg + 16 * i;
                a0 += w * sc[d]; a1 += w * sc[D + d]; a2 += w * sc[2 * D + d]; a3 += w * sc[3 * D + d]; }
            *(LAS f32x4*)(red + (dg * 4 + 0) * 128 + ct * 4) = a0; *(LAS f32x4*)(red + (dg * 4 + 1) * 128 + ct * 4) = a1;
            *(LAS f32x4*)(red + (dg * 4 + 2) * 128 + ct * 4) = a2; *(LAS f32x4*)(red + (dg * 4 + 3) * 128 + ct * 4) = a3;
            __syncthreads();
            { const int b = c.tid >> 7, col = c.tid & 127; float s = p.b_ada[it * 128 + col];
#pragma unroll
              for (int g = 0; g < 16; ++g) s += red[(g * 4 + b) * 128 + col];
              mod[(size_t)b * 6 * D + it * 128 + col] = s; }
        }
        __syncthreads();
    }
    {
        LAS float* scr = (LAS float*)(c.lds + c.wave * 8448);
        bf16* BT1 = (bf16*)(ws + WS_BT1); bf16* BT2 = (bf16*)(ws + WS_BT2);
        constexpr int I_IN = 64 * (IN_BF / 32), I_IN8 = 64 * ((IN_WIDTH - IN_BF) / 32), I_GATE = 64 * (2 * D / 32), I_UQ = 16 * (A_WIDTH / 32), I_QI = 16 * (IDX_H * IDX_D / 32), I_UV = 8 * (A_WIDTH / 32),
                      I_UVX = 0;
        constexpr int NITEMS = I_IN + I_IN8 + I_GATE + I_UQ + I_QI + I_UV + I_UVX;
        for (int it = c.gw; it < NITEMS; it += c.ngw) {
            int r = it;
            if (r < I_IN) { p0_transpose_item(p.w_in, D, IN_BF, BT1, 0, scr, r, c.lane, IN_WIDTH); continue; } r -= I_IN;
            if (r < I_IN8) { p0_transpose_item_f8(p.w_in + IN_BF, D, IN_WIDTH - IN_BF, ws + WS_W8IN, 1024.0f, scr, r, c.lane, IN_WIDTH); continue; } r -= I_IN8;
            if (r < I_GATE) { p0_transpose_item_f8(p.w_gate, D, 2 * D, ws + WS_G8, 1024.0f, scr, r, c.lane); continue; } r -= I_GATE;
            if (r < I_UQ) { p0_transpose_item(p.w_uq, A_QR, A_WIDTH, BT2, 0, scr, r, c.lane); continue; } r -= I_UQ;
            if (r < I_QI) { p0_transpose_item(p.w_qi, A_QR, IDX_H * IDX_D, BT2, A_WIDTH, scr, r, c.lane); continue; } r -= I_QI;
            p0_transpose_item(p.w_uv, A_KVR, A_WIDTH, (bf16*)(ws + WS_BTUV), 0, scr, r, c.lane);
        }
        const size_t gt = (size_t)c.bid * NTHR + c.tid, gs = (size_t)c.nb * NTHR;
        for (size_t i = gt; i < (size_t)(IN_PAD - IN_WIDTH) * D / 16; i += gs) *(v4u*)(ws + WS_W8IN + (size_t)(IN_WIDTH - IN_BF) * D + 16 * i) = (v4u){0u, 0u, 0u, 0u};
        p0_convert(p.w_uk, (bf16*)(ws + WS_WUK), (size_t)A_KVR * A_WIDTH, gt, gs);
        p0_convert(p.sub_keys, (bf16*)(ws + WS_SK), (size_t)2 * P_NK * 128, gt, gs);
    }
}

__device__ __forceinline__ void ph_modulate(const float* X, const float* g, const float* mod, int sh_off, int sc_off, bf16* H, unsigned char* H8, const Ctx& c) {
    for (int m = c.gw; m < T; m += c.ngw) {
        const int b = m / SEQ;
        const f32x4* xr = (const f32x4*)(X + (size_t)m * D) + c.lane;
        f32x4 v[16]; float s = 0.f;
#pragma unroll
        for (int j = 0; j < 16; ++j) { v[j] = xr[64 * j]; s += (v[j].x * v[j].x + v[j].y * v[j].y) + (v[j].z * v[j].z + v[j].w * v[j].w); }
        const float rstd = 1.0f / sqrtf(wave_sum(s) * (1.0f / D) + EPS);
        const f32x4* gp = (const f32x4*)g + c.lane; const f32x4* shp = (const f32x4*)(mod + (size_t)b * 6 * D + sh_off) + c.lane; const f32x4* scp = (const f32x4*)(mod + (size_t)b * 6 * D + sc_off) + c.lane;
        v2u* o = (v2u*)(H + (size_t)m * D) + c.lane;
#pragma unroll
        for (int j = 0; j < 16; ++j) { const f32x4 gg = gp[64 * j], sh = shp[64 * j], sc = scp[64 * j];
            const f32x4 y = (v[j] * rstd * gg) * (sc + 1.0f) + sh;
            v2u w; w.x = cvt_pk_bf16(y.x, y.y); w.y = cvt_pk_bf16(y.z, y.w); o[64 * j] = w;
            if (H8) { int q = 0; q = PK_FP8(y.x * 16.0f, y.y * 16.0f, q, false); q = PK_FP8(y.z * 16.0f, y.w * 16.0f, q, true); ((unsigned*)(H8 + (size_t)m * D))[c.lane + 64 * j] = (unsigned)q; } }
    }
}

__device__ __forceinline__ void ph_postproc(const Params& p, const Ctx& c) {
    bf16* P1 = (bf16*)(p.ws + WS_P1); float* WIDX = (float*)(p.ws + WS_WIDX);
    const int lane = c.lane;
    const float inv = exp2f(-(float)lane * (13.287712379549449f / 63.0f));
    for (int t = c.gw; t < T; t += c.ngw) {
        bf16* row = P1 + (size_t)t * N1;
        const int pos = t % SEQ;
        { v4u a = *(v4u*)(row + C_CQ + lane * 8), b = *(v4u*)(row + C_CQ + 512 + lane * 8);
          float f[16] = {bflo(a.x), bfhi(a.x), bflo(a.y), bfhi(a.y), bflo(a.z), bfhi(a.z), bflo(a.w), bfhi(a.w), bflo(b.x), bfhi(b.x), bflo(b.y), bfhi(b.y), bflo(b.z), bfhi(b.z), bflo(b.w), bfhi(b.w)};
          float s = 0.f;
#pragma unroll
          for (int j = 0; j < 16; ++j) s += f[j] * f[j];
          const float rstd = 1.0f / sqrtf(wave_sum(s) * (1.0f / A_QR) + EPS);
          const float* g0 = p.g_cq + lane * 8; const float* g1 = p.g_cq + 512 + lane * 8;
#pragma unroll
          for (int j = 0; j < 8; ++j) { f[j] *= rstd * g0[j]; f[8 + j] *= rstd * g1[j]; }
          a.x = cvt_pk_bf16(f[0], f[1]); a.y = cvt_pk_bf16(f[2], f[3]); a.z = cvt_pk_bf16(f[4], f[5]); a.w = cvt_pk_bf16(f[6], f[7]);
          b.x = cvt_pk_bf16(f[8], f[9]); b.y = cvt_pk_bf16(f[10], f[11]); b.z = cvt_pk_bf16(f[12], f[13]); b.w = cvt_pk_bf16(f[14], f[15]);
          *(v4u*)(row + C_CQ + lane * 8) = a; *(v4u*)(row + C_CQ + 512 + lane * 8) = b; }
        { v4u a = *(v4u*)(row + C_CKV + lane * 8);
          float f[8] = {bflo(a.x), bfhi(a.x), bflo(a.y), bfhi(a.y), bflo(a.z), bfhi(a.z), bflo(a.w), bfhi(a.w)};
          float s = 0.f;
#pragma unroll
          for (int j = 0; j < 8; ++j) s += f[j] * f[j];
          const float rstd = 1.0f / sqrtf(wave_sum(s) * (1.0f / A_KVR) + EPS);
          const float* g0 = p.g_ckv + lane * 8;
#pragma unroll
          for (int j = 0; j < 8; ++j) f[j] *= rstd * g0[j];
          a.x = cvt_pk_bf16(f[0], f[1]); a.y = cvt_pk_bf16(f[2], f[3]); a.z = cvt_pk_bf16(f[4], f[5]); a.w = cvt_pk_bf16(f[6], f[7]);
          *(v4u*)((bf16*)(p.ws + WS_CKV) + (size_t)t * A_KVR + lane * 8) = a; }
        { unsigned w = *(unsigned*)(row + C_KI + lane * 2); const float f0 = bflo(w), f1 = bfhi(w);
          const float mu = wave_sum(f0 + f1) * (1.0f / IDX_D); const float d0 = f0 - mu, d1 = f1 - mu;
          const float var = wave_sum(d0 * d0 + d1 * d1) * (1.0f / IDX_D); const float rstd = 1.0f / sqrtf(var + EPS);
          const float y0 = d0 * rstd * p.g_ki[lane * 2] + p.b_ki[lane * 2], y1 = d1 * rstd * p.g_ki[lane * 2 + 1] + p.b_ki[lane * 2 + 1];
          *(unsigned*)(row + C_KI + lane * 2) = cvt_pk_bf16(y0, y1); }
        WIDX[(size_t)t * IDX_H + lane] = bf2f(row[C_WI + lane]) * (0.125f * 0.08838834764831845f);
        { const float angf = (float)pos * inv; const double a = (double)angf; const double r = a - 6.283185307179586476925 * rint(a * 0.15915494309189533577);
          float sn, cs; __sincosf((float)r, &sn, &cs);
#pragma unroll
          for (int h = 0; h < R_HEADS; ++h) {
              bf16* q = row + C_RQ + h * 128; bf16* k = row + C_RK + h * 128;
              const float q1 = bf2f(q[lane]), q2 = bf2f(q[64 + lane]), k1 = bf2f(k[lane]) * 0.08838834764831845f, k2 = bf2f(k[64 + lane]) * 0.08838834764831845f;
              q[lane] = f2bf(q1 * cs - q2 * sn); q[64 + lane] = f2bf(q1 * sn + q2 * cs);
              k[lane] = f2bf(k1 * cs - k2 * sn); k[64 + lane] = f2bf(k1 * sn + k2 * cs); } }
    }
}

template <bool OUT8> __device__ __forceinline__ void lds_gemm_unit(const bf16* A, int lda, const bf16* Bt, int ldb, int K, void* C, int ldc, float s8, const Ctx& c) {
    constexpr int PB = 272; LAS unsigned char* As = c.lds; LAS unsigned char* Bs = c.lds + 256 * PB;
    const int tid = c.tid, lane = c.lane, wr = c.wave >> 1, wc = c.wave & 1, fr = lane & 15, fq = lane >> 4;
    f32x4 acc[4][4];
#pragma unroll
    for (int i = 0; i < 4; ++i)
#pragma unroll
        for (int j = 0; j < 4; ++j) acc[i][j] = (f32x4){0.f, 0.f, 0.f, 0.f};
    for (int k0 = 0; k0 < K; k0 += 128) {
        __syncthreads();
#pragma unroll
        for (int i = 0; i < 8; ++i) { const int q = tid + 512 * i, r = q >> 4, ch = q & 15; *(LAS v4u*)(As + r * PB + ch * 16) = *(const v4u*)(A + (size_t)r * lda + k0 + ch * 8); }
#pragma unroll
        for (int i = 0; i < 4; ++i) { const int q = tid + 512 * i, r = q >> 4, ch = q & 15; *(LAS v4u*)(Bs + r * PB + ch * 16) = *(const v4u*)(Bt + (size_t)r * ldb + k0 + ch * 8); }
        LDS_WAIT(); __syncthreads();
#pragma unroll
        for (int ks = 0; ks < 4; ++ks) { bf16x8 a[4], b[4];
#pragma unroll
            for (int i = 0; i < 4; ++i) { a[i] = *(const LAS bf16x8*)(As + (64 * wr + 16 * i + fr) * PB + ks * 64 + fq * 16); b[i] = *(const LAS bf16x8*)(Bs + (64 * wc + 16 * i + fr) * PB + ks * 64 + fq * 16); }
#pragma unroll
            for (int i = 0; i < 4; ++i)
#pragma unroll
                for (int j = 0; j < 4; ++j) acc[i][j] = __builtin_amdgcn_mfma_f32_16x16x32_bf16(b[j], a[i], acc[i][j], 0, 0, 0); }
    }
#pragma unroll
    for (int i = 0; i < 4; ++i)
#pragma unroll
        for (int j = 0; j < 4; ++j) { const size_t off = (size_t)(64 * wr + 16 * i + fr) * ldc + 64 * wc + 16 * j + 4 * fq;
            if constexpr (OUT8) { int q = 0; q = PK_FP8(acc[i][j][0] * s8, acc[i][j][1] * s8, q, false); q = PK_FP8(acc[i][j][2] * s8, acc[i][j][3] * s8, q, true); *(unsigned*)((unsigned char*)C + off) = (unsigned)q; }
            else { v2u w; w.x = cvt_pk_bf16(acc[i][j][0], acc[i][j][1]); w.y = cvt_pk_bf16(acc[i][j][2], acc[i][j][3]); *(v2u*)((bf16*)C + off) = w; } }
}
__device__ __forceinline__ void ph_qlat(const Params& p, const Ctx& c) {
    const bf16* Q2 = (const bf16*)(p.ws + WS_Q2); const bf16* WUK = (const bf16*)(p.ws + WS_WUK); bf16* QL = (bf16*)(p.ws + WS_QL);
    for (int u = c.bid; u < 16 * 32 * 4; u += c.nb) { const int h = u / 128, rem = u % 128, rt = rem / 4, ct = rem % 4;
        lds_gemm_unit<false>(Q2 + (size_t)(rt * 256) * N2 + h * 128, N2, WUK + (size_t)(ct * 128) * A_WIDTH + h * 128, A_WIDTH, 128, QL + (size_t)(rt * 256) * 8192 + h * 512 + ct * 128, 8192, 1.0f, c); }
    __syncthreads();
}
__device__ __forceinline__ void ph_oproj(const Params& p, const Ctx& c) {
    const bf16* OL = (const bf16*)(p.ws + WS_OLAT); const bf16* BTUV = (const bf16*)(p.ws + WS_BTUV); unsigned char* Y8 = p.ws + WS_YCAT;
    for (int u = c.bid; u < 16 * 32; u += c.nb) { const int h = u / 32, rt = u % 32;
        lds_gemm_unit<true>(OL + (size_t)(rt * 256) * 8192 + h * 512, 8192, BTUV + (size_t)(h * 128) * A_KVR, A_KVR, A_KVR, Y8 + (size_t)(rt * 256) * D + h * 128, D, 16.0f, c); }
    __syncthreads();
}

__device__ __forceinline__ void ph_scores(const Params& p, const Ctx& c) {
    const bf16* P1 = (const bf16*)(p.ws + WS_P1); const bf16* Q2 = (const bf16*)(p.ws + WS_Q2); const float* WIDX = (const float*)(p.ws + WS_WIDX); float* SC = (float*)(p.ws + WS_SC);
    constexpr int QPB = 272, QH = 32, QBYTES = QH * 16 * QPB;
    constexpr int WPB = 272; LAS unsigned char* wl = c.lds + QBYTES;
    const int tid = c.tid, lane = c.lane, w = c.wave, fr = lane & 15, fq = lane >> 4;
    for (int bu = c.bid; bu < NB * 64; bu += c.nb) {
        const int b = bu / 64, pr = bu % 64;
        for (int side = 0; side < 2; ++side) {
            const int qt = side ? 127 - pr : pr, nitems = qt / 4 + 1, t0 = b * SEQ + qt * 16;
            for (int half = 0; half < 2; ++half) {
                __syncthreads();
                if (half == 0 && tid < 256) { const int wq = tid >> 4, wc = tid & 15;
                    *(LAS f32x4*)(wl + wq * WPB + wc * 16) = *(const f32x4*)(WIDX + (size_t)(t0 + wq) * IDX_H + wc * 4); }
#pragma unroll
                for (int g = 0; g < 2; ++g) { v4u r[8];
#pragma unroll
                    for (int i = 0; i < 8; ++i) { const int q = tid + 512 * (g * 8 + i), hh = q >> 8, qq = (q >> 4) & 15, ch = q & 15;
                        r[i] = *(const v4u*)(Q2 + (size_t)(t0 + qq) * N2 + A_WIDTH + (half * QH + hh) * IDX_D + ch * 8); }
#pragma unroll
                    for (int i = 0; i < 8; ++i) { const int q = tid + 512 * (g * 8 + i);
                        *(LAS v4u*)(c.lds + (q >> 4) * QPB + (q & 15) * 16) = r[i]; } }
                LDS_WAIT(); __syncthreads();
                for (int item = w; item < nitems; item += 8) {
                    const int s0 = b * SEQ + item * 64;
                    bf16x8 kf[4][4];
#pragma unroll
                    for (int mi = 0; mi < 4; ++mi)
#pragma unroll
                        for (int ks = 0; ks < 4; ++ks) kf[mi][ks] = *(const bf16x8*)(P1 + (size_t)(s0 + 16 * mi + fr) * N1 + C_KI + 32 * ks + 8 * fq);
                    f32x4 sc[4];
                    float* scp = SC + (size_t)(t0 + fr) * SEQ + item * 64 + 4 * fq;
                    if (half) {
#pragma unroll
                        for (int mi = 0; mi < 4; ++mi) sc[mi] = *(const f32x4*)(scp + 16 * mi); }
                    else {
#pragma unroll
                        for (int mi = 0; mi < 4; ++mi) sc[mi] = (f32x4){0.f, 0.f, 0.f, 0.f}; }
                    __builtin_amdgcn_s_waitcnt(0x0F70);
                    const LAS unsigned char* wb = wl + fr * WPB + half * QH * 4;
                    const LAS unsigned char* qb = c.lds + fr * QPB + fq * 16;
#define SC_MM(A, hh) do { bf16x8 qf[4]; _Pragma("unroll") for (int ks = 0; ks < 4; ++ks) qf[ks] = *(const LAS bf16x8*)(buf + (hh) * 16 * QPB + ks * 64); \
                _Pragma("unroll") for (int mi = 0; mi < 4; ++mi) A[mi] = (f32x4){0.f, 0.f, 0.f, 0.f}; \
                _Pragma("unroll") for (int ks = 0; ks < 4; ++ks) _Pragma("unroll") for (int mi = 0; mi < 4; ++mi) A[mi] = __builtin_amdgcn_mfma_f32_16x16x32_bf16(kf[mi][ks], qf[ks], A[mi], 0, 0, 0); } while (0)
#define SC_EPI(A, hh) do { _Pragma("unroll") for (int mi = 0; mi < 4; ++mi) _Pragma("unroll") for (int j = 0; j < 4; ++j) sc[mi][j] += wv[hh] * __int_as_float(max(__float_as_int(A[mi][j]), 0)); } while (0)
#define SC_PIPE() do { _Pragma("unroll") for (int _q = 0; _q < 16; ++_q) { __builtin_amdgcn_sched_group_barrier(0x8, 1, 0); __builtin_amdgcn_sched_group_barrier(0x2, 2, 0); } } while (0)
                    for (int hg = 0; hg < QH / 4; ++hg) {
                        const LAS unsigned char* buf = qb + hg * 4 * 16 * QPB;
                        const f32x4 wv = *(const LAS f32x4*)(wb + hg * 16);
                        f32x4 a0[4], a1[4];
                        SC_MM(a0, 0);
                        SC_MM(a1, 1); SC_EPI(a0, 0); SC_PIPE();
                        SC_MM(a0, 2); SC_EPI(a1, 1); SC_PIPE();
                        SC_MM(a1, 3); SC_EPI(a0, 2); SC_PIPE();
                        SC_EPI(a1, 3);
                    }
#undef SC_MM
#undef SC_EPI
#undef SC_PIPE
#pragma unroll
                    for (int mi = 0; mi < 4; ++mi) *(f32x4*)(scp + 16 * mi) = sc[mi];
                }
            }
        }
    }
    __syncthreads();
}

__device__ __forceinline__ void ph_topk(const Params& p, const Ctx& c) {
    const float* SC = (const float*)(p.ws + WS_SC); int* SEL = (int*)(p.ws + WS_SEL); int* CNT = (int*)(p.ws + WS_CNT);
    const int lane = c.lane; const unsigned long long lt_mask = (1ull << lane) - 1ull;
    for (int t = c.gw; t < T; t += c.ngw) {
        const int pos = t % SEQ, qc = pos / CHUNK, nadm = (qc + 1) * CHUNK;
        int* so = SEL + (size_t)t * TOPK;
        if (nadm <= TOPK) { for (int i = lane; i < nadm; i += 64) so[i] = i; if (lane == 0) CNT[t] = nadm; continue; }
        unsigned key[32];
        const float* sr = SC + (size_t)t * SEQ;
#pragma unroll
        for (int j = 0; j < 32; ++j) { unsigned k = 0u; if (j <= qc) { const unsigned bits = __float_as_uint(sr[lane + 64 * j]); k = (bits & 0x80000000u) ? ~bits : (bits | 0x80000000u); } key[j] = k; }
        unsigned thr = 0u;
        for (int bit = 31; bit >= 0; --bit) { const unsigned cand = thr | (1u << bit); int cnt = 0;
#pragma unroll
            for (int j = 0; j < 32; ++j) cnt += __popcll(__ballot(key[j] >= cand));
            if (cnt >= TOPK) { thr = cand; if (cnt == TOPK) break; } }
        int ngt = 0;
#pragma unroll
        for (int j = 0; j < 32; ++j) ngt += __popcll(__ballot(key[j] > thr));
        const int need = TOPK - ngt; int base = 0, eqt = 0;
#pragma unroll
        for (int j = 0; j < 32; ++j) {
            const unsigned long long mg = __ballot(key[j] > thr), me = __ballot(key[j] == thr);
            const int erank = __popcll(me & lt_mask) + eqt; const bool esel = (key[j] == thr) && (erank < need);
            const unsigned long long ms = mg | __ballot(esel);
            if ((ms >> lane) & 1ull) so[base + __popcll(ms & lt_mask)] = lane + 64 * j;
            base += __popcll(ms); eqt += __popcll(me);
        }
        if (lane == 0) CNT[t] = TOPK;
    }
}

__device__ __forceinline__ int t5_bucket(int rel) {
    const int n = rel < 0 ? -rel : rel; int bk;
    if (n < 8) bk = n; else { const int n2 = n * n; int k = 0;
#pragma unroll
        for (int j = 1; j <= 7; ++j) k += (n2 >= (64 << j)) ? 1 : 0;
        bk = 8 + k; }
    return (rel > 0 ? 16 : 0) + bk;
}
__device__ __forceinline__ bf16x4 tr_read4(unsigned addr, int) { bf16x4 r; asm volatile("ds_read_b64_tr_b16 %0, %1\n\ts_waitcnt lgkmcnt(0)" : "=&v"(r) : "v"(addr) : "memory"); return r; }
#define TR_READ(dst, addr, OFF) asm volatile("ds_read_b64_tr_b16 %0, %1 offset:%2" : "=&v"(dst) : "v"(addr), "i"(OFF) : "memory")

constexpr int KV_PITCH = 1056;
constexpr int ATT_LDS_END = 8 * 16 * KV_PITCH + 64 + 2048;
__device__ __forceinline__ void ph_attn(const Params& p, const Ctx& c) {
    const bf16* CKV = (const bf16*)(p.ws + WS_CKV); const bf16* QL = (const bf16*)(p.ws + WS_QL); const int* SEL = (const int*)(p.ws + WS_SEL); const int* CNT = (const int*)(p.ws + WS_CNT);
    bf16* OL = (bf16*)(p.ws + WS_OLAT);
    const int lane = c.lane, fr = lane & 15, fq = lane >> 4;
    const int cw = c.wave & 3;
    LAS unsigned char* buf0 = c.lds + cw * (32 * KV_PITCH);
    const unsigned bufa = (unsigned)(size_t)buf0;
    const unsigned tr_base0 = bufa + (unsigned)((4 * fq + (fr >> 2)) * KV_PITCH + (fr & 3) * 8);
    const float t5b_scale = 0.08838834764831845f;
    LAS float* t5l = (LAS float*)(c.lds + 8 * 16 * KV_PITCH + 64);
    unsigned* ctl = (unsigned*)(p.ws + WS_CTL);
    LAS unsigned* xm = (LAS unsigned*)(c.lds + 8 * 16 * KV_PITCH);
    if (c.tid == 0) { const unsigned x = xb_xcc_id(); unsigned pre = 0, tot = 0;
        for (unsigned j = 0; j < 16; ++j) { const unsigned n = xb_ld(&ctl[XB_XCNT(j)]); pre += (j < x) ? n : 0u; tot += n; }
        const bool ok = (tot == (unsigned)c.nb) && (T % (c.nb * 4) == 0);
        unsigned rk = 0; if (ok) rk = xb_add(&ctl[XB_ATT_RANK + 64 * x], 1u);
        xm[0] = ok ? (pre + rk) : 0xffffffffu; }
    t5l[c.tid] = p.t5[c.tid];
    __syncthreads();
    const unsigned vbx = xm[0]; const bool xmap = (vbx != 0xffffffffu);
    const int naw = c.nb * 4;
    if (c.wave >= 4) { for (int it = c.bid * 4 + (c.wave - 4); it < 1024; it += naw) adaln_late(p, it, c.lane); convert_late_weights(p, (LAS float*)(c.lds + ATT_LDS_END + (c.wave - 4) * 4224), c.lane, c.bid * 4 + (c.wave - 4), naw); convert_expert_rows(p, c, c.bid * 4 + (c.wave - 4), naw); }
    if (c.wave < 4)
    for (int it = c.bid * 4 + cw; it < T; it += naw) {
        int t = it;
        if (xmap) { const int base = (int)vbx * 4 + cw;
            const int bsz = naw / NB, q = it / naw;
            t = (base / bsz) * SEQ + (base % bsz) + q * bsz; }
        const int b = t / SEQ, pos = t % SEQ;
        const int cnt = CNT[t];
        int s0 = 0, s1 = 0, s2 = 0, s3 = 0;
        if (lane < cnt) s0 = SEL[(size_t)t * TOPK + lane];
        if (lane + 64 < cnt) s1 = SEL[(size_t)t * TOPK + 64 + lane];
        if (lane + 128 < cnt) s2 = SEL[(size_t)t * TOPK + 128 + lane];
        if (lane + 192 < cnt) s3 = SEL[(size_t)t * TOPK + 192 + lane];
        const bf16* kvb = CKV + (size_t)(b * SEQ) * A_KVR + lane * 8;
        const int nch = cnt >> 4;
#define ATT_GATHER(ch_) do { const int _c = (ch_); const int _sj = (_c < 4) ? s0 : (_c < 8) ? s1 : (_c < 12) ? s2 : s3; const int _lb = (_c & 3) * 16; \
            LAS unsigned char* _b = buf0 + (_c & 1) * (16 * KV_PITCH); \
            _Pragma("unroll") for (int r = 0; r < 16; ++r) { const int idx = __builtin_amdgcn_readlane(_sj, _lb + r); \
                __builtin_amdgcn_global_load_lds((const unsigned*)(kvb + (size_t)idx * A_KVR), (LAS unsigned*)(_b + r * KV_PITCH), 16, 0, 0); } } while (0)
        ATT_GATHER(0);
        bf16x8 qf[16];
#pragma unroll
        for (int ks = 0; ks < 16; ++ks) qf[ks] = *(const bf16x8*)(QL + (size_t)t * 8192 + fr * 512 + ks * 32 + fq * 8);
        f32x4 acc[32];
#pragma unroll
        for (int mt = 0; mt < 32; ++mt) acc[mt] = (f32x4){0.f, 0.f, 0.f, 0.f};
        float m_run = -INFINITY, l_run = 0.f;
        float bias[4];
#define ATT_BIAS(ch_) do { const int _c = (ch_); const int _sj = (_c < 4) ? s0 : (_c < 8) ? s1 : (_c < 12) ? s2 : s3; const int _lb = (_c & 3) * 16; \
            _Pragma("unroll") for (int j = 0; j < 4; ++j) { const int kidx = __shfl(_sj, _lb + 4 * fq + j); bias[j] = t5l[t5_bucket(kidx - pos) * A_HEADS + fr]; } } while (0)
        for (int ch = 0; ch < nch; ++ch) {
            ATT_BIAS(ch);
            if (ch + 1 < nch) { ATT_GATHER(ch + 1); asm volatile("s_waitcnt vmcnt(16)" ::: "memory"); } else { asm volatile("s_waitcnt vmcnt(0)" ::: "memory"); }
            LAS unsigned char* buf = buf0 + (ch & 1) * (16 * KV_PITCH);
            const unsigned tr_base = tr_base0 + (unsigned)((ch & 1) * (16 * KV_PITCH));
            f32x4 sa = {0.f, 0.f, 0.f, 0.f}, sb = sa;
#pragma unroll
            for (int ks = 0; ks < 16; ks += 2) {
                const bf16x8 a0 = *(const LAS bf16x8*)(buf + fr * KV_PITCH + (ks + 0) * 64 + fq * 16), a1 = *(const LAS bf16x8*)(buf + fr * KV_PITCH + (ks + 1) * 64 + fq * 16);
                sa = __builtin_amdgcn_mfma_f32_16x16x32_bf16(a0, qf[ks + 0], sa, 0, 0, 0); sb = __builtin_amdgcn_mfma_f32_16x16x32_bf16(a1, qf[ks + 1], sb, 0, 0, 0); }
            const f32x4 s = sa + sb;
            float lg[4]; float mc = -INFINITY;
#pragma unroll
            for (int j = 0; j < 4; ++j) { lg[j] = s[j] * t5b_scale + bias[j]; mc = fmaxf(mc, lg[j]); }
            mc = fmaxf(mc, __shfl_xor(mc, 16)); mc = fmaxf(mc, __shfl_xor(mc, 32));
            if (__ballot(mc > m_run + 8.0f)) { const float m_new = fmaxf(m_run, mc); const float alpha = __expf(m_run - m_new); l_run *= alpha; m_run = m_new;
#pragma unroll
                for (int mt = 0; mt < 32; ++mt) acc[mt] *= alpha; }
            float pe[4]; float ps = 0.f;
#pragma unroll
            for (int j = 0; j < 4; ++j) { pe[j] = __expf(lg[j] - m_run); ps += pe[j]; }
            l_run += ps;
            v2u pw; pw.x = cvt_pk_bf16(pe[0], pe[1]); pw.y = cvt_pk_bf16(pe[2], pe[3]);
            const unsigned qx = (unsigned)__shfl_xor((int)pw.x, 32), qy = (unsigned)__shfl_xor((int)pw.y, 32);
            const bool lowg = fq < 2;
            const v4u pb4 = lowg ? (v4u){pw.x, pw.y, qx, qy} : (v4u){0u, 0u, 0u, 0u};
            const bf16x8 pb = __builtin_bit_cast(bf16x8, pb4);
            const unsigned tr2 = tr_base + (unsigned)((lowg ? 8 : -8) * KV_PITCH);
            bf16x4 ta[2], tb[2], ua[2], ub[2];
#define ATT_TR(d1, d2, g) do { _Pragma("unroll") for (int i = 0; i < 2; ++i) { TR_READ(d1[i], tr_base, ((g) * 2 + i) * 32); TR_READ(d2[i], tr2, ((g) * 2 + i) * 32); } } while (0)
#define ATT_MM(s1, s2, g) do { _Pragma("unroll") for (int i = 0; i < 2; ++i) acc[(g) * 2 + i] = __builtin_amdgcn_mfma_f32_16x16x32_bf16(__builtin_shufflevector(s1[i], s2[i], 0, 1, 2, 3, 4, 5, 6, 7), pb, acc[(g) * 2 + i], 0, 0, 0); } while (0)
            ATT_TR(ta, ua, 0);
#pragma unroll
            for (int g = 0; g < 16; g += 2) {
                ATT_TR(tb, ub, g + 1);
                asm volatile("s_waitcnt lgkmcnt(4)" : "+v"(ta[0]), "+v"(ta[1]), "+v"(ua[0]), "+v"(ua[1]) :: "memory");
                ATT_MM(ta, ua, g);
                if (g + 2 < 16) ATT_TR(ta, ua, g + 2);
                if (g + 2 < 16) asm volatile("s_waitcnt lgkmcnt(4)" : "+v"(tb[0]), "+v"(tb[1]), "+v"(ub[0]), "+v"(ub[1]) :: "memory");
                else asm volatile("s_waitcnt lgkmcnt(0)" : "+v"(tb[0]), "+v"(tb[1]), "+v"(ub[0]), "+v"(ub[1]) :: "memory");
                ATT_MM(tb, ub, g + 1);
            }
#undef ATT_TR
#undef ATT_MM
            asm volatile("" ::: "memory");
        }
#undef ATT_BIAS
#undef ATT_GATHER
        float lt = l_run; lt += __shfl_xor(lt, 16); lt += __shfl_xor(lt, 32);
        const float il = 1.0f / lt;
        bf16* orow = OL + (size_t)t * 8192 + fr * 512 + 4 * fq;
#pragma unroll
        for (int mt = 0; mt < 32; ++mt) { v2u w; w.x = cvt_pk_bf16(acc[mt][0] * il, acc[mt][1] * il); w.y = cvt_pk_bf16(acc[mt][2] * il, acc[mt][3] * il); *(v2u*)(orow + 16 * mt) = w; }
    }
    __syncthreads();
}

#define TR_PAIR(dst, addr, PITCH4) do { bf16x4 _lo, _hi; \
    asm volatile("ds_read_b64_tr_b16 %0, %2\n\tds_read_b64_tr_b16 %1, %2 offset:%3\n\ts_waitcnt lgkmcnt(0)" : "=&v"(_lo), "=&v"(_hi) : "v"(addr), "i"(PITCH4) : "memory"); \
    dst = __builtin_shufflevector(_lo, _hi, 0, 1, 2, 3, 4, 5, 6, 7); } while (0)

constexpr size_t WS_SN = 1464 * MiB;
__device__ __forceinline__ void ph_ret_state(const Params& p, const Ctx& c) {
    const bf16* P1 = (const bf16*)(p.ws + WS_P1); bf16* SN = (bf16*)(p.ws + WS_SN);
    constexpr int KPB = 272, VPB = 80;
    LAS unsigned char* ktb = c.lds; LAS unsigned char* vtb = c.lds + 2 * 64 * KPB;
    const int tid = c.tid, lane = c.lane, w = c.wave, fr = lane & 15, fq = lane >> 4;
    for (int u = c.bid; u < NB * R_HEADS * 8; u += c.nb) {
        const int b = u / 64, h = (u / 8) % 8, vsl = u % 8;
        const float gam = 1.0f - exp2f(-5.0f - (float)h), lgm = logf(gam), dec64 = __expf(64.0f * lgm);
        f32x4 acc[2] = {{0.f, 0.f, 0.f, 0.f}, {0.f, 0.f, 0.f, 0.f}};
        const int kr0 = tid >> 4, kc0 = tid & 15;
        const int vr = tid >> 2, vc = tid & 3;
        const bf16* kbase = P1 + (size_t)(b * SEQ) * N1 + C_RK + h * 128 + kc0 * 8;
        const bf16* vbase = P1 + (size_t)(b * SEQ) * N1 + C_RV + h * 256 + vsl * 32 + vc * 8;
        const float sc0 = __expf((float)(63 - kr0) * lgm), sc1 = __expf((float)(31 - kr0) * lgm);
        v4u ka, kb, va = {0u, 0u, 0u, 0u};
        ka = *(const v4u*)(kbase + (size_t)kr0 * N1); kb = *(const v4u*)(kbase + (size_t)(kr0 + 32) * N1); if (tid < 256) va = *(const v4u*)(vbase + (size_t)vr * N1);
        __syncthreads();
        for (int n = 0; n < SEQ / CHUNK; ++n) {
            LAS unsigned char* kt = ktb + (n & 1) * 64 * KPB; LAS unsigned char* vt = vtb + (n & 1) * 64 * VPB;
            { v4u o; o.x = cvt_pk_bf16(bflo(ka.x) * sc0, bfhi(ka.x) * sc0); o.y = cvt_pk_bf16(bflo(ka.y) * sc0, bfhi(ka.y) * sc0); o.z = cvt_pk_bf16(bflo(ka.z) * sc0, bfhi(ka.z) * sc0); o.w = cvt_pk_bf16(bflo(ka.w) * sc0, bfhi(ka.w) * sc0);
              *(LAS v4u*)(kt + kr0 * KPB + kc0 * 16) = o;
              o.x = cvt_pk_bf16(bflo(kb.x) * sc1, bfhi(kb.x) * sc1); o.y = cvt_pk_bf16(bflo(kb.y) * sc1, bfhi(kb.y) * sc1); o.z = cvt_pk_bf16(bflo(kb.z) * sc1, bfhi(kb.z) * sc1); o.w = cvt_pk_bf16(bflo(kb.w) * sc1, bfhi(kb.w) * sc1);
              *(LAS v4u*)(kt + (kr0 + 32) * KPB + kc0 * 16) = o;
              if (tid < 256) *(LAS v4u*)(vt + vr * VPB + vc * 16) = va; }
            if (n + 1 < SEQ / CHUNK) { const size_t ro = (size_t)((n + 1) * CHUNK) * N1;
                ka = *(const v4u*)(kbase + ro + (size_t)kr0 * N1); kb = *(const v4u*)(kbase + ro + (size_t)(kr0 + 32) * N1); if (tid < 256) va = *(const v4u*)(vbase + ro + (size_t)vr * N1); }
            { bf16* sp = SN + ((size_t)((b * R_HEADS + h) * 32 + n) * 256 + vsl * 32 + fr) * 128 + 16 * w + 4 * fq;
#pragma unroll
              for (int nt = 0; nt < 2; ++nt) { v2u o; o.x = cvt_pk_bf16(acc[nt][0], acc[nt][1]); o.y = cvt_pk_bf16(acc[nt][2], acc[nt][3]); *(v2u*)(sp + (size_t)(16 * nt) * 128) = o; acc[nt] *= dec64; } }
            LDS_WAIT(); __syncthreads();
            const unsigned ka_addr = (unsigned)(size_t)kt + (unsigned)((8 * fq + (fr >> 2)) * KPB + (16 * w + 4 * (fr & 3)) * 2);
            const unsigned va_addr = (unsigned)(size_t)vt + (unsigned)((8 * fq + (fr >> 2)) * VPB + (4 * (fr & 3)) * 2);
#pragma unroll
            for (int ks = 0; ks < 2; ++ks) { bf16x8 af, b0, b1;
                TR_PAIR(af, ka_addr + ks * 32 * KPB, 4 * KPB); TR_PAIR(b0, va_addr + ks * 32 * VPB, 4 * VPB); TR_PAIR(b1, va_addr + ks * 32 * VPB + 32, 4 * VPB);
                acc[0] = __builtin_amdgcn_mfma_f32_16x16x32_bf16(af, b0, acc[0], 0, 0, 0); acc[1] = __builtin_amdgcn_mfma_f32_16x16x32_bf16(af, b1, acc[1], 0, 0, 0); }
        }
        __syncthreads();
    }
}
__device__ __forceinline__ void ph_ret_out(const Params& p, const Ctx& c) {
    const bf16* P1 = (const bf16*)(p.ws + WS_P1); const bf16* SN = (const bf16*)(p.ws + WS_SN); unsigned char* Y8 = p.ws + WS_YCAT;
    constexpr int QPB = 272, VPB = 528, APB = 144;
    LAS unsigned char* qt = c.lds; LAS unsigned char* kt = qt + 64 * QPB; LAS unsigned char* vt = kt + 64 * QPB; LAS unsigned char* at = vt + 64 * VPB;
    LAS float* red = (LAS float*)(at + 64 * APB);
    const int tid = c.tid, lane = c.lane, w = c.wave, fr = lane & 15, fq = lane >> 4;
    for (int u = c.bid; u < NB * 32 * R_HEADS; u += c.nb) {
        const int b = u / 256, n = (u / 8) % 32, h = u % 8;
        const float gam = 1.0f - exp2f(-5.0f - (float)h), lgm = logf(gam);
        const size_t t0 = (size_t)b * SEQ + n * CHUNK;
        __syncthreads();
        for (int i = tid; i < 64 * 16; i += NTHR) { const int l = i >> 4, ch = i & 15;
            *(LAS v4u*)(qt + l * QPB + ch * 16) = *(const v4u*)(P1 + (t0 + l) * N1 + C_RQ + h * 128 + ch * 8);
            *(LAS v4u*)(kt + l * QPB + ch * 16) = *(const v4u*)(P1 + (t0 + l) * N1 + C_RK + h * 128 + ch * 8); }
        for (int i = tid; i < 64 * 32; i += NTHR) { const int l = i >> 5, ch = i & 31; *(LAS v4u*)(vt + l * VPB + ch * 16) = *(const v4u*)(P1 + (t0 + l) * N1 + C_RV + h * 256 + ch * 8); }
        __syncthreads();
        { const int pt = w & 3, lt0 = 2 * (w >> 2);
          f32x4 a0 = {0.f, 0.f, 0.f, 0.f}, a1 = a0;
#pragma unroll
          for (int ks = 0; ks < 4; ++ks) { const bf16x8 qf = *(const LAS bf16x8*)(qt + (16 * pt + fr) * QPB + ks * 64 + fq * 16);
              const bf16x8 k0 = *(const LAS bf16x8*)(kt + (16 * lt0 + fr) * QPB + ks * 64 + fq * 16), k1 = *(const LAS bf16x8*)(kt + (16 * lt0 + 16 + fr) * QPB + ks * 64 + fq * 16);
              a0 = __builtin_amdgcn_mfma_f32_16x16x32_bf16(k0, qf, a0, 0, 0, 0); a1 = __builtin_amdgcn_mfma_f32_16x16x32_bf16(k1, qf, a1, 0, 0, 0); }
          const int pos = 16 * pt + fr;
#pragma unroll
          for (int j = 0; j < 4; ++j) { const int l0 = 16 * lt0 + 4 * fq + j, l1 = l0 + 16;
              a0[j] = (pos >= l0) ? a0[j] * __expf((float)(pos - l0) * lgm) : 0.f; a1[j] = (pos >= l1) ? a1[j] * __expf((float)(pos - l1) * lgm) : 0.f; }
          v2u o; o.x = cvt_pk_bf16(a0[0], a0[1]); o.y = cvt_pk_bf16(a0[2], a0[3]); *(LAS v2u*)(at + pos * APB + (16 * lt0 + 4 * fq) * 2) = o;
          o.x = cvt_pk_bf16(a1[0], a1[1]); o.y = cvt_pk_bf16(a1[2], a1[3]); *(LAS v2u*)(at + pos * APB + (16 * lt0 + 16 + 4 * fq) * 2) = o; }
        f32x4 acc[2][4];
#pragma unroll
        for (int mi = 0; mi < 2; ++mi)
#pragma unroll
            for (int pt = 0; pt < 4; ++pt) acc[mi][pt] = (f32x4){0.f, 0.f, 0.f, 0.f};
        { const bf16* sp = SN + ((size_t)((b * R_HEADS + h) * 32 + n) * 256 + 32 * w + fr) * 128 + 8 * fq;
#pragma unroll
          for (int ks = 0; ks < 4; ++ks) { const bf16x8 s0 = *(const bf16x8*)(sp + ks * 32), s1 = *(const bf16x8*)(sp + 16 * 128 + ks * 32);
#pragma unroll
              for (int pt = 0; pt < 4; ++pt) { const bf16x8 qf = *(const LAS bf16x8*)(qt + (16 * pt + fr) * QPB + ks * 64 + fq * 16);
                  acc[0][pt] = __builtin_amdgcn_mfma_f32_16x16x32_bf16(s0, qf, acc[0][pt], 0, 0, 0); acc[1][pt] = __builtin_amdgcn_mfma_f32_16x16x32_bf16(s1, qf, acc[1][pt], 0, 0, 0); } } }
#pragma unroll
        for (int pt = 0; pt < 4; ++pt) { const float dq = __expf((float)(16 * pt + fr + 1) * lgm); acc[0][pt] *= dq; acc[1][pt] *= dq; }
        LDS_WAIT(); __syncthreads();
        { const unsigned v_addr = (unsigned)(size_t)vt + (unsigned)((8 * fq + (fr >> 2)) * VPB + (32 * w + 4 * (fr & 3)) * 2);
#pragma unroll
          for (int ks = 0; ks < 2; ++ks) { bf16x8 v0, v1; TR_PAIR(v0, v_addr + ks * 32 * VPB, 4 * VPB); TR_PAIR(v1, v_addr + ks * 32 * VPB + 32, 4 * VPB);
#pragma unroll
              for (int pt = 0; pt < 4; ++pt) { const bf16x8 af = *(const LAS bf16x8*)(at + (16 * pt + fr) * APB + ks * 64 + fq * 16);
                  acc[0][pt] = __builtin_amdgcn_mfma_f32_16x16x32_bf16(v0, af, acc[0][pt], 0, 0, 0); acc[1][pt] = __builtin_amdgcn_mfma_f32_16x16x32_bf16(v1, af, acc[1][pt], 0, 0, 0); } } }
#pragma unroll
        for (int pt = 0; pt < 4; ++pt) { float s = 0.f;
#pragma unroll
            for (int mi = 0; mi < 2; ++mi)
#pragma unroll
                for (int j = 0; j < 4; ++j) s += acc[mi][pt][j] * acc[mi][pt][j];
            s += __shfl_xor(s, 16); s += __shfl_xor(s, 32);
            if (lane < 16) red[w * 64 + 16 * pt + lane] = s; }
        LDS_WAIT(); __syncthreads();
#pragma unroll
        for (int pt = 0; pt < 4; ++pt) { const int pos = 16 * pt + fr; float ss = 0.f;
#pragma unroll
            for (int ww = 0; ww < 8; ++ww) ss += red[ww * 64 + pos];
            const float rstd = 1.0f / sqrtf(ss * (1.0f / R_V) + EPS);
#pragma unroll
            for (int mi = 0; mi < 2; ++mi) { const int dv = 32 * w + 16 * mi + 4 * fq;
                const f32x4 g = *(const f32x4*)(p.g_ret + h * 256 + dv);
                const v2u rg = *(const v2u*)(P1 + (t0 + pos) * N1 + C_RG + h * 256 + dv);
                const float r0 = bflo(rg.x), r1 = bfhi(rg.x), r2 = bflo(rg.y), r3 = bfhi(rg.y);
                const float rs = rstd * 16.0f; int q = 0;
                q = PK_FP8(r0 * sigmoidf_(r0) * acc[mi][pt][0] * rs * g.x, r1 * sigmoidf_(r1) * acc[mi][pt][1] * rs * g.y, q, false);
                q = PK_FP8(r2 * sigmoidf_(r2) * acc[mi][pt][2] * rs * g.z, r3 * sigmoidf_(r3) * acc[mi][pt][3] * rs * g.w, q, true);
                *(unsigned*)(Y8 + (t0 + pos) * D + A_WIDTH + h * 256 + dv) = (unsigned)q; } }
    }
    __syncthreads();
}

__device__ __forceinline__ unsigned fkey(float f) { const unsigned b = __float_as_uint(f); return (b & 0x80000000u) ? ~b : (b | 0x80000000u); }
typedef __bf16 bf16x2_r __attribute__((ext_vector_type(2)));
template <int NV> __device__ __forceinline__ unsigned tok_thr16(const unsigned (&k)[NV]) {
    unsigned thr = 0u; bool done = false;
    for (int bit = 31; bit >= 0; --bit) { const unsigned cand = thr | (1u << bit); int cnt = 0;
#pragma unroll
        for (int i = 0; i < NV; ++i) cnt += (k[i] >= cand) ? 1 : 0;
        cnt += __shfl_xor(cnt, 16); cnt += __shfl_xor(cnt, 32);
        if (!done && cnt >= P_TOPK) { thr = cand; done = (cnt == P_TOPK); }
        if (!__ballot(!done)) break; }
    return thr;
}
__device__ __forceinline__ void ph_peer_route(const Params& p, const Ctx& c) {
    const bf16* PQ = (const bf16*)(p.ws + WS_PQ); const bf16* SK = (const bf16*)(p.ws + WS_SK); int* EID = (int*)(p.ws + WS_EID); float* GATE = (float*)(p.ws + WS_GATE);
    constexpr int KP = 272;
    LAS unsigned char* sk = c.lds;
    LAS float* wl = (LAS float*)(c.lds + 2 * 128 * KP) + c.wave * 1536;
    LAS float* v1l = wl; LAS int* i1l = (LAS int*)(wl + 256); LAS float* v2l = wl + 512; LAS int* i2l = (LAS int*)(wl + 768); LAS float* tvl = wl + 1024; LAS int* tel = (LAS int*)(wl + 1280);
    const int lane = c.lane, fr = lane & 15, fq = lane >> 4;
    __syncthreads();
    for (int i = c.tid; i < 2 * 128 * 16; i += NTHR) { const int r = i >> 4, ch = i & 15; *(LAS v4u*)(sk + r * KP + ch * 16) = *(const v4u*)(SK + r * 128 + ch * 8); }
    __syncthreads();
    for (int u = c.gw; u < (T / 16) * P_HEADS; u += c.ngw) {
        const int tgp = u / P_HEADS, h = u % P_HEADS, t = tgp * 16 + fr;
        unsigned ka[32], kb[32]; float sva[32], svb[32];
#pragma unroll
        for (int half = 0; half < 2; ++half) {
            f32x4 acc[8];
#pragma unroll
            for (int mt = 0; mt < 8; ++mt) acc[mt] = (f32x4){0.f, 0.f, 0.f, 0.f};
#pragma unroll
            for (int ks = 0; ks < 4; ++ks) { const bf16x8 qf = *(const bf16x8*)(PQ + (size_t)t * 2048 + h * 256 + half * 128 + ks * 32 + fq * 8);
#pragma unroll
                for (int mt = 0; mt < 8; ++mt) { const bf16x8 kf = *(const LAS bf16x8*)(sk + (half * 128 + 16 * mt + fr) * KP + ks * 64 + fq * 16); acc[mt] = __builtin_amdgcn_mfma_f32_16x16x32_bf16(kf, qf, acc[mt], 0, 0, 0); } }
#pragma unroll
            for (int mt = 0; mt < 8; ++mt)
#pragma unroll
                for (int j = 0; j < 4; ++j) { if (half == 0) { sva[mt * 4 + j] = acc[mt][j]; ka[mt * 4 + j] = fkey(acc[mt][j]); } else { svb[mt * 4 + j] = acc[mt][j]; kb[mt * 4 + j] = fkey(acc[mt][j]); } }
        }
#define ROUTE_EMIT(K, V, NV, thr, VL, IL, IDX) do { int ngl = 0, nel = 0; \
            _Pragma("unroll") for (int i = 0; i < NV; ++i) { ngl += (K[i] > thr) ? 1 : 0; nel += (K[i] == thr) ? 1 : 0; } \
            int pg = 0, pe = 0, ngt = 0; \
            _Pragma("unroll") for (int q = 0; q < 4; ++q) { const int cg = __shfl(ngl, fr + 16 * q), ce = __shfl(nel, fr + 16 * q); pg += (q < fq) ? cg : 0; pe += (q < fq) ? ce : 0; ngt += cg; } \
            const int need = P_TOPK - ngt; \
            _Pragma("unroll") for (int i = 0; i < NV; ++i) { int slot = -1; \
                if (K[i] > thr) { slot = pg; ++pg; } else if (K[i] == thr) { if (pe < need) slot = ngt + pe; ++pe; } \
                if (slot >= 0) { VL[fr * 16 + slot] = V[i]; IL[fr * 16 + slot] = IDX(i); } } } while (0)
#define KEYIDX(i) (16 * ((i) >> 2) + 4 * fq + ((i) & 3))
        { const unsigned ta = tok_thr16<32>(ka); ROUTE_EMIT(ka, sva, 32, ta, v1l, i1l, KEYIDX);
          const unsigned tb = tok_thr16<32>(kb); ROUTE_EMIT(kb, svb, 32, tb, v2l, i2l, KEYIDX); }
        LDS_WAIT();
        float cd[64]; unsigned ck[64];
        { const f32x4 va = *(const LAS f32x4*)(v1l + fr * 16 + 4 * fq);
#pragma unroll
          for (int bq = 0; bq < 4; ++bq) { const f32x4 vb = *(const LAS f32x4*)(v2l + fr * 16 + 4 * bq);
#pragma unroll
              for (int ai = 0; ai < 4; ++ai)
#pragma unroll
                  for (int bj = 0; bj < 4; ++bj) { const float v = va[ai] + vb[bj]; cd[ai * 16 + bq * 4 + bj] = v; ck[ai * 16 + bq * 4 + bj] = fkey(v); } } }
#define CANDEID(i) (i1l[fr * 16 + 4 * fq + ((i) >> 4)] * P_NK + i2l[fr * 16 + ((i) & 15)])
        { const unsigned tc = tok_thr16<64>(ck); ROUTE_EMIT(ck, cd, 64, tc, tvl, tel, CANDEID); }
#undef ROUTE_EMIT
#undef KEYIDX
#undef CANDEID
        LDS_WAIT();
        { const f32x4 tv = *(const LAS f32x4*)(tvl + fr * 16 + 4 * fq); const v4u te = *(const LAS v4u*)(tel + fr * 16 + 4 * fq);
          float mx = fmaxf(fmaxf(tv[0], tv[1]), fmaxf(tv[2], tv[3])); mx = fmaxf(mx, __shfl_xor(mx, 16)); mx = fmaxf(mx, __shfl_xor(mx, 32));
          f32x4 e; float sm = 0.f;
#pragma unroll
          for (int j = 0; j < 4; ++j) { e[j] = __expf(tv[j] - mx); sm += e[j]; }
          sm += __shfl_xor(sm, 16); sm += __shfl_xor(sm, 32);
          const float inv = 1.0f / sm;
          *(v4u*)(EID + (size_t)t * 128 + h * 16 + 4 * fq) = te; *(f32x4*)(GATE + (size_t)t * 128 + h * 16 + 4 * fq) = e * inv; }
        LDS_WAIT();
    }
    __syncthreads();
}
typedef __bf16 bf16x2_t __attribute__((ext_vector_type(2)));
typedef float v32f_t __attribute__((ext_vector_type(32))); typedef unsigned v6u_t __attribute__((ext_vector_type(6))); typedef __bf16 v32bf_t __attribute__((ext_vector_type(32)));
typedef unsigned v16u_t __attribute__((ext_vector_type(16)));
__device__ __forceinline__ void ld48(const unsigned char* ptr, int lane8, v6u_t& w0, v6u_t& w1) { const v4u a = *(const v4u*)ptr, c = *(const v4u*)(ptr + 2048); const v2u_t b0 = *(const v2u_t*)(ptr + 1024 - (lane8)), b1 = *(const v2u_t*)(ptr + 1536 - (lane8));
    w0 = (v6u_t){a.x, a.y, a.z, a.w, b0.x, b0.y}; w1 = (v6u_t){b1.x, b1.y, c.x, c.y, c.z, c.w}; }
#ifndef PG
#define PG 2
#endif
constexpr size_t WS_DP = WS_P1, WS_CF = WS_P1 + 64 * MiB, WS_SS = WS_P1 + 68 * MiB;
#define XB_PEER_RANK(k) (5120 + 1024 * (k))
struct PeerMap { int s0, ns, tw, tstride; };
__device__ __forceinline__ PeerMap peer_map(const Params& p, const Ctx& c, int k) {
    unsigned* ctl = (unsigned*)(p.ws + WS_CTL); LAS unsigned* xm = (LAS unsigned*)(c.lds + 16384);
    __syncthreads();
    if (c.tid == 0) { const unsigned x = xb_xcc_id(); unsigned pre = 0, tot = 0; bool eq = true;
        for (unsigned j = 0; j < 16; ++j) { const unsigned n = xb_ld(&ctl[XB_XCNT(j)]); pre += (j < x) ? n : 0u; tot += n; eq = eq && (j < 8 ? n == 32u : n == 0u); }
        const bool ok = eq && (tot == (unsigned)c.nb) && (c.nb == 256) && (x < 8);
        unsigned rk = 0; if (ok) rk = xb_add(&ctl[XB_PEER_RANK(k) + 64 * x], 1u);
        xm[0] = (ok && rk < 32u) ? (x * 32u + rk) : 0xffffffffu; }
    __syncthreads();
    const unsigned v = xm[0]; PeerMap m;
    if (v != 0xffffffffu) { m.s0 = 2 * (int)(v >> 5); m.ns = 2; m.tw = (int)(v & 31u) * NWAVES + c.wave; m.tstride = 32 * NWAVES; }
    else { m.s0 = 0; m.ns = 16; m.tw = c.gw; m.tstride = c.ngw; }
    return m;
}
__device__ __forceinline__ v6u_t ld24o(const unsigned char* tab, unsigned e, unsigned ca, unsigned cb) { const unsigned oa = e * 192u + ca, ob = e * 192u + cb;
    const v4u a = *(const v4u*)(tab + (size_t)oa); const v2u_t b = *(const v2u_t*)(tab + (size_t)ob); return (v6u_t){a.x, a.y, a.z, a.w, b.x, b.y}; }
__device__ __forceinline__ v6u_t ld24(const unsigned char* row, int ch8) { const v4u a = *(const v4u*)(row + ch8 * 16); const v2u_t b = *(const v2u_t*)(row + 128 + ch8 * 8); return (v6u_t){a.x, a.y, a.z, a.w, b.x, b.y}; }
__device__ __forceinline__ void ph_peer_u(const Params& p, const Ctx& c) {
    const bf16* H = (const bf16*)(p.ws + WS_H); const int* EID = (const int*)(p.ws + WS_EID);
#ifdef PEER_PROBE
    const int emask = p.dummy ? (PEER_PROBE) : -1; float* DP = (float*)(p.ws + WS_DP + (p.dummy ? 128 * MiB : 0));
#else
    constexpr int emask = -1; float* DP = (float*)(p.ws + WS_DP);
#endif
    const PeerMap m = peer_map(p, c, 0);
    const int lane = c.lane, ch8 = lane & 7, grp = lane >> 3; const bool b2 = lane & 4, b1 = lane & 2, b0 = lane & 1;
    const int ntok = (m.tw < T) ? (T - m.tw + m.tstride - 1) / m.tstride : 0, nitems = m.ns * ntok;
    if (nitems == 0) return;
#define IT_S(k) (m.s0 + (k) / ntok)
#define IT_T(k) (m.tw + ((k) % ntok) * m.tstride)
    int ev[16], evn[16]; unsigned xpn[16]; f32x2 xf[16]; v6u_t A[4], B[4];
#define SU_IDX(EV, XP, s_, t_) do { _Pragma("unroll") for (int i = 0; i < 16; ++i) EV[i] = EID[(size_t)(t_) * 128 + 8 * i + grp] & emask; \
        _Pragma("unroll") for (int k = 0; k < 4; ++k) { const v4u a = *(const v4u*)(H + (size_t)(t_) * D + (s_) * 256 + ch8 * 32 + k * 8); XP[k * 4 + 0] = a.x; XP[k * 4 + 1] = a.y; XP[k * 4 + 2] = a.z; XP[k * 4 + 3] = a.w; } } while (0)
#define SU_LD(R, EV, TAB, i0) do { _Pragma("unroll") for (int j = 0; j < 4; ++j) R[j] = ld24o((TAB), (unsigned)EV[(i0) + j], ca, cb); } while (0)
#define SU_USE(R, i0) do { _Pragma("unroll") for (int j = 0; j < 4; ++j) { const v32f_t uf = __builtin_amdgcn_cvt_scalef32_pk32_f32_fp6(R[j], 1.0f); \
                f32x2 a0 = {0.f, 0.f}, a1 = {0.f, 0.f}, a2 = {0.f, 0.f}, a3 = {0.f, 0.f}; \
                _Pragma("unroll") for (int q = 0; q < 16; q += 4) { \
                    a0 = __builtin_elementwise_fma((f32x2){uf[2 * q], uf[2 * q + 1]}, xf[q], a0); \
                    a1 = __builtin_elementwise_fma((f32x2){uf[2 * q + 2], uf[2 * q + 3]}, xf[q + 1], a1); \
                    a2 = __builtin_elementwise_fma((f32x2){uf[2 * q + 4], uf[2 * q + 5]}, xf[q + 2], a2); \
                    a3 = __builtin_elementwise_fma((f32x2){uf[2 * q + 6], uf[2 * q + 7]}, xf[q + 3], a3); } \
                const f32x2 sm = (a0 + a1) + (a2 + a3); part[(i0) + j] = sm.x + sm.y; __builtin_amdgcn_sched_barrier(0); } } while (0)
#define SU_IDS(EV, t_) do { _Pragma("unroll") for (int i = 0; i < 16; ++i) EV[i] = EID[(size_t)(t_) * 128 + 8 * i + grp] & emask; } while (0)
#define SU_X(XP, s_, t_) do { _Pragma("unroll") for (int k4 = 0; k4 < 4; ++k4) { const v4u a = *(const v4u*)(H + (size_t)(t_) * D + (s_) * 256 + ch8 * 32 + k4 * 8); XP[k4 * 4 + 0] = a.x; XP[k4 * 4 + 1] = a.y; XP[k4 * 4 + 2] = a.z; XP[k4 * 4 + 3] = a.w; } } while (0)
    const unsigned ca = ch8 * 16, cb = 128 + ch8 * 8;
    v6u_t C[4], Dq[4]; int evnn[16];
    { const int k1 = (nitems > 1) ? 1 : 0;
      SU_IDS(ev, IT_T(0)); SU_X(xpn, IT_S(0), IT_T(0)); SU_IDS(evn, IT_T(k1));
      const unsigned char* tab0 = p.ws + WS_U8 + (size_t)__builtin_amdgcn_readfirstlane(IT_S(0)) * SLB;
      SU_LD(A, ev, tab0, 0); SU_LD(B, ev, tab0, 4); SU_LD(C, ev, tab0, 8); SU_LD(Dq, ev, tab0, 12); }
#pragma unroll
    for (int i = 0; i < 16; ++i) xf[i] = (f32x2){__uint_as_float(xpn[i] << 16), __uint_as_float(xpn[i] & 0xffff0000u)};
    for (int k = 0; k < nitems; ++k) {
        const int kn = (k + 1 < nitems) ? k + 1 : k, kn2 = (k + 2 < nitems) ? k + 2 : nitems - 1;
        const int s = __builtin_amdgcn_readfirstlane(IT_S(k)), sn = __builtin_amdgcn_readfirstlane(IT_S(kn)), t = IT_T(k), tn = IT_T(kn);
        const unsigned char* tabn = p.ws + WS_U8 + (size_t)sn * SLB;
        SU_IDS(evnn, IT_T(kn2)); SU_X(xpn, sn, tn); __builtin_amdgcn_sched_barrier(0);
        float part[16];
        SU_USE(A, 0);   SU_LD(A, evn, tabn, 0);
        SU_USE(B, 4);   SU_LD(B, evn, tabn, 4);
        SU_USE(C, 8);   SU_LD(C, evn, tabn, 8);
        SU_USE(Dq, 12); SU_LD(Dq, evn, tabn, 12);
        float p8[8], p4[4], p2[2];
#pragma unroll
        for (int q = 0; q < 8; ++q) { const float keep = b2 ? part[q + 8] : part[q], send = b2 ? part[q] : part[q + 8]; p8[q] = keep + __shfl_xor(send, 4); }
#pragma unroll
        for (int q = 0; q < 4; ++q) { const float keep = b1 ? p8[q + 4] : p8[q], send = b1 ? p8[q] : p8[q + 4]; p4[q] = keep + __shfl_xor(send, 2); }
#pragma unroll
        for (int q = 0; q < 2; ++q) { const float keep = b0 ? p4[q + 2] : p4[q], send = b0 ? p4[q] : p4[q + 2]; p2[q] = keep + __shfl_xor(send, 1); }
        const int st0 = (b2 ? 8 : 0) + (b1 ? 4 : 0) + (b0 ? 2 : 0);
        float* dp = DP + ((size_t)s * T + t) * 128 + grp;
        dp[8 * st0] = p2[0]; dp[8 * (st0 + 1)] = p2[1];
#pragma unroll
        for (int i = 0; i < 16; ++i) { evn[i] = evnn[i]; xf[i] = (f32x2){__uint_as_float(xpn[i] << 16), __uint_as_float(xpn[i] & 0xffff0000u)}; }
    }
#undef SU_IDX
#undef SU_IDS
#undef SU_X
#undef SU_LD
#undef SU_USE
}
__device__ __forceinline__ void ph_peer_coef(const Params& p, const Ctx& c) {
    const float* DP = (const float*)(p.ws + WS_DP); const int* EID = (const int*)(p.ws + WS_EID); const float* GATE = (const float*)(p.ws + WS_GATE);
    const float* SU = (const float*)(p.ws + WS_SU); const float* SV = (const float*)(p.ws + WS_SV); float* CF = (float*)(p.ws + WS_CF);
    for (int i = c.bid * NTHR + c.tid; i < T * 128; i += c.nb * NTHR) { float d = 0.f;
#pragma unroll
        for (int s = 0; s < 16; ++s) d += DP[(size_t)s * T * 128 + i];
        const int e = EID[i]; d *= SU[e];
        CF[i] = GATE[i] * 0.5f * d * (1.0f + erff(d * 0.70710678118654752f)) * SV[e]; }
}
__device__ __forceinline__ void ph_peer_v(const Params& p, const Ctx& c) {
    const int* EID = (const int*)(p.ws + WS_EID); const float* CF = (const float*)(p.ws + WS_CF); float* SS = (float*)(p.ws + WS_SS); const float* mod = (const float*)(p.ws + WS_MOD);
    const PeerMap m = peer_map(p, c, 1);
    const int lane = c.lane, ch8 = lane & 7, grp = lane >> 3; const bool b5 = lane & 32, b4 = lane & 16, b3 = lane & 8;
    const int ntok = (m.tw < T) ? (T - m.tw + m.tstride - 1) / m.tstride : 0, nitems = m.ns * ntok;
    if (nitems == 0) return;
    const int cofs = ch8 * 32 + (b5 ? 16 : 0) + (b4 ? 8 : 0) + (b3 ? 4 : 0);
    int ev[16], evn[16]; float cv[16], cvn[16]; v6u_t A[4], B[4];
#define SV_IDX(EV, CV, t_) do { _Pragma("unroll") for (int i = 0; i < 16; ++i) { EV[i] = EID[(size_t)(t_) * 128 + 8 * i + grp]; CV[i] = CF[(size_t)(t_) * 128 + 8 * i + grp]; } } while (0)
#define SV_LD(R, EV, TAB, i0) do { _Pragma("unroll") for (int j = 0; j < 4; ++j) R[j] = ld24o((TAB), (unsigned)EV[(i0) + j], ca, cb); } while (0)
#define SV_USE(R, i0) do { _Pragma("unroll") for (int j = 0; j < 4; ++j) { const f32x2 c2 = {cv[(i0) + j], cv[(i0) + j]}; const v32f_t vf = __builtin_amdgcn_cvt_scalef32_pk32_f32_fp6(R[j], 1.0f); \
                _Pragma("unroll") for (int q = 0; q < 16; ++q) acc[q] = __builtin_elementwise_fma((f32x2){vf[2 * q], vf[2 * q + 1]}, c2, acc[q]); } } while (0)
    SV_IDX(ev, cv, IT_T(0));
    const unsigned ca = ch8 * 16, cb = 128 + ch8 * 8;
    { const unsigned char* tab0 = p.ws + WS_V8 + (size_t)__builtin_amdgcn_readfirstlane(IT_S(0)) * SLB; SV_LD(A, ev, tab0, 0); SV_LD(B, ev, tab0, 4); }
    for (int k = 0; k < nitems; ++k) {
        const int kn = (k + 1 < nitems) ? k + 1 : k, s = __builtin_amdgcn_readfirstlane(IT_S(k)), sn = __builtin_amdgcn_readfirstlane(IT_S(kn)), t = IT_T(k), tn = IT_T(kn);
        const unsigned char* tab = p.ws + WS_V8 + (size_t)s * SLB; const unsigned char* tabn = p.ws + WS_V8 + (size_t)sn * SLB;
        SV_IDX(evn, cvn, tn);
        const int col = s * 256 + cofs;
        float* orow = p.out + (size_t)t * D + col;
        const f32x4 xa = *(const f32x4*)orow, ga = *(const f32x4*)(mod + (size_t)(t / SEQ) * 6 * D + 5 * D + col);
        __builtin_amdgcn_sched_barrier(0);
        f32x2 acc[16];
#pragma unroll
        for (int q = 0; q < 16; ++q) acc[q] = (f32x2){0.f, 0.f};
        SV_USE(A, 0); SV_LD(A, ev, tab, 8);
        SV_USE(B, 4); SV_LD(B, ev, tab, 12);
        SV_USE(A, 8); SV_LD(A, evn, tabn, 0);
        SV_USE(B, 12); SV_LD(B, evn, tabn, 4);
        f32x2 q8[8], q4[4], q2[2];
#pragma unroll
        for (int q = 0; q < 8; ++q) { const f32x2 keep = b5 ? acc[q + 8] : acc[q], send = b5 ? acc[q] : acc[q + 8]; q8[q] = (f32x2){keep.x + __shfl_xor(send.x, 32), keep.y + __shfl_xor(send.y, 32)}; }
#pragma unroll
        for (int q = 0; q < 4; ++q) { const f32x2 keep = b4 ? q8[q + 4] : q8[q], send = b4 ? q8[q] : q8[q + 4]; q4[q] = (f32x2){keep.x + __shfl_xor(send.x, 16), keep.y + __shfl_xor(send.y, 16)}; }
#pragma unroll
        for (int q = 0; q < 2; ++q) { const f32x2 keep = b3 ? q4[q + 2] : q4[q], send = b3 ? q4[q] : q4[q + 2]; q2[q] = (f32x2){keep.x + __shfl_xor(send.x, 8), keep.y + __shfl_xor(send.y, 8)}; }
        const f32x4 y = {xa.x + ga.x * q2[0].x, xa.y + ga.y * q2[0].y, xa.z + ga.z * q2[1].x, xa.w + ga.w * q2[1].y};
        *(f32x4*)orow = y;
        const float ss = wave_sum((y.x * y.x + y.y * y.y) + (y.z * y.z + y.w * y.w));
        if (lane == 0) SS[(size_t)s * T + t] = ss;
#pragma unroll
        for (int i = 0; i < 16; ++i) { ev[i] = evn[i]; cv[i] = cvn[i]; }
    }
#undef SV_IDX
#undef SV_LD
#undef SV_USE
#undef IT_S
#undef IT_T
}
__device__ __forceinline__ void ph_peer_norm(const Params& p, const Ctx& c) {
    const float* SS = (const float*)(p.ws + WS_SS); const int lane = c.lane;
    for (int t = c.gw; t < T; t += c.ngw) {
        const float tot = wave_sum(lane < 16 ? SS[(size_t)lane * T + t] : 0.f);
        const float rstd = 1.0f / sqrtf(tot * (1.0f / D) + EPS);
        float* orow = p.out + (size_t)t * D;
#pragma unroll
        for (int k = 0; k < 16; ++k) { const int col = k * 256 + lane * 4; const f32x4 y = *(const f32x4*)(orow + col), ga = *(const f32x4*)(p.g_final + col);
            *(f32x4*)(orow + col) = (f32x4){y.x * rstd * ga.x, y.y * rstd * ga.y, y.z * rstd * ga.z, y.w * rstd * ga.w}; }
    }
}


constexpr int N_PHASES = 22;
__global__ void __launch_bounds__(NTHR, 2) fwd_kernel(Params p) {
    extern __shared__ __attribute__((aligned(16))) unsigned char lds_raw[];
    Ctx c; c.lds = (LAS unsigned char*)lds_raw; c.tid = threadIdx.x; c.lane = c.tid & 63; c.wave = __builtin_amdgcn_readfirstlane(c.tid >> 6);
    c.bid = blockIdx.x; c.nb = gridDim.x; c.gw = c.bid * NWAVES + c.wave; c.ngw = c.nb * NWAVES;
    volatile LAS unsigned* MISC = (volatile LAS unsigned*)(c.lds + MISC_OFF);
    if (c.tid < 64) MISC[c.tid] = 0u;
    __syncthreads();
    const int lo = p.ph_lo, hi = p.ph_hi;
    XcdBarrier bar; bar.bar = (unsigned*)(p.ws + WS_CTL); bar.x = 0; bar.st = nullptr;
    if (hi - lo > 1) bar = xcd_barrier_post((unsigned*)(p.ws + WS_CTL), MISC + 8);
#define IN(k) (lo <= (k) && (k) < hi)
#ifdef PH_TIME
#define TS(k) do { if (c.bid == 0 && c.tid == 0) ((unsigned long long*)(p.ws + WS_CTL))[4000 + (k)] = __builtin_amdgcn_s_memrealtime(); } while (0)
#else
#define TS(k) do { } while (0)
#endif
#define SEAM(k) do { if (IN(k) && IN((k) + 1)) xcd_barrier(bar); TS((k) + 1); } while (0)
    unsigned char* ws = p.ws;
    const float* mod = (const float*)(ws + WS_MOD);
    TS(0);
    if (IN(0)) { ph_prologue(p, c); } SEAM(0);
    if (IN(1)) { ph_modulate(p.x, p.g_mix, mod, 0 * D, 1 * D, (bf16*)(ws + WS_H), ws + WS_H8, c); } SEAM(1);
    if (IN(2)) {
        { pg8::Gemm g{(const bf16*)(ws + WS_H), (const bf16*)(ws + WS_BT1), T, IN_BF, D, D, D}; pg8::StaticOrder S; S.init(T, IN_BF, c.nb, c.bid);
          pg8::EpiB<0> E{(bf16*)(ws + WS_P1), nullptr, nullptr, nullptr, N1, 0, 1.0f, 0.f};
          pg8::gemm_phase<pg8::EpiB<0>, pg8::StaticOrder, true, true>(c.lds, g, S, E); }
        { pg8::Gemm g{(const bf16*)(ws + WS_H8), (const bf16*)(ws + WS_W8IN), T, IN_PAD - IN_BF, D / 2, D / 2, D / 2}; pg8::StaticOrder S; S.init(T, IN_PAD - IN_BF, c.nb, c.bid);
          pg8::EpiB<0> E{(bf16*)(ws + WS_P1) + IN_BF, nullptr, nullptr, nullptr, N1, 0, 1.0f / 16384.0f, 0.f};
          pg8::gemm_phase<pg8::EpiB<0>, pg8::StaticOrder, true, true, true>(c.lds, g, S, E); }
        { pg8::Gemm g{(const bf16*)(ws + WS_H8), (const bf16*)(ws + WS_G8), T, 2 * D, D / 2, D / 2, D / 2}; pg8::StaticOrder S; S.init(T, 2 * D, c.nb, c.bid);
          pg8::EpiGate E{(bf16*)(ws + WS_P1) + C_GA, N1, p.b_gate, 1.0f / 16384.0f};
          pg8::gemm_phase<pg8::EpiGate, pg8::StaticOrder, true, true, true>(c.lds, g, S, E); }
    } SEAM(2);
    if (IN(3)) { ph_postproc(p, c); } SEAM(3);
    if (IN(4)) { pg8::Gemm g{(const bf16*)(ws + WS_P1) + C_CQ, (const bf16*)(ws + WS_BT2), T, N2, A_QR, N1, A_QR}; pg8::StaticOrder S; S.init(T, N2, c.nb, c.bid);
        pg8::EpiB<0> E{(bf16*)(ws + WS_Q2), nullptr, nullptr, nullptr, N2, 0, 1.0f, 0.f};
        pg8::gemm_phase<pg8::EpiB<0>, pg8::StaticOrder, true, true>(c.lds, g, S, E); } SEAM(4);
    if (IN(5)) { ph_ret_state(p, c); ph_qlat(p, c); } SEAM(5);
    if (IN(6)) { ph_scores(p, c); } SEAM(6);
    if (IN(7)) { ph_topk(p, c); } SEAM(7);
    if (IN(8)) { ph_attn(p, c); } SEAM(8);
    if (IN(9)) { adaln_late_reduce(p, c); ph_oproj(p, c); ph_ret_out(p, c); } SEAM(9);
    if (IN(12)) { pg8::Gemm g{(const bf16*)(ws + WS_YCAT), (const bf16*)(ws + WS_BTUP), T, D, A_WIDTH / 2, D / 2, D / 2}; pg8::StaticOrder S; S.init(T, D, c.nb, c.bid);
        pg8::EpiB<2> E{(bf16*)(ws + WS_MERGED), nullptr, nullptr, (const bf16*)(ws + WS_P1) + C_GA, D, N1, 1.0f / 16384.0f, 0.f};
        pg8::gemm_phase<pg8::EpiB<2>, pg8::StaticOrder, true, true, true>(c.lds, g, S, E); }
    if (IN(12) && IN(13)) { VM_WAIT(); __syncthreads(); }
    if (IN(13)) { pg8::Gemm g{(const bf16*)(ws + WS_YCAT + A_WIDTH), (const bf16*)(ws + WS_BTUP + A_WIDTH), T, D, R_W / 2, D / 2, D / 2}; pg8::StaticOrder S; S.init(T, D, c.nb, c.bid);
        pg8::EpiB<3> E{(bf16*)(ws + WS_MERGED), ws + WS_MERGED8, nullptr, (const bf16*)(ws + WS_P1) + C_GR, D, N1, 1.0f / 16384.0f, 64.0f};
        pg8::gemm_phase<pg8::EpiB<3>, pg8::StaticOrder, true, true, true>(c.lds, g, S, E); } SEAM(13);
    if (IN(14)) { pg8::Gemm g{(const bf16*)(ws + WS_MERGED8), (const bf16*)(ws + WS_BTOUT), T, D, D / 2, D / 2, D / 2}; pg8::StaticOrder S; S.init(T, D, c.nb, c.bid);
        pg8::EpiRes E{p.x, p.out, D, mod + 2 * D, 6 * D, 1.0f / 65536.0f};
        pg8::gemm_phase<pg8::EpiRes, pg8::StaticOrder, true, true, true>(c.lds, g, S, E); } SEAM(14);
    if (IN(15)) { ph_modulate(p.out, p.g_ffn, mod, 3 * D, 4 * D, (bf16*)(ws + WS_H), nullptr, c); } SEAM(15);
    if (IN(16)) { pg8::Gemm g{(const bf16*)(ws + WS_H), (const bf16*)(ws + WS_BTPQ), T, 2048, D, D, D}; pg8::StaticOrder S; S.init(T, 2048, c.nb, c.bid);
        pg8::EpiB<0> E{(bf16*)(ws + WS_PQ), nullptr, nullptr, nullptr, 2048, 0, 1.0f, 0.f};
        pg8::gemm_phase<pg8::EpiB<0>, pg8::StaticOrder, true, true>(c.lds, g, S, E); } SEAM(16);
    if (IN(17)) { ph_peer_route(p, c); } SEAM(17);
    if (IN(18)) { ph_peer_u(p, c); } SEAM(18);
    if (IN(19)) { ph_peer_coef(p, c); } SEAM(19);
    if (IN(20)) { ph_peer_v(p, c); } SEAM(20);
    if (IN(21)) { ph_peer_norm(p, c); }
#ifdef PH_TIME
    xcd_barrier(bar); TS(22);
    if (c.bid == 0 && c.tid == 0) { __threadfence(); const volatile unsigned long long* ts = (const volatile unsigned long long*)(p.ws + WS_CTL) + 4000; p.out[0] += (float)(long long)(ts[PH_B] - ts[PH_A]) * 0.01f - (float)(PH_OFF); }
#endif
#undef IN
#undef SEAM
}

#ifdef DBG_STOP
__device__ __forceinline__ float dsan(float v) { return (v - v == 0.0f) ? v : 777.0f; }
__global__ void dump_kernel(Params p, int k) {
    unsigned char* ws = p.ws; const size_t n = (size_t)T * D;
    for (size_t i = (size_t)blockIdx.x * blockDim.x + threadIdx.x; i < n; i += (size_t)gridDim.x * blockDim.x) {
        float v = 0.f;
        if (k == 0) { v = ((const float*)(ws + WS_MOD))[i % 98304] + bf2f(((const bf16*)(ws + WS_BT1))[i] ) + bf2f(((const bf16*)(ws + WS_BT1))[(i + n) % 66060288])
                + bf2f(((const bf16*)(ws + WS_BT2))[i % 10485760]) + bf2f(((const bf16*)(ws + WS_WUK))[i % 1048576]) + bf2f(((const bf16*)(ws + WS_BTUV))[i % 1048576])
                + bf2f(((const bf16*)(ws + WS_BTUP))[i % 16777216]) + bf2f(((const bf16*)(ws + WS_BTOUT))[i % 16777216]) + bf2f(((const bf16*)(ws + WS_BTPQ))[i % 8388608])
                + bf2f(((const bf16*)(ws + WS_SK))[i % 32768]) + (float)(ws + WS_U8)[i] + (float)(ws + WS_V8)[i]; }
        else if (k == 1 || k == 15) v = bf2f(((const bf16*)(ws + WS_H))[i]);
        else if (k == 2 || k == 3) { const bf16* P = (const bf16*)(ws + WS_P1); v = bf2f(P[i]) + bf2f(P[i + n]) + bf2f(P[i + 2 * n]) + bf2f(P[(i + 3 * n) % 132120576]) + ((const float*)(ws + WS_WIDX))[i % 524288] * (k == 3 ? 1.f : 0.f); }
        else if (k == 4) { const bf16* P = (const bf16*)(ws + WS_Q2); v = bf2f(P[i]) + bf2f(P[i + n]) + bf2f(P[(i + 2 * n) % 83886080]); }
        else if (k == 5) { const bf16* P = (const bf16*)(ws + WS_QL); v = bf2f(P[i]) + bf2f(P[i + n]); }
        else if (k == 6) { const size_t j = i % ((size_t)T * SEQ); const int t = (int)(j / SEQ), s = (int)(j % SEQ); v = (s < (((t % SEQ) / 64) + 1) * 64) ? ((const float*)(ws + WS_SC))[j] : 0.f; }
        else if (k == 7) { const size_t j = i % ((size_t)T * TOPK); const int t = (int)(j / TOPK), s = (int)(j % TOPK); const int cnt = ((const int*)(ws + WS_CNT))[t]; v = (s < cnt) ? (float)((const int*)(ws + WS_SEL))[j] : (float)cnt; }
        else if (k == 8) { const bf16* P = (const bf16*)(ws + WS_OLAT); v = bf2f(P[i]) + bf2f(P[i + n]); }
        else if (k == 9) { v = (float)(ws + WS_YCAT)[(i / 2048) * 4096 + (i % 2048)]; }
        else if (k == 10) { v = ((const float*)(ws + WS_SC))[i % ((size_t)T * 2048)]; }
        else if (k == 11) { v = (float)(ws + WS_YCAT)[i]; }
        else if (k == 12 || k == 13) { v = bf2f(((const bf16*)(ws + WS_MERGED))[i]); }
        else if (k == 14 || k == 18) { v = p.out[i]; }
        else if (k == 16) { v = bf2f(((const bf16*)(ws + WS_PQ))[i % ((size_t)T * 2048)]); }
        else if (k == 17) { v = (float)((const int*)(ws + WS_EID))[i % ((size_t)T * 128)] + ((const float*)(ws + WS_GATE))[i % ((size_t)T * 128)]; }
        p.out[i] = dsan(v);
    }
}
#endif

#ifndef MK_SINGLE
#define MK_SINGLE 1
#endif
extern "C" void kernel_launch(void* const* d_in, const int* in_sizes, int n_in, void* d_out, int out_size, void* d_ws, size_t ws_size, hipStream_t stream) {
    static int grid = 0;
    if (grid == 0) {
        if (n_in != 26 || in_sizes[0] != T * D || out_size != T * D || ws_size < WS_END) { fprintf(stderr, "kernel_launch: unexpected shapes (n_in %d, in0 %d, out %d, ws %zu < %zu)\n", n_in, n_in > 0 ? in_sizes[0] : -1, out_size, ws_size, (size_t)WS_END); grid = -1; return; }
        int dev = 0, cus = 0, per_cu = 0;
        if (hipGetDevice(&dev) != hipSuccess || hipDeviceGetAttribute(&cus, hipDeviceAttributeMultiprocessorCount, dev) != hipSuccess) { grid = -1; return; }
        if (hipFuncSetAttribute((const void*)fwd_kernel, hipFuncAttributeMaxDynamicSharedMemorySize, LDS_BYTES) != hipSuccess) { fprintf(stderr, "kernel_launch: hipFuncSetAttribute failed\n"); grid = -1; return; }
        if (hipOccupancyMaxActiveBlocksPerMultiprocessor(&per_cu, (const void*)fwd_kernel, NTHR, LDS_BYTES) != hipSuccess || per_cu < 1) { fprintf(stderr, "kernel_launch: occupancy query reports %d blocks per CU\n", per_cu); }
        (void)hipGetLastError();
        grid = cus;
    }
    if (grid < 0) return;
    (void)hipMemsetAsync((char*)d_ws + WS_CTL, 0, CTL_ZERO_BYTES, stream);
    Params p{};
    const float** pf = (const float**)&p;
    for (int i = 0; i < 26; ++i) pf[i] = (const float*)d_in[i];
    p.out = (float*)d_out; p.ws = (unsigned char*)d_ws;
#ifdef DBG_STOP
    for (int ph = 0; ph <= DBG_STOP; ++ph) { p.ph_lo = ph; p.ph_hi = ph + 1; hipLaunchKernelGGL(fwd_kernel, dim3(grid), dim3(NTHR), LDS_BYTES, stream, p); }
    p.ph_lo = 0; p.ph_hi = 0;
    hipLaunchKernelGGL(dump_kernel, dim3(2048), dim3(256), 0, stream, p, (int)DBG_STOP);
#elif MK_SINGLE
    p.ph_lo = 0; p.ph_hi = N_PHASES;
    hipLaunchKernelGGL(fwd_kernel, dim3(grid), dim3(NTHR), LDS_BYTES, stream, p);
#else
    for (int ph = 0; ph < N_PHASES; ++ph) { p.ph_lo = ph; p.ph_hi = ph + 1;
#ifdef PEER_PROBE
        if (ph == 18) { p.dummy = 1; for (int rep = 0; rep < PEER_DUMMY; ++rep) hipLaunchKernelGGL(fwd_kernel, dim3(grid), dim3(NTHR), LDS_BYTES, stream, p); p.dummy = 0; }
#endif
        hipLaunchKernelGGL(fwd_kernel, dim3(grid), dim3(NTHR), LDS_BYTES, stream, p);
#ifdef REP_MASK
        if ((REP_MASK >> ph) & 1) for (int rep = 0; rep < REP_N; ++rep) hipLaunchKernelGGL(fwd_kernel, dim3(grid), dim3(NTHR), LDS_BYTES, stream, p);
#endif
    }
#endif
}
```

```cpp
#include <hip/hip_runtime.h>
#include <cstdio>
#include <cstdint>

#define GAS __attribute__((address_space(1)))
#define LAS __attribute__((address_space(3)))
typedef unsigned short bf16;
typedef unsigned v4u __attribute__((ext_vector_type(4)));
typedef unsigned v2u __attribute__((ext_vector_type(2)));
typedef float f32x4 __attribute__((ext_vector_type(4)));
typedef float f32x2 __attribute__((ext_vector_type(2)));
typedef short bf16x8 __attribute__((ext_vector_type(8)));
typedef short bf16x4 __attribute__((ext_vector_type(4)));

constexpr int D = 4096, NB = 4, SEQ = 2048, T = NB * SEQ;
constexpr int CHUNK = 64;
constexpr float EPS = 1e-6f;
constexpr int A_HEADS = 16, A_HD = 128, A_QR = 1024, A_KVR = 512, A_WIDTH = 2048;
constexpr int IDX_H = 64, IDX_D = 128, TOPK = 256;
constexpr int R_HEADS = 8, R_QK = 128, R_V = 256, R_QKW = 1024, R_W = 2048;
constexpr int P_HEADS = 8, P_QD = 256, P_NK = 128, P_TOPK = 16, P_EXP = 16384;
constexpr int IN_WIDTH = 7872, IN_PAD = 7936, IN_BF = 1792;
constexpr int N1 = IN_PAD + 2 * D;
constexpr int N2 = A_WIDTH + IDX_H * IDX_D;
constexpr int C_CQ = 0, C_CKV = 1024, C_KI = 1536, C_WI = 1664, C_RQ = 1728, C_RK = 2752, C_RV = 3776, C_RG = 5824, C_GA = IN_PAD, C_GR = IN_PAD + D;

__device__ __forceinline__ float bf2f(bf16 h) { return __uint_as_float(((unsigned)h) << 16); }
__device__ __forceinline__ float bflo(unsigned w) { return __uint_as_float(w << 16); }
__device__ __forceinline__ float bfhi(unsigned w) { return __uint_as_float(w & 0xffff0000u); }
typedef __bf16 bf16v2_t __attribute__((ext_vector_type(2)));
__device__ __forceinline__ unsigned cvt_pk_bf16(float lo, float hi) { const bf16v2_t v = __builtin_convertvector((f32x2){lo, hi}, bf16v2_t); return __builtin_bit_cast(unsigned, v); }
__device__ __forceinline__ bf16 f2bf(float f) { return (bf16)(cvt_pk_bf16(f, 0.f) & 0xffffu); }
__device__ __forceinline__ float wave_sum(float v) {
#pragma unroll
    for (int o = 1; o < 64; o <<= 1) v += __shfl_xor(v, o);
    return v;
}
#define PK_FP8(a, b, old, hi) __builtin_amdgcn_cvt_pk_fp8_f32(__builtin_amdgcn_fmed3f((a), -448.0f, 448.0f), __builtin_amdgcn_fmed3f((b), -448.0f, 448.0f), (old), (hi))
__device__ __forceinline__ float sigmoidf_(float v) { return __builtin_amdgcn_rcpf(1.0f + __expf(-v)); }

namespace pg8 {
#define PG8_LAS __attribute__((address_space(3)))
typedef unsigned short bf16_t;
typedef unsigned u32x4 __attribute__((ext_vector_type(4)));
constexpr int BM = 256, BK = 64, HALF = 128, HTB = HALF * BK * 2  , STAGE_BYTES = 8 * HTB, NXCD = 8, WGM = 8;

__host__ __device__ __forceinline__ int lds_byte(int r, int c) { const int st = (r >> 4) * 2 + (c >> 5), rr = r & 15, cc = c & 31, ob = rr * 64 + cc * 2; return st * 1024 + (ob ^ (((ob >> 9) & 1) << 5)); }
__host__ __device__ __forceinline__ void stage_rc(int b, int& R, int& C) { const int st = b / 1024, sb = b % 1024, swz = sb ^ (((sb >> 9) & 1) << 5); R = (st >> 1) * 16 + swz / 64; C = (st & 1) * 32 + (swz % 64) / 2; }
__host__ __device__ __forceinline__ int perm32(int rho) { const int n = rho >> 4, i = rho & 15; return 8 * (i >> 2) + 4 * n + (i & 3); }

struct Unit { int pm, pn; };
struct Gemm { const bf16_t* A; const bf16_t* Bt; int M, N, K, lda, ldb; };

struct StaticOrder {
    int nM, nN, nwg, G, c;
    __host__ __device__ void init(int M, int N, int G_, int c_) { nM = M / BM; nN = N / BM; nwg = nM * nN; G = G_; c = c_; }
    __host__ __device__ bool next(int i, Unit& u) const {
        const long L = (long)i * G + c; if (L >= nwg) return false;
        int wgid = (int)L; { const int q = nwg / NXCD, r = nwg % NXCD, xcd = wgid % NXCD, off = wgid / NXCD; wgid = (xcd < r ? xcd * (q + 1) : r * (q + 1) + (xcd - r) * q) + off; }
        const int nig = WGM * nN, gid = wgid / nig, fm = gid * WGM, gsz = (nM - fm) < WGM ? (nM - fm) : WGM;
        u.pm = fm + ((wgid % nig) % gsz); u.pn = (wgid % nig) / gsz; return true;
    }
    __device__ __forceinline__ void a_ready(const Unit&) const {}
    __device__ __forceinline__ void done(const Unit&) const {}
};

template <int MODE> struct EpiB {
    static constexpr bool PERM = true, AFTER_DRAIN = false;
    bf16_t* O; unsigned char* O8; const float* bias; const bf16_t* gate; int ldc, ldg; float scale, scale8;
    __device__ __forceinline__ void operator()(const f32x4 (&acc)[2][2][4][2], const Unit& u, int wr, int wc, int fr, int fq) const {
        const int row0 = u.pm * BM + wr * 64 + fr; const int col0 = u.pn * BM + wc * 32 + 8 * fq;
        const bool gates = (MODE == 1) && (u.pn >= 31);
        f32x4 bv[2][2];
#pragma unroll
        for (int bj = 0; bj < 2; ++bj)
#pragma unroll
            for (int n = 0; n < 2; ++n) bv[bj][n] = gates ? *(const f32x4*)(bias + (col0 - 31 * BM) + bj * HALF + 4 * n) : (f32x4){0.f, 0.f, 0.f, 0.f};
#pragma unroll
        for (int ai = 0; ai < 2; ++ai)
#pragma unroll
            for (int m = 0; m < 4; ++m) { const size_t r = (size_t)(row0 + ai * HALF + m * 16); bf16_t* rowp = O + r * ldc + col0;
#pragma unroll
                for (int bj = 0; bj < 2; ++bj) { f32x4 v0 = acc[ai][bj][m][0] * scale, v1 = acc[ai][bj][m][1] * scale;
                    if (MODE == 1) { if (gates) { v0 = v0 + bv[bj][0]; v1 = v1 + bv[bj][1];
#pragma unroll
                            for (int j = 0; j < 4; ++j) { v0[j] = sigmoidf_(v0[j]); v1[j] = sigmoidf_(v1[j]); } } }
                    if (MODE == 2 || MODE == 3) { const u32x4 gw = *(const u32x4*)(gate + r * ldg + col0 + bj * HALF);
                        v0[0] *= bflo(gw.x); v0[1] *= bfhi(gw.x); v0[2] *= bflo(gw.y); v0[3] *= bfhi(gw.y); v1[0] *= bflo(gw.z); v1[1] *= bfhi(gw.z); v1[2] *= bflo(gw.w); v1[3] *= bfhi(gw.w); }
                    if (MODE == 3) { const u32x4 pw = *(const u32x4*)(rowp + bj * HALF);
                        v0[0] += bflo(pw.x); v0[1] += bfhi(pw.x); v0[2] += bflo(pw.y); v0[3] += bfhi(pw.y); v1[0] += bflo(pw.z); v1[1] += bfhi(pw.z); v1[2] += bflo(pw.w); v1[3] += bfhi(pw.w); }
                    u32x4 w; w.x = cvt_pk_bf16(v0[0], v0[1]); w.y = cvt_pk_bf16(v0[2], v0[3]); w.z = cvt_pk_bf16(v1[0], v1[1]); w.w = cvt_pk_bf16(v1[2], v1[3]);
                    if (MODE != 3) *(u32x4*)(rowp + bj * HALF) = w;
                    if (MODE == 3) { int q0 = 0, q1 = 0; q0 = PK_FP8(v0[0] * scale8, v0[1] * scale8, q0, false); q0 = PK_FP8(v0[2] * scale8, v0[3] * scale8, q0, true);
                        q1 = PK_FP8(v1[0] * scale8, v1[1] * scale8, q1, false); q1 = PK_FP8(v1[2] * scale8, v1[3] * scale8, q1, true);
                        *(v2u*)(O8 + r * ldc + col0 + bj * HALF) = (v2u){(unsigned)q0, (unsigned)q1}; } } }
    }
};
typedef int v8i_t __attribute__((ext_vector_type(8)));
typedef int v4i_t __attribute__((ext_vector_type(4)));
__device__ __forceinline__ v8i_t f8cat(const bf16x8 lo, const bf16x8 hi) { const v4i_t a = __builtin_bit_cast(v4i_t, lo), b = __builtin_bit_cast(v4i_t, hi); return __builtin_shufflevector(a, b, 0, 1, 2, 3, 4, 5, 6, 7); }
struct EpiGate {
    static constexpr bool PERM = true, AFTER_DRAIN = false;
    bf16_t* O; int ldc; const float* bias; float scale;
    __device__ __forceinline__ void operator()(const f32x4 (&acc)[2][2][4][2], const Unit& u, int wr, int wc, int fr, int fq) const {
        const int row0 = u.pm * BM + wr * 64 + fr; const int col0 = u.pn * BM + wc * 32 + 8 * fq;
        f32x4 bv[2][2];
#pragma unroll
        for (int bj = 0; bj < 2; ++bj)
#pragma unroll
            for (int n = 0; n < 2; ++n) bv[bj][n] = *(const f32x4*)(bias + col0 + bj * HALF + 4 * n) * -1.4426950408889634f;
        const float nsc = scale * -1.4426950408889634f;
#pragma unroll
        for (int ai = 0; ai < 2; ++ai)
#pragma unroll
            for (int m = 0; m < 4; ++m) { bf16_t* rowp = O + (size_t)(row0 + ai * HALF + m * 16) * ldc + col0;
#pragma unroll
                for (int bj = 0; bj < 2; ++bj) { f32x4 v0 = acc[ai][bj][m][0] * nsc + bv[bj][0], v1 = acc[ai][bj][m][1] * nsc + bv[bj][1];
#pragma unroll
                    for (int j = 0; j < 4; ++j) { v0[j] = __builtin_amdgcn_rcpf(1.0f + __builtin_amdgcn_exp2f(v0[j])); v1[j] = __builtin_amdgcn_rcpf(1.0f + __builtin_amdgcn_exp2f(v1[j])); }
                    u32x4 w; w.x = cvt_pk_bf16(v0[0], v0[1]); w.y = cvt_pk_bf16(v0[2], v0[3]); w.z = cvt_pk_bf16(v1[0], v1[1]); w.w = cvt_pk_bf16(v1[2], v1[3]);
                    *(u32x4*)(rowp + bj * HALF) = w; } }
    }
};
struct EpiRes {
    static constexpr bool PERM = true, AFTER_DRAIN = false;
    const float* X; bf16_t* O; int ldc; const float* gt; int ldgt; float scale;
    __device__ __forceinline__ void operator()(const f32x4 (&acc)[2][2][4][2], const Unit& u, int wr, int wc, int fr, int fq) const {
        const int row0 = u.pm * BM + wr * 64 + fr, col0 = u.pn * BM + wc * 32 + 8 * fq;
        const float* g = gt + (size_t)(u.pm / (SEQ / BM)) * ldgt;
        f32x4 gv[2][2];
#pragma unroll
        for (int bj = 0; bj < 2; ++bj)
#pragma unroll
            for (int n = 0; n < 2; ++n) gv[bj][n] = *(const f32x4*)(g + col0 + bj * HALF + n * 4);
#pragma unroll
        for (int ai = 0; ai < 2; ++ai)
#pragma unroll
            for (int m = 0; m < 4; ++m) { const size_t off = (size_t)(row0 + ai * HALF + m * 16) * ldc + col0;
#pragma unroll
                for (int bj = 0; bj < 2; ++bj) { const f32x4 x0 = *(const f32x4*)(X + off + bj * HALF), x1 = *(const f32x4*)(X + off + bj * HALF + 4);
                    const f32x4 y0 = x0 + gv[bj][0] * (acc[ai][bj][m][0] * scale), y1 = x1 + gv[bj][1] * (acc[ai][bj][m][1] * scale);
                    v4u w; w.x = cvt_pk_bf16(y0[0], y0[1]); w.y = cvt_pk_bf16(y0[2], y0[3]); w.z = cvt_pk_bf16(y1[0], y1[1]); w.w = cvt_pk_bf16(y1[2], y1[3]);
                    *(v4u*)(O + off + bj * HALF) = w; } }
    }
};

template <class Epi, class Sched, bool ALIGN_EPI = false, bool SP2 = false, bool F8 = false>
__device__ __forceinline__ void gemm_phase(PG8_LAS unsigned char* lds, const Gemm g, const Sched& S, const Epi& E) {
    const int tid = threadIdx.x, wid = __builtin_amdgcn_readfirstlane(tid >> 6), lane = tid & 63, wr = wid >> 2, wc = wid & 3, fr = lane & 15, fq = lane >> 4;
    const int K = g.K, nt = K / BK;
    unsigned voffA[2], voffB[2];
#pragma unroll
    for (int i = 0; i < 2; ++i) { int R, C; stage_rc(tid * 16 + i * 8192, R, C); const int Rb = Epi::PERM ? ((R & ~31) + perm32(R & 31)) : R;
        voffA[i] = (unsigned)(R * g.lda + C) * 2u; voffB[i] = (unsigned)(Rb * g.ldb + C) * 2u; }
    const size_t kstep = (size_t)(BK * 2);
    const size_t hstepA = (size_t)HALF * g.lda * 2, hstepB = (size_t)HALF * g.ldb * 2;
    const size_t tstepA = 2 * hstepA, tstepB = 2 * hstepB;
    const unsigned ldsw = (unsigned)wid * 1024u;
    const int aoff = lds_byte(wr * 64 + fr, fq * 8), boff = lds_byte(wc * 32 + fr, fq * 8);
#define PG8_SA(b, h) (((b) * 2 + (h)) * HTB)
#define PG8_SB(b, h) ((4 + (b) * 2 + (h)) * HTB)
#define PG8_STAGE(bufoff, gbase, voff) do { _Pragma("unroll") for (int _i = 0; _i < 2; ++_i) \
        __builtin_amdgcn_global_load_lds((const unsigned*)((const char*)(gbase) + (voff)[_i]), (PG8_LAS unsigned*)(lds + (bufoff) + ldsw + _i * 8192), 16, 0, 0); } while (0)
#define PG8_LDA(dst, b, h) do { if constexpr (F8) { _Pragma("unroll") for (int m = 0; m < 4; ++m) dst##8[m] = f8cat(*(const PG8_LAS bf16x8*)(lds + PG8_SA(b, h) + aoff + m * 2048), *(const PG8_LAS bf16x8*)(lds + PG8_SA(b, h) + aoff + m * 2048 + 1024)); } \
        else { _Pragma("unroll") for (int m = 0; m < 4; ++m) _Pragma("unroll") for (int k = 0; k < 2; ++k) dst[m][k] = *(const PG8_LAS bf16x8*)(lds + PG8_SA(b, h) + aoff + m * 2048 + k * 1024); } } while (0)
#define PG8_LDB(dst, b, h) do { if constexpr (F8) { _Pragma("unroll") for (int n = 0; n < 2; ++n) dst##8[n] = f8cat(*(const PG8_LAS bf16x8*)(lds + PG8_SB(b, h) + boff + n * 2048), *(const PG8_LAS bf16x8*)(lds + PG8_SB(b, h) + boff + n * 2048 + 1024)); } \
        else { _Pragma("unroll") for (int n = 0; n < 2; ++n) _Pragma("unroll") for (int k = 0; k < 2; ++k) dst[n][k] = *(const PG8_LAS bf16x8*)(lds + PG8_SB(b, h) + boff + n * 2048 + k * 1024); } } while (0)
#define PG8_MMA(ai, bj, At, Bt) do { __builtin_amdgcn_s_setprio(1); _Pragma("unroll") for (int m = 0; m < 4; ++m) _Pragma("unroll") for (int n = 0; n < 2; ++n) { \
        if constexpr (F8) { asm volatile("v_mfma_scale_f32_16x16x128_f8f6f4 %0, %1, %2, %0, %3, %3 op_sel_hi:[0,0,0]" : "+v"(acc[ai][bj][m][n]) : "v"(Bt##8[n]), "v"(At##8[m]), "v"(f8scale)); } \
        else { _Pragma("unroll") for (int k = 0; k < 2; ++k) acc[ai][bj][m][n] = __builtin_amdgcn_mfma_f32_16x16x32_bf16(Bt[n][k], At[m][k], acc[ai][bj][m][n], 0, 0, 0); } } __builtin_amdgcn_s_setprio(0); } while (0)
#define PG8_WAIT_V(n) asm volatile("s_waitcnt vmcnt(" #n ")" ::: "memory")
#define PG8_WAIT_L(n) asm volatile("s_waitcnt lgkmcnt(" #n ")" ::: "memory")
#define PG8_BAR __builtin_amdgcn_s_barrier()
#define PG8_SCHED __builtin_amdgcn_sched_barrier(0)
    Unit cur, nxt; int ui = 0;
    if (!S.next(0, cur)) return;
    f32x4 acc[2][2][4][2];
#pragma unroll
    for (int a = 0; a < 2; ++a)
#pragma unroll
        for (int b = 0; b < 2; ++b)
#pragma unroll
            for (int m = 0; m < 4; ++m)
#pragma unroll
                for (int n = 0; n < 2; ++n) acc[a][b][m][n] = (f32x4){0.f, 0.f, 0.f, 0.f};
    bf16x8 At[4][2], B0[2][2], B1[2][2]; v8i_t At8[4], B08[2], B18[2];
    const int f8scale = 0x7f7f7f7f;
    const char* cA = (const char*)g.A + (size_t)cur.pm * tstepA; const char* cB = (const char*)g.Bt + (size_t)cur.pn * tstepB;
    S.a_ready(cur);
    if constexpr (SP2) {
        PG8_STAGE(PG8_SB(0, 0), cB, voffB); PG8_STAGE(PG8_SB(0, 1), cB + hstepB, voffB); PG8_STAGE(PG8_SA(0, 0), cA, voffA); PG8_STAGE(PG8_SA(0, 1), cA + hstepA, voffA);
        if (wr == 1) PG8_BAR;
        PG8_WAIT_V(2); PG8_BAR;
        PG8_STAGE(PG8_SB(1, 0), cB + kstep, voffB); PG8_STAGE(PG8_SA(1, 0), cA + kstep, voffA); PG8_STAGE(PG8_SB(1, 1), cB + hstepB + kstep, voffB);
        PG8_WAIT_V(6); PG8_BAR;
    } else {
        PG8_STAGE(PG8_SB(0, 0), cB, voffB); PG8_STAGE(PG8_SA(0, 0), cA, voffA); PG8_STAGE(PG8_SB(0, 1), cB + hstepB, voffB); PG8_STAGE(PG8_SA(0, 1), cA + hstepA, voffA);
        if (wr == 1) PG8_BAR;
        PG8_WAIT_V(4); PG8_BAR;
        PG8_STAGE(PG8_SB(1, 0), cB + kstep, voffB); PG8_STAGE(PG8_SA(1, 0), cA + kstep, voffA); PG8_STAGE(PG8_SB(1, 1), cB + hstepB + kstep, voffB);
        PG8_WAIT_V(6); PG8_BAR;
    }
    for (;;) {
        const bool has_next = S.next(ui + 1, nxt);
        const char* nA = has_next ? (const char*)g.A + (size_t)nxt.pm * tstepA : cA; const char* nB = has_next ? (const char*)g.Bt + (size_t)nxt.pn * tstepB : cB;
        for (int t = 0; t < nt; t += 2) {
            const bool last = (t == nt - 2);
            const char* a1 = cA + (size_t)(t + 1) * kstep;
            const char* a2 = last ? nA : cA + (size_t)(t + 2) * kstep; const char* b2 = last ? nB : cB + (size_t)(t + 2) * kstep;
            const char* a3 = a2 + kstep; const char* b3 = b2 + kstep;
            if (last && has_next) S.a_ready(nxt);
            if constexpr (SP2) {
            PG8_LDB(B0, 0, 0); PG8_LDB(B1, 0, 1); PG8_SCHED; PG8_LDA(At, 0, 0); PG8_STAGE(PG8_SA(1, 1), a1 + hstepA, voffA);
            PG8_WAIT_V(8); PG8_WAIT_L(0); PG8_BAR; PG8_MMA(0, 0, At, B0); PG8_MMA(0, 1, At, B1); PG8_BAR; PG8_SCHED;
            PG8_LDA(At, 0, 1); PG8_STAGE(PG8_SB(0, 0), b2, voffB); PG8_STAGE(PG8_SB(0, 1), b2 + hstepB, voffB); PG8_STAGE(PG8_SA(0, 0), a2, voffA);
            PG8_WAIT_V(8); PG8_WAIT_L(0); PG8_BAR; PG8_MMA(1, 0, At, B0); PG8_MMA(1, 1, At, B1); PG8_BAR; PG8_SCHED;
            PG8_LDB(B0, 1, 0); PG8_LDB(B1, 1, 1); PG8_SCHED; PG8_LDA(At, 1, 0); PG8_STAGE(PG8_SA(0, 1), a2 + hstepA, voffA);
            PG8_WAIT_V(8); PG8_WAIT_L(0); PG8_BAR; PG8_MMA(0, 0, At, B0); PG8_MMA(0, 1, At, B1); PG8_BAR; PG8_SCHED;
            PG8_LDA(At, 1, 1); PG8_STAGE(PG8_SB(1, 0), b3, voffB); PG8_STAGE(PG8_SB(1, 1), b3 + hstepB, voffB); PG8_STAGE(PG8_SA(1, 0), a3, voffA);
            PG8_WAIT_V(8); PG8_WAIT_L(0); PG8_BAR; PG8_MMA(1, 0, At, B0); PG8_MMA(1, 1, At, B1); PG8_BAR; PG8_SCHED;
            } else {
            PG8_LDB(B0, 0, 0); PG8_SCHED; PG8_LDA(At, 0, 0); PG8_STAGE(PG8_SA(1, 1), a1 + hstepA, voffA);
            PG8_WAIT_L(8); PG8_BAR; PG8_WAIT_L(0); PG8_MMA(0, 0, At, B0); PG8_BAR; PG8_SCHED;
            PG8_LDB(B1, 0, 1); PG8_STAGE(PG8_SB(0, 0), b2, voffB);
            PG8_BAR; PG8_WAIT_L(0); PG8_MMA(0, 1, At, B1); PG8_BAR;
            PG8_LDA(At, 0, 1); PG8_STAGE(PG8_SA(0, 0), a2, voffA);
            PG8_BAR; PG8_WAIT_L(0); PG8_MMA(1, 0, At, B0); PG8_BAR; PG8_SCHED;
            PG8_STAGE(PG8_SB(0, 1), b2 + hstepB, voffB);
            PG8_WAIT_V(6); PG8_BAR; PG8_MMA(1, 1, At, B1); PG8_BAR;
            PG8_LDB(B0, 1, 0); PG8_SCHED; PG8_LDA(At, 1, 0); PG8_STAGE(PG8_SA(0, 1), a2 + hstepA, voffA);
            PG8_WAIT_L(8); PG8_BAR; PG8_WAIT_L(0); PG8_MMA(0, 0, At, B0); PG8_BAR; PG8_SCHED;
            PG8_LDB(B1, 1, 1); PG8_STAGE(PG8_SB(1, 0), b3, voffB);
            PG8_BAR; PG8_WAIT_L(0); PG8_MMA(0, 1, At, B1); PG8_BAR;
            PG8_LDA(At, 1, 1); PG8_STAGE(PG8_SA(1, 0), a3, voffA);
            PG8_BAR; PG8_WAIT_L(0); PG8_MMA(1, 0, At, B0); PG8_BAR; PG8_SCHED;
            PG8_STAGE(PG8_SB(1, 1), b3 + hstepB, voffB);
            PG8_WAIT_V(6); PG8_BAR; PG8_MMA(1, 1, At, B1); PG8_BAR;
            }
        }
        if constexpr (F8) { asm volatile("s_nop 15\n\ts_nop 15" ::: "memory"); }
        if constexpr (ALIGN_EPI) { if (wr == 0) PG8_BAR; }
        if constexpr (!Epi::AFTER_DRAIN) { E(acc, cur, wr, wc, fr, fq); S.done(cur); }
        if (!has_next) break;
#pragma unroll
        for (int a = 0; a < 2; ++a)
#pragma unroll
            for (int b = 0; b < 2; ++b)
#pragma unroll
                for (int m = 0; m < 4; ++m)
#pragma unroll
                    for (int n = 0; n < 2; ++n) acc[a][b][m][n] = (f32x4){0.f, 0.f, 0.f, 0.f};
        cur = nxt; cA = nA; cB = nB; ++ui;
        if constexpr (ALIGN_EPI) { if (wr == 1) PG8_BAR; }
    }
    PG8_WAIT_V(0);
    if constexpr (!ALIGN_EPI) { if (wr == 0) PG8_BAR; }
    PG8_BAR;
    if constexpr (Epi::AFTER_DRAIN) { E.fused(acc, cur, wr, wc, fr, fq, lds, wid, lane); S.done(cur); }
#undef PG8_SA
#undef PG8_SB
#undef PG8_STAGE
#undef PG8_LDA
#undef PG8_LDB
#undef PG8_MMA
#undef PG8_WAIT_V
#undef PG8_WAIT_L
#undef PG8_BAR
#undef PG8_SCHED
}}

constexpr size_t MiB = 1u << 20;
constexpr size_t WS_CTL = 0, CTL_ZERO_BYTES = 2 * MiB;
constexpr size_t WS_MOD = 1 * MiB;
constexpr size_t WS_BT1 = 2 * MiB;
constexpr size_t WS_W8IN = 16 * MiB;
constexpr size_t WS_G8 = 64 * MiB;
constexpr size_t WS_H8 = 96 * MiB;
constexpr size_t WS_BT2 = 128 * MiB;
constexpr size_t WS_WUK = 148 * MiB;
constexpr size_t WS_BTUV = 150 * MiB;
constexpr size_t WS_BTUP = 152 * MiB;
constexpr size_t WS_BTOUT = 184 * MiB;
constexpr size_t WS_BTPQ = 216 * MiB;
constexpr size_t WS_SK = 232 * MiB;
constexpr size_t WS_U8 = 233 * MiB, WS_V8 = 297 * MiB, WS_SU = 361 * MiB, WS_SV = 362 * MiB;
constexpr int ROW6 = 3072;
constexpr size_t WS_H = 489 * MiB;
constexpr size_t WS_P1 = 553 * MiB;
constexpr size_t WS_Q2 = 805 * MiB;
constexpr size_t WS_QL = 965 * MiB;
constexpr size_t WS_SC = 1093 * MiB;
constexpr size_t WS_SEL = 1157 * MiB, WS_CNT = 1165 * MiB, WS_WIDX = 1166 * MiB;
constexpr size_t WS_OLAT = 1168 * MiB;
constexpr size_t WS_YCAT = 1296 * MiB;
constexpr size_t WS_MERGED8 = 1328 * MiB;
constexpr size_t WS_MERGED = 1360 * MiB;
constexpr size_t WS_PQ = 1424 * MiB;
constexpr size_t WS_EID = 1456 * MiB, WS_GATE = 1460 * MiB;
constexpr size_t WS_CKV = 1528 * MiB;
constexpr size_t WS_END = 1536 * MiB;

constexpr int SCRATCH_BYTES = 155648;
constexpr int MISC_OFF = SCRATCH_BYTES;
constexpr int LDS_BYTES = SCRATCH_BYTES + 1024;
constexpr int NWAVES = 8, NTHR = 512;

struct Params {
    const float *x, *c, *w_ada, *b_ada, *g_mix, *w_in, *g_cq, *g_ckv, *w_uq, *w_uk, *w_uv, *w_qi, *g_ki, *b_ki, *t5, *g_ret, *w_up, *w_gate, *b_gate, *w_out, *g_ffn, *w_pq, *sub_keys, *u_exp, *v_exp, *g_final;
    float* out; unsigned char* ws; int ph_lo, ph_hi;
#ifdef PEER_PROBE
    int dummy;
#endif
};

#define LDS_WAIT() asm volatile("s_waitcnt lgkmcnt(0)" ::: "memory")
#define VM_WAIT() asm volatile("s_waitcnt vmcnt(0)" ::: "memory")

#define XB_TMO      128
#define XB_XCNT(j)  (256  + 64 * (j))
#define XB_XSUB(j)  (1280 + 64 * (j))
#define XB_XGEN(j)  (2304 + 64 * (j))
#define XB_TOP      3328
#define XB_TOPGEN   3392
#define XCD_BAR_WORDS 3456
#define XB_ATT_RANK  4096
#define XB_SPIN_CAP (1u << 18)

__device__ __forceinline__ unsigned xb_ld(unsigned* p)              { return __hip_atomic_load(p, __ATOMIC_RELAXED, __HIP_MEMORY_SCOPE_AGENT); }
__device__ __forceinline__ unsigned xb_add(unsigned* p, unsigned v) { return __hip_atomic_fetch_add(p, v, __ATOMIC_RELAXED, __HIP_MEMORY_SCOPE_AGENT); }
__device__ __forceinline__ unsigned xb_xcc_id() { return (unsigned)__builtin_amdgcn_s_getreg((3 << 11) | 20) & 0xFu; }
#define XB_SPIN(cond, bar) do { unsigned _sp = 0; while (cond) { __builtin_amdgcn_s_sleep(1); \
    if ((++_sp & 255u) == 0u) { if (xb_ld(&(bar)[XB_TMO])) break; if (_sp > XB_SPIN_CAP) { atomicAdd(&(bar)[XB_TMO], 1u); break; } } } } while (0)

struct XcdBarrier { unsigned* bar; unsigned x; volatile LAS unsigned* st; };

__device__ __forceinline__ XcdBarrier xcd_barrier_post(unsigned* bar, volatile LAS unsigned* st) {
    XcdBarrier b; b.bar = bar; b.x = xb_xcc_id(); b.st = st;
    if (threadIdx.x == 0) (void)xb_add(&bar[XB_XCNT(b.x)], 1u);
    return b;
}
__device__ __forceinline__ void xcd_barrier_complete(unsigned* bar, unsigned x, unsigned& nloc, unsigned& nx) {
    const unsigned G = gridDim.x * gridDim.y * gridDim.z;
    unsigned sum, cnt, mine, sp = 0u;
    for (;;) {
        sum = 0u; cnt = 0u; mine = 0u;
#pragma unroll
        for (unsigned j = 0; j < 16; ++j) { const unsigned c = xb_ld(&bar[XB_XCNT(j)]); sum += c; cnt += (c > 0u) ? 1u : 0u; mine = (j == x) ? c : mine; }
        if (sum == G) break;
        __builtin_amdgcn_s_sleep(1);
        if ((++sp & 255u) == 0u) { if (xb_ld(&bar[XB_TMO])) break; if (sp > XB_SPIN_CAP) { atomicAdd(&bar[XB_TMO], 1u); break; } }
    }
    nloc = mine > 0u ? mine : 1u; nx = cnt > 0u ? cnt : 1u;
}
__device__ __forceinline__ void xcd_barrier(const XcdBarrier& b) {
    asm volatile("s_waitcnt vmcnt(0)" ::: "memory");
    __syncthreads();
    if (threadIdx.x == 0) {
        unsigned* bar = b.bar;
        __builtin_amdgcn_s_waitcnt(0);
        unsigned nloc = b.st[0], nx = b.st[1];
        if (nloc == 0u) { xcd_barrier_complete(bar, b.x, nloc, nx); b.st[0] = nloc; b.st[1] = nx; }
        const unsigned old = xb_add(&bar[XB_XSUB(b.x)], 1u);
        const unsigned gen = old / nloc;
        if (old + 1u == (gen + 1u) * nloc) {
            __builtin_amdgcn_fence(__ATOMIC_RELEASE, "agent");
            asm volatile("s_waitcnt vmcnt(0)" ::: "memory");
            const unsigned og = xb_add(&bar[XB_TOP], 1u);
            const unsigned tg = og / nx;
            if (og + 1u == (tg + 1u) * nx) xb_add(&bar[XB_TOPGEN], 1u);
            else XB_SPIN(xb_ld(&bar[XB_TOPGEN]) == tg, bar);
            __builtin_amdgcn_fence(__ATOMIC_ACQUIRE, "agent");
            xb_add(&bar[XB_XGEN(b.x)], 1u);
            asm volatile("s_waitcnt vmcnt(0)" ::: "memory");
        } else {
            XB_SPIN(xb_ld(&bar[XB_XGEN(b.x)]) == gen, bar);
            __builtin_amdgcn_fence(__ATOMIC_ACQUIRE, "agent");
            asm volatile("s_waitcnt vmcnt(0)" ::: "memory");
        }
    }
    __syncthreads();
}

struct Ctx { LAS unsigned char* lds; int tid, lane, wave, gw, ngw, bid, nb; };

__device__ __forceinline__ void p0_transpose_item(const float* W, int K, int N, bf16* WT, int row_off, LAS float* scr, int item, int lane, int ldw = 0) {
    if (!ldw) ldw = N;
    const int nblk = N / 32, kb = item / nblk, nb = item % nblk, k0 = 64 * kb, n0 = 32 * nb;
#pragma unroll 8
    for (int i = 0; i < 32; ++i) { const int kk = 2 * i + (lane >> 5); scr[kk * 33 + (lane & 31)] = W[(size_t)(k0 + kk) * ldw + n0 + (lane & 31)]; }
    LDS_WAIT(); asm volatile("" ::: "memory");
    const int c = lane & 7;
#pragma unroll
    for (int j = 0; j < 4; ++j) { const int n = (lane >> 3) + 8 * j; const LAS float* s = scr + (8 * c) * 33 + n;
        v4u o; o.x = cvt_pk_bf16(s[0 * 33], s[1 * 33]); o.y = cvt_pk_bf16(s[2 * 33], s[3 * 33]); o.z = cvt_pk_bf16(s[4 * 33], s[5 * 33]); o.w = cvt_pk_bf16(s[6 * 33], s[7 * 33]);
        *(v4u*)(WT + (size_t)(row_off + n0 + n) * K + k0 + 8 * c) = o; }
    LDS_WAIT(); asm volatile("" ::: "memory");
}
__device__ __forceinline__ void p0_transpose_item_f8(const float* W, int K, int N, unsigned char* WT, float sc, LAS float* scr, int item, int lane, int ldw = 0) {
    if (!ldw) ldw = N;
    const int nblk = N / 32, kb = item / nblk, nb = item % nblk, k0 = 64 * kb, n0 = 32 * nb;
#pragma unroll 8
    for (int i = 0; i < 32; ++i) { const int kk = 2 * i + (lane >> 5); scr[kk * 33 + (lane & 31)] = W[(size_t)(k0 + kk) * ldw + n0 + (lane & 31)]; }
    LDS_WAIT(); asm volatile("" ::: "memory");
    const int n = lane >> 1, kh = (lane & 1) * 32; const LAS float* s = scr + kh * 33 + n;
    unsigned o[8];
#pragma unroll
    for (int j = 0; j < 8; ++j) { int w = 0; w = PK_FP8(s[(4 * j) * 33] * sc, s[(4 * j + 1) * 33] * sc, w, false); w = PK_FP8(s[(4 * j + 2) * 33] * sc, s[(4 * j + 3) * 33] * sc, w, true); o[j] = (unsigned)w; }
    unsigned char* dp = WT + (size_t)(n0 + n) * K + k0 + kh;
    *(v4u*)dp = (v4u){o[0], o[1], o[2], o[3]}; *(v4u*)(dp + 16) = (v4u){o[4], o[5], o[6], o[7]};
    LDS_WAIT(); asm volatile("" ::: "memory");
}
__device__ __forceinline__ void p0_convert(const float* src, bf16* dst, size_t n, size_t i0, size_t stride) {
    for (size_t i = i0; i < n / 8; i += stride) { const f32x4 a = *(const f32x4*)(src + 8 * i), b = *(const f32x4*)(src + 8 * i + 4);
        v4u o; o.x = cvt_pk_bf16(a[0], a[1]); o.y = cvt_pk_bf16(a[2], a[3]); o.z = cvt_pk_bf16(b[0], b[1]); o.w = cvt_pk_bf16(b[2], b[3]); *(v4u*)(dst + 8 * i) = o; }
}

__device__ __forceinline__ void tr32_item(const float* W, int K, int N, bf16* WT, LAS float* scr, int item, int lane) {
    const int nblk = N / 32, kb = item / nblk, nb = item % nblk, k0 = 32 * kb, n0 = 32 * nb;
#pragma unroll 8
    for (int i = 0; i < 16; ++i) { const int kk = 2 * i + (lane >> 5); scr[kk * 33 + (lane & 31)] = W[(size_t)(k0 + kk) * N + n0 + (lane & 31)]; }
    LDS_WAIT(); asm volatile("" ::: "memory");
#pragma unroll
    for (int j = 0; j < 2; ++j) { const int q = lane + 64 * j, n = q >> 2, cch = q & 3; const LAS float* s = scr + (8 * cch) * 33 + n;
        v4u o; o.x = cvt_pk_bf16(s[0 * 33], s[1 * 33]); o.y = cvt_pk_bf16(s[2 * 33], s[3 * 33]); o.z = cvt_pk_bf16(s[4 * 33], s[5 * 33]); o.w = cvt_pk_bf16(s[6 * 33], s[7 * 33]);
        *(v4u*)(WT + (size_t)(n0 + n) * K + k0 + 8 * cch) = o; }
    LDS_WAIT(); asm volatile("" ::: "memory");
}
__device__ __forceinline__ void tr32_item_f8(const float* W, int K, int N, unsigned char* WT, float sc, LAS float* scr, int item, int lane) {
    const int nblk = N / 32, kb = item / nblk, nb = item % nblk, k0 = 32 * kb, n0 = 32 * nb;
#pragma unroll 8
    for (int i = 0; i < 16; ++i) { const int kk = 2 * i + (lane >> 5); scr[kk * 33 + (lane & 31)] = W[(size_t)(k0 + kk) * N + n0 + (lane & 31)]; }
    LDS_WAIT(); asm volatile("" ::: "memory");
    const int n = lane >> 1, kh = (lane & 1) * 16; const LAS float* s = scr + kh * 33 + n;
    unsigned o[4];
#pragma unroll
    for (int j = 0; j < 4; ++j) { int w = 0; w = PK_FP8(s[(4 * j) * 33] * sc, s[(4 * j + 1) * 33] * sc, w, false); w = PK_FP8(s[(4 * j + 2) * 33] * sc, s[(4 * j + 3) * 33] * sc, w, true); o[j] = (unsigned)w; }
    *(v4u*)(WT + (size_t)(n0 + n) * K + k0 + kh) = (v4u){o[0], o[1], o[2], o[3]};
    LDS_WAIT(); asm volatile("" ::: "memory");
}
__device__ __forceinline__ void convert_late_weights(const Params& p, LAS float* scr, int lane, int first, int stride) {
    unsigned char* ws = p.ws;
    constexpr int I_UP = 128 * (D / 32), I_OUT = 128 * (D / 32), I_PQ = 128 * (2048 / 32);
    for (int it = first; it < I_UP + I_OUT + I_PQ; it += stride) { int r = it;
        if (r < I_UP) { tr32_item_f8(p.w_up, D, D, ws + WS_BTUP, 1024.0f, scr, r, lane); continue; } r -= I_UP;
        if (r < I_OUT) { tr32_item_f8(p.w_out, D, D, ws + WS_BTOUT, 1024.0f, scr, r, lane); continue; } r -= I_OUT;
        tr32_item(p.w_pq, D, 2048, (bf16*)(ws + WS_BTPQ), scr, r, lane); }
}
constexpr size_t WS_SILU = WS_CTL + 1472 * 1024;
constexpr size_t WS_MODP = 1093 * MiB;
__device__ __forceinline__ void adaln_late(const Params& p, int item, int lane) {
    const int cc = item & 63, rg = item >> 6;
    const float* wp = p.w_ada + (size_t)(rg * 256) * (6 * D) + 2 * D + cc * 256 + lane * 4;
    f32x4 a0 = {0.f, 0.f, 0.f, 0.f}, a1 = a0, a2 = a0, a3 = a0;
#pragma unroll 8
    for (int d = 0; d < 256; ++d) { const f32x4 w = *(const f32x4*)(wp + (size_t)d * (6 * D)); const int dd = rg * 256 + d;
        const float* sl = (const float*)(p.ws + WS_SILU);
        a0 += w * sl[dd]; a1 += w * sl[D + dd]; a2 += w * sl[2 * D + dd]; a3 += w * sl[3 * D + dd]; }
    float* pp = (float*)(p.ws + WS_MODP) + (size_t)(rg * 4) * (4 * D) + cc * 256 + lane * 4;
    *(f32x4*)(pp) = a0; *(f32x4*)(pp + 4 * D) = a1; *(f32x4*)(pp + 2 * 4 * D) = a2; *(f32x4*)(pp + 3 * 4 * D) = a3;
}
__device__ __forceinline__ void adaln_late_reduce(const Params& p, const Ctx& c) {
    const float* pp = (const float*)(p.ws + WS_MODP); float* mod = (float*)(p.ws + WS_MOD);
    for (int i = c.bid * NTHR + c.tid; i < 4 * 4 * D; i += c.nb * NTHR) { const int b = i / (4 * D), col = i % (4 * D); float s_ = p.b_ada[2 * D + col];
#pragma unroll
        for (int rg = 0; rg < 16; ++rg) s_ += pp[(size_t)(rg * 4 + b) * (4 * D) + col];
        mod[(size_t)b * 6 * D + 2 * D + col] = s_; }
}
typedef unsigned v2u_t __attribute__((ext_vector_type(2)));
constexpr size_t SLB = (size_t)P_EXP * 192;
__device__ __forceinline__ void convert_expert_rows(const Params& p, const Ctx& c, int r_first, int r_stride) {
    unsigned char* ws = p.ws;
        {
            typedef float v16f_t __attribute__((ext_vector_type(16))); typedef float v32f_t __attribute__((ext_vector_type(32))); typedef unsigned v6u_t __attribute__((ext_vector_type(6)));
            v16f_t pa, pb;
#pragma unroll
            for (int i = 0; i < 16; ++i) { pa[i] = (i < 8) ? 0.125f * i : 1.0f + 0.125f * (i - 8); pb[i] = (i < 8) ? 2.0f + 0.25f * i : 4.0f + 0.5f * (i - 8); }
            const v32f_t pd = __builtin_amdgcn_cvt_scalef32_pk32_f32_fp6(__builtin_amdgcn_cvt_scalef32_2xpk16_fp6_f32(pa, pb, 1.0f), 1.0f);
            const bool inter = (pd[1] == pb[0]);
            bool okl = true;
#pragma unroll
            for (int i = 0; i < 16; ++i) okl = okl && (inter ? (pd[2 * i] == pa[i] && pd[2 * i + 1] == pb[i]) : (pd[i] == pa[i] && pd[16 + i] == pb[i]));
            for (int r = r_first; r < 2 * P_EXP; r += r_stride) {
                const bool isv = r >= P_EXP; const int e = isv ? r - P_EXP : r;
                const float* src = (isv ? p.v_exp : p.u_exp) + (size_t)e * D;
                f32x4 v[16]; float mx = 0.f;
#pragma unroll
                for (int g = 0; g < 2; ++g)
#pragma unroll
                    for (int k = 0; k < 8; ++k) { v[g * 8 + k] = *(const f32x4*)(src + (g * 64 + c.lane) * 32 + k * 4);
                        mx = fmaxf(mx, fmaxf(fmaxf(fabsf(v[g * 8 + k].x), fabsf(v[g * 8 + k].y)), fmaxf(fabsf(v[g * 8 + k].z), fabsf(v[g * 8 + k].w)))); }
#pragma unroll
                for (int o = 1; o < 64; o <<= 1) mx = fmaxf(mx, __shfl_xor(mx, o));
                const float scale = (mx > 0.f) ? mx * (1.0f / 7.5f) : 1.0f; float inv = 1.0f / scale;
                if (!okl) inv = __builtin_nanf("");
                v6u_t wq[2];
#pragma unroll
                for (int g = 0; g < 2; ++g) { v16f_t a, b;
                    if (inter) {
#pragma unroll
                        for (int i = 0; i < 16; ++i) { a[i] = v[g * 8 + (2 * i) / 4][(2 * i) % 4] * inv; b[i] = v[g * 8 + (2 * i + 1) / 4][(2 * i + 1) % 4] * inv; } }
                    else {
#pragma unroll
                        for (int i = 0; i < 16; ++i) { a[i] = v[g * 8 + i / 4][i % 4] * inv; b[i] = v[g * 8 + 4 + i / 4][i % 4] * inv; } }
                    wq[g] = __builtin_amdgcn_cvt_scalef32_2xpk16_fp6_f32(a, b, 1.0f); }
#pragma unroll
                for (int g = 0; g < 2; ++g) { unsigned char* drow = ws + (isv ? WS_V8 : WS_U8) + (size_t)(g * 8 + (c.lane >> 3)) * SLB + (size_t)e * 192;
                    *(v4u*)(drow + (c.lane & 7) * 16) = (v4u){wq[g][0], wq[g][1], wq[g][2], wq[g][3]};
                    *(v2u_t*)(drow + 128 + (c.lane & 7) * 8) = (v2u_t){wq[g][4], wq[g][5]}; }
                if (c.lane == 0) ((float*)(ws + (isv ? WS_SV : WS_SU)))[e] = scale;
            }
        }
}

__device__ __forceinline__ void ph_prologue(const Params& p, const Ctx& c) {
    unsigned char* ws = p.ws;
    {
        float* mod = (float*)(ws + WS_MOD); LAS float* sc = (LAS float*)c.lds;
        LAS float* red = sc + 4 * D;
        for (int it = c.bid; it < 2 * D / 128; it += c.nb) {
            __syncthreads();
            for (int i = c.tid; i < 4 * D; i += NTHR) { const float v = p.c[i]; const float sv = v * sigmoidf_(v); sc[i] = sv; if (it == 0) ((float*)(ws + WS_SILU))[i] = sv; }
            __syncthreads();
            const int ct = c.tid & 31, dg = c.tid >> 5, e = it * 128 + ct * 4;
            f32x4 a0 = {0, 0, 0, 0}, a1 = a0, a2 = a0, a3 = a0;
            const float* wp = p.w_ada + (size_t)dg * (6 * D) + e;
#pragma unroll 8
            for (int i = 0; i < D / 16; ++i) { const f32x4 w = *(const f32x4*)(wp + (size_t)(16 * i) * (6 * D)); const int d = dg + 16 * i;
                a0 += w * sc[d]; a1 += w * sc[D + d]; a2 += w * sc[2 * D + d]; a3 += w * sc[3 * D + d]; }
            *(LAS f32x4*)(red + (dg * 4 + 0) * 128 + ct * 4) = a0; *(LAS f32x4*)(red + (dg * 4 + 1) * 128 + ct * 4) = a1;
            *(LAS f32x4*)(red + (dg * 4 + 2) * 128 + ct * 4) = a2; *(LAS f32x4*)(red + (dg * 4 + 3) * 128 + ct * 4) = a3;
            __syncthreads();
            { const int b = c.tid >> 7, col = c.tid & 127; float s = p.b_ada[it * 128 + col];
#pragma unroll
              for (int g = 0; g < 16; ++g) s += red[(g * 4 + b) * 128 + col];
              mod[(size_t)b * 6 * D + it * 128 + col] = s; }
        }
        __syncthreads();
    }
    {
        LAS float* scr = (LAS float*)(c.lds + c.wave * 8448);
        bf16* BT1 = (bf16*)(ws + WS_BT1); bf16* BT2 = (bf16*)(ws + WS_BT2);
        constexpr int I_IN = 64 * (IN_BF / 32), I_IN8 = 64 * ((IN_WIDTH - IN_BF) / 32), I_GATE = 64 * (2 * D / 32), I_UQ = 16 * (A_WIDTH / 32), I_QI = 16 * (IDX_H * IDX_D / 32), I_UV = 8 * (A_WIDTH / 32),
                      I_UVX = 0;
        constexpr int NITEMS = I_IN + I_IN8 + I_GATE + I_UQ + I_QI + I_UV + I_UVX;
        for (int it = c.gw; it < NITEMS; it += c.ngw) {
            int r = it;
            if (r < I_IN) { p0_transpose_item(p.w_in, D, IN_BF, BT1, 0, scr, r, c.lane, IN_WIDTH); continue; } r -= I_IN;
            if (r < I_IN8) { p0_transpose_item_f8(p.w_in + IN_BF, D, IN_WIDTH - IN_BF, ws + WS_W8IN, 1024.0f, scr, r, c.lane, IN_WIDTH); continue; } r -= I_IN8;
            if (r < I_GATE) { p0_transpose_item_f8(p.w_gate, D, 2 * D, ws + WS_G8, 1024.0f, scr, r, c.lane); continue; } r -= I_GATE;
            if (r < I_UQ) { p0_transpose_item(p.w_uq, A_QR, A_WIDTH, BT2, 0, scr, r, c.lane); continue; } r -= I_UQ;
            if (r < I_QI) { p0_transpose_item(p.w_qi, A_QR, IDX_H * IDX_D, BT2, A_WIDTH, scr, r, c.lane); continue; } r -= I_QI;
            p0_transpose_item(p.w_uv, A_KVR, A_WIDTH, (bf16*)(ws + WS_BTUV), 0, scr, r, c.lane);
        }
        const size_t gt = (size_t)c.bid * NTHR + c.tid, gs = (size_t)c.nb * NTHR;
        for (size_t i = gt; i < (size_t)(IN_PAD - IN_WIDTH) * D / 16; i += gs) *(v4u*)(ws + WS_W8IN + (size_t)(IN_WIDTH - IN_BF) * D + 16 * i) = (v4u){0u, 0u, 0u, 0u};
        p0_convert(p.w_uk, (bf16*)(ws + WS_WUK), (size_t)A_KVR * A_WIDTH, gt, gs);
        p0_convert(p.sub_keys, (bf16*)(ws + WS_SK), (size_t)2 * P_NK * 128, gt, gs);
    }
}

template <bool XB = false>
__device__ __forceinline__ void ph_modulate(const float* X, const float* g, const float* mod, int sh_off, int sc_off, bf16* H, unsigned char* H8, const Ctx& c) {
    for (int m = c.gw; m < T; m += c.ngw) {
        const int b = m / SEQ;
        const f32x4* xr = (const f32x4*)(X + (size_t)m * D) + c.lane;
        f32x4 v[16]; float s = 0.f;
#pragma unroll
        for (int j = 0; j < 16; ++j) { if (XB) { const v2u w = ((const v2u*)((const bf16*)X + (size_t)m * D) + c.lane)[64 * j]; v[j] = (f32x4){__uint_as_float(w.x << 16), __uint_as_float(w.x & 0xffff0000u), __uint_as_float(w.y << 16), __uint_as_float(w.y & 0xffff0000u)}; } else v[j] = xr[64 * j];
            s += (v[j].x * v[j].x + v[j].y * v[j].y) + (v[j].z * v[j].z + v[j].w * v[j].w); }
        const float rstd = 1.0f / sqrtf(wave_sum(s) * (1.0f / D) + EPS);
        const f32x4* gp = (const f32x4*)g + c.lane; const f32x4* shp = (const f32x4*)(mod + (size_t)b * 6 * D + sh_off) + c.lane; const f32x4* scp = (const f32x4*)(mod + (size_t)b * 6 * D + sc_off) + c.lane;
        v2u* o = (v2u*)(H + (size_t)m * D) + c.lane;
#pragma unroll
        for (int j = 0; j < 16; ++j) { const f32x4 gg = gp[64 * j], sh = shp[64 * j], sc = scp[64 * j];
            const f32x4 y = (v[j] * rstd * gg) * (sc + 1.0f) + sh;
            v2u w; w.x = cvt_pk_bf16(y.x, y.y); w.y = cvt_pk_bf16(y.z, y.w); o[64 * j] = w;
            if (H8) { int q = 0; q = PK_FP8(y.x * 16.0f, y.y * 16.0f, q, false); q = PK_FP8(y.z * 16.0f, y.w * 16.0f, q, true); ((unsigned*)(H8 + (size_t)m * D))[c.lane + 64 * j] = (unsigned)q; } }
    }
}

__device__ __forceinline__ void ph_postproc(const Params& p, const Ctx& c) {
    bf16* P1 = (bf16*)(p.ws + WS_P1); float* WIDX = (float*)(p.ws + WS_WIDX);
    const int lane = c.lane;
    const float inv = exp2f(-(float)lane * (13.287712379549449f / 63.0f));
    for (int t = c.gw; t < T; t += c.ngw) {
        bf16* row = P1 + (size_t)t * N1;
        const int pos = t % SEQ;
        { v4u a = *(v4u*)(row + C_CQ + lane * 8), b = *(v4u*)(row + C_CQ + 512 + lane * 8);
          float f[16] = {bflo(a.x), bfhi(a.x), bflo(a.y), bfhi(a.y), bflo(a.z), bfhi(a.z), bflo(a.w), bfhi(a.w), bflo(b.x), bfhi(b.x), bflo(b.y), bfhi(b.y), bflo(b.z), bfhi(b.z), bflo(b.w), bfhi(b.w)};
          float s = 0.f;
#pragma unroll
          for (int j = 0; j < 16; ++j) s += f[j] * f[j];
          const float rstd = 1.0f / sqrtf(wave_sum(s) * (1.0f / A_QR) + EPS);
          const float* g0 = p.g_cq + lane * 8; const float* g1 = p.g_cq + 512 + lane * 8;
#pragma unroll
          for (int j = 0; j < 8; ++j) { f[j] *= rstd * g0[j]; f[8 + j] *= rstd * g1[j]; }
          a.x = cvt_pk_bf16(f[0], f[1]); a.y = cvt_pk_bf16(f[2], f[3]); a.z = cvt_pk_bf16(f[4], f[5]); a.w = cvt_pk_bf16(f[6], f[7]);
          b.x = cvt_pk_bf16(f[8], f[9]); b.y = cvt_pk_bf16(f[10], f[11]); b.z = cvt_pk_bf16(f[12], f[13]); b.w = cvt_pk_bf16(f[14], f[15]);
          *(v4u*)(row + C_CQ + lane * 8) = a; *(v4u*)(row + C_CQ + 512 + lane * 8) = b; }
        { v4u a = *(v4u*)(row + C_CKV + lane * 8);
          float f[8] = {bflo(a.x), bfhi(a.x), bflo(a.y), bfhi(a.y), bflo(a.z), bfhi(a.z), bflo(a.w), bfhi(a.w)};
          float s = 0.f;
#pragma unroll
          for (int j = 0; j < 8; ++j) s += f[j] * f[j];
          const float rstd = 1.0f / sqrtf(wave_sum(s) * (1.0f / A_KVR) + EPS);
          const float* g0 = p.g_ckv + lane * 8;
#pragma unroll
          for (int j = 0; j < 8; ++j) f[j] *= rstd * g0[j];
          a.x = cvt_pk_bf16(f[0], f[1]); a.y = cvt_pk_bf16(f[2], f[3]); a.z = cvt_pk_bf16(f[4], f[5]); a.w = cvt_pk_bf16(f[6], f[7]);
          *(v4u*)((bf16*)(p.ws + WS_CKV) + (size_t)t * A_KVR + lane * 8) = a; }
        { unsigned w = *(unsigned*)(row + C_KI + lane * 2); const float f0 = bflo(w), f1 = bfhi(w);
          const float mu = wave_sum(f0 + f1) * (1.0f / IDX_D); const float d0 = f0 - mu, d1 = f1 - mu;
          const float var = wave_sum(d0 * d0 + d1 * d1) * (1.0f / IDX_D); const float rstd = 1.0f / sqrtf(var + EPS);
          const float y0 = d0 * rstd * p.g_ki[lane * 2] + p.b_ki[lane * 2], y1 = d1 * rstd * p.g_ki[lane * 2 + 1] + p.b_ki[lane * 2 + 1];
          *(unsigned*)(row + C_KI + lane * 2) = cvt_pk_bf16(y0, y1); }
        WIDX[(size_t)t * IDX_H + lane] = bf2f(row[C_WI + lane]) * (0.125f * 0.08838834764831845f);
        { const float angf = (float)pos * inv; const double a = (double)angf; const double r = a - 6.283185307179586476925 * rint(a * 0.15915494309189533577);
          float sn, cs; __sincosf((float)r, &sn, &cs);
#pragma unroll
          for (int h = 0; h < R_HEADS; ++h) {
              bf16* q = row + C_RQ + h * 128; bf16* k = row + C_RK + h * 128;
              const float q1 = bf2f(q[lane]), q2 = bf2f(q[64 + lane]), k1 = bf2f(k[lane]) * 0.08838834764831845f, k2 = bf2f(k[64 + lane]) * 0.08838834764831845f;
              q[lane] = f2bf(q1 * cs - q2 * sn); q[64 + lane] = f2bf(q1 * sn + q2 * cs);
              k[lane] = f2bf(k1 * cs - k2 * sn); k[64 + lane] = f2bf(k1 * sn + k2 * cs); } }
    }
}

template <bool OUT8> __device__ __forceinline__ void lds_gemm_unit(const bf16* A, int lda, const bf16* Bt, int ldb, int K, void* C, int ldc, float s8, const Ctx& c) {
    constexpr int PB = 272; LAS unsigned char* As = c.lds; LAS unsigned char* Bs = c.lds + 256 * PB;
    const int tid = c.tid, lane = c.lane, wr = c.wave >> 1, wc = c.wave & 1, fr = lane & 15, fq = lane >> 4;
    f32x4 acc[4][4];
#pragma unroll
    for (int i = 0; i < 4; ++i)
#pragma unroll
        for (int j = 0; j < 4; ++j) acc[i][j] = (f32x4){0.f, 0.f, 0.f, 0.f};
    for (int k0 = 0; k0 < K; k0 += 128) {
        __syncthreads();
#pragma unroll
        for (int i = 0; i < 8; ++i) { const int q = tid + 512 * i, r = q >> 4, ch = q & 15; *(LAS v4u*)(As + r * PB + ch * 16) = *(const v4u*)(A + (size_t)r * lda + k0 + ch * 8); }
#pragma unroll
        for (int i = 0; i < 4; ++i) { const int q = tid + 512 * i, r = q >> 4, ch = q & 15; *(LAS v4u*)(Bs + r * PB + ch * 16) = *(const v4u*)(Bt + (size_t)r * ldb + k0 + ch * 8); }
        LDS_WAIT(); __syncthreads();
#pragma unroll
        for (int ks = 0; ks < 4; ++ks) { bf16x8 a[4], b[4];
#pragma unroll
            for (int i = 0; i < 4; ++i) { a[i] = *(const LAS bf16x8*)(As + (64 * wr + 16 * i + fr) * PB + ks * 64 + fq * 16); b[i] = *(const LAS bf16x8*)(Bs + (64 * wc + 16 * i + fr) * PB + ks * 64 + fq * 16); }
#pragma unroll
            for (int i = 0; i < 4; ++i)
#pragma unroll
                for (int j = 0; j < 4; ++j) acc[i][j] = __builtin_amdgcn_mfma_f32_16x16x32_bf16(b[j], a[i], acc[i][j], 0, 0, 0); }
    }
#pragma unroll
    for (int i = 0; i < 4; ++i)
#pragma unroll
        for (int j = 0; j < 4; ++j) { const size_t off = (size_t)(64 * wr + 16 * i + fr) * ldc + 64 * wc + 16 * j + 4 * fq;
            if constexpr (OUT8) { int q = 0; q = PK_FP8(acc[i][j][0] * s8, acc[i][j][1] * s8, q, false); q = PK_FP8(acc[i][j][2] * s8, acc[i][j][3] * s8, q, true); *(unsigned*)((unsigned char*)C + off) = (unsigned)q; }
            else { v2u w; w.x = cvt_pk_bf16(acc[i][j][0], acc[i][j][1]); w.y = cvt_pk_bf16(acc[i][j][2], acc[i][j][3]); *(v2u*)((bf16*)C + off) = w; } }
}
__device__ __forceinline__ void ph_qlat(const Params& p, const Ctx& c) {
    const bf16* Q2 = (const bf16*)(p.ws + WS_Q2); const bf16* WUK = (const bf16*)(p.ws + WS_WUK); bf16* QL = (bf16*)(p.ws + WS_QL);
    for (int u = c.bid; u < 16 * 32 * 4; u += c.nb) { const int h = u / 128, rem = u % 128, rt = rem / 4, ct = rem % 4;
        lds_gemm_unit<false>(Q2 + (size_t)(rt * 256) * N2 + h * 128, N2, WUK + (size_t)(ct * 128) * A_WIDTH + h * 128, A_WIDTH, 128, QL + (size_t)(rt * 256) * 8192 + h * 512 + ct * 128, 8192, 1.0f, c); }
    __syncthreads();
}
__device__ __forceinline__ void ph_oproj(const Params& p, const Ctx& c) {
    const bf16* OL = (const bf16*)(p.ws + WS_OLAT); const bf16* BTUV = (const bf16*)(p.ws + WS_BTUV); unsigned char* Y8 = p.ws + WS_YCAT;
    for (int u = c.bid; u < 16 * 32; u += c.nb) { const int h = u / 32, rt = u % 32;
        lds_gemm_unit<true>(OL + (size_t)(rt * 256) * 8192 + h * 512, 8192, BTUV + (size_t)(h * 128) * A_KVR, A_KVR, A_KVR, Y8 + (size_t)(rt * 256) * D + h * 128, D, 16.0f, c); }
    __syncthreads();
}

__device__ __forceinline__ void ph_scores(const Params& p, const Ctx& c) {
    const bf16* P1 = (const bf16*)(p.ws + WS_P1); const bf16* Q2 = (const bf16*)(p.ws + WS_Q2); const float* WIDX = (const float*)(p.ws + WS_WIDX); float* SC = (float*)(p.ws + WS_SC);
    constexpr int QPB = 272, QH = 32, QBYTES = QH * 16 * QPB;
    constexpr int WPB = 272; LAS unsigned char* wl = c.lds + QBYTES;
    const int tid = c.tid, lane = c.lane, w = c.wave, fr = lane & 15, fq = lane >> 4;
    for (int bu = c.bid; bu < NB * 64; bu += c.nb) {
        const int b = bu / 64, pr = bu % 64;
        for (int side = 0; side < 2; ++side) {
            const int qt = side ? 127 - pr : pr, nitems = qt / 4 + 1, t0 = b * SEQ + qt * 16;
            for (int half = 0; half < 2; ++half) {
                __syncthreads();
                if (half == 0 && tid < 256) { const int wq = tid >> 4, wc = tid & 15;
                    *(LAS f32x4*)(wl + wq * WPB + wc * 16) = *(const f32x4*)(WIDX + (size_t)(t0 + wq) * IDX_H + wc * 4); }
#pragma unroll
                for (int g = 0; g < 2; ++g) { v4u r[8];
#pragma unroll
                    for (int i = 0; i < 8; ++i) { const int q = tid + 512 * (g * 8 + i), hh = q >> 8, qq = (q >> 4) & 15, ch = q & 15;
                        r[i] = *(const v4u*)(Q2 + (size_t)(t0 + qq) * N2 + A_WIDTH + (half * QH + hh) * IDX_D + ch * 8); }
#pragma unroll
                    for (int i = 0; i < 8; ++i) { const int q = tid + 512 * (g * 8 + i);
                        *(LAS v4u*)(c.lds + (q >> 4) * QPB + (q & 15) * 16) = r[i]; } }
                LDS_WAIT(); __syncthreads();
                for (int item = w; item < nitems; item += 8) {
                    const int s0 = b * SEQ + item * 64;
                    bf16x8 kf[4][4];
#pragma unroll
                    for (int mi = 0; mi < 4; ++mi)
#pragma unroll
                        for (int ks = 0; ks < 4; ++ks) kf[mi][ks] = *(const bf16x8*)(P1 + (size_t)(s0 + 16 * mi + fr) * N1 + C_KI + 32 * ks + 8 * fq);
                    f32x4 sc[4];
                    float* scp = SC + (size_t)(t0 + fr) * SEQ + item * 64 + 4 * fq;
                    if (half) {
#pragma unroll
                        for (int mi = 0; mi < 4; ++mi) sc[mi] = *(const f32x4*)(scp + 16 * mi); }
                    else {
#pragma unroll
                        for (int mi = 0; mi < 4; ++mi) sc[mi] = (f32x4){0.f, 0.f, 0.f, 0.f}; }
                    __builtin_amdgcn_s_waitcnt(0x0F70);
                    const LAS unsigned char* wb = wl + fr * WPB + half * QH * 4;
                    const LAS unsigned char* qb = c.lds + fr * QPB + fq * 16;
#define SC_MM(A, hh) do { bf16x8 qf[4]; _Pragma("unroll") for (int ks = 0; ks < 4; ++ks) qf[ks] = *(const LAS bf16x8*)(buf + (hh) * 16 * QPB + ks * 64); \
                _Pragma("unroll") for (int mi = 0; mi < 4; ++mi) A[mi] = (f32x4){0.f, 0.f, 0.f, 0.f}; \
                _Pragma("unroll") for (int ks = 0; ks < 4; ++ks) _Pragma("unroll") for (int mi = 0; mi < 4; ++mi) A[mi] = __builtin_amdgcn_mfma_f32_16x16x32_bf16(kf[mi][ks], qf[ks], A[mi], 0, 0, 0); } while (0)
#define SC_EPI(A, hh) do { _Pragma("unroll") for (int mi = 0; mi < 4; ++mi) _Pragma("unroll") for (int j = 0; j < 4; ++j) sc[mi][j] += wv[hh] * __int_as_float(max(__float_as_int(A[mi][j]), 0)); } while (0)
#define SC_PIPE() do { _Pragma("unroll") for (int _q = 0; _q < 16; ++_q) { __builtin_amdgcn_sched_group_barrier(0x8, 1, 0); __builtin_amdgcn_sched_group_barrier(0x2, 2, 0); } } while (0)
                    for (int hg = 0; hg < QH / 4; ++hg) {
                        const LAS unsigned char* buf = qb + hg * 4 * 16 * QPB;
                        const f32x4 wv = *(const LAS f32x4*)(wb + hg * 16);
                        f32x4 a0[4], a1[4];
                        SC_MM(a0, 0);
                        SC_MM(a1, 1); SC_EPI(a0, 0); SC_PIPE();
                        SC_MM(a0, 2); SC_EPI(a1, 1); SC_PIPE();
                        SC_MM(a1, 3); SC_EPI(a0, 2); SC_PIPE();
                        SC_EPI(a1, 3);
                    }
#undef SC_MM
#undef SC_EPI
#undef SC_PIPE
#pragma unroll
                    for (int mi = 0; mi < 4; ++mi) *(f32x4*)(scp + 16 * mi) = sc[mi];
                }
            }
        }
    }
    __syncthreads();
}

template <int N> __device__ __forceinline__ void bitonic_merge_desc(unsigned (&a)[N]) {
#pragma unroll
    for (int j = N >> 1; j > 0; j >>= 1)
#pragma unroll
        for (int i = 0; i < N; ++i) { const int l = i ^ j; if (l > i) { const unsigned hi = max(a[i], a[l]), lo = min(a[i], a[l]); a[i] = hi; a[l] = lo; } }
}
template <int N> __device__ __forceinline__ void bitonic_sort_desc(unsigned (&a)[N]) {
#pragma unroll
    for (int k = 2; k <= N; k <<= 1)
#pragma unroll
        for (int j = k >> 1; j > 0; j >>= 1)
#pragma unroll
            for (int i = 0; i < N; ++i) { const int l = i ^ j; if (l > i) { const bool desc = ((i & k) == 0) || (k == N);
                    const unsigned hi = max(a[i], a[l]), lo = min(a[i], a[l]); a[i] = desc ? hi : lo; a[l] = desc ? lo : hi; } }
}
template <int NV> __device__ __forceinline__ void top16_of_32(const unsigned (&src)[NV], int o, unsigned (&t)[16]) {
    unsigned A[16], B[16];
#pragma unroll
    for (int i = 0; i < 16; ++i) { A[i] = src[o + i]; B[i] = src[o + 16 + i]; }
    bitonic_sort_desc<16>(A); bitonic_sort_desc<16>(B);
#pragma unroll
    for (int i = 0; i < 16; ++i) t[i] = max(A[i], B[15 - i]);
    bitonic_merge_desc<16>(t);
}
__device__ __forceinline__ void ph_topk(const Params& p, const Ctx& c) {
    const float* SC = (const float*)(p.ws + WS_SC); int* SEL = (int*)(p.ws + WS_SEL); int* CNT = (int*)(p.ws + WS_CNT);
    const int lane = c.lane; const unsigned long long lt_mask = (1ull << lane) - 1ull;
    for (int t = c.gw; t < T; t += c.ngw) {
        const int pos = t % SEQ, qc = pos / CHUNK, nadm = (qc + 1) * CHUNK;
        int* so = SEL + (size_t)t * TOPK;
        if (nadm <= TOPK) { for (int i = lane; i < nadm; i += 64) so[i] = i; if (lane == 0) CNT[t] = nadm; continue; }
        unsigned key[32];
        const float* sr = SC + (size_t)t * SEQ;
#pragma unroll
        for (int j = 0; j < 32; ++j) { unsigned k = 0u; if (j <= qc) { const unsigned bits = __float_as_uint(sr[lane + 64 * j]); k = (bits & 0x80000000u) ? ~bits : (bits | 0x80000000u); } key[j] = k; }
        unsigned thr = 0u; bool full = true;
        { unsigned t16[16]; top16_of_32<32>(key, 0, t16);
          for (int bit = 31; bit >= 0; --bit) { const unsigned cand = thr | (1u << bit); int cnt = 0;
#pragma unroll
              for (int j = 0; j < 16; ++j) cnt += __popcll(__ballot(t16[j] >= cand));
              if (cnt >= TOPK) { thr = cand; if (cnt == TOPK) break; } }
          full = __ballot(t16[15] >= thr) != 0ull; }
        if (full) { thr = 0u;
        for (int bit = 31; bit >= 0; --bit) { const unsigned cand = thr | (1u << bit); int cnt = 0;
#pragma unroll
            for (int j = 0; j < 22; ++j) cnt += __popcll(__ballot(key[j] >= cand));
            int cl = 0;
#pragma unroll
            for (int j = 22; j < 32; ++j) cl += (key[j] >= cand) ? 1 : 0;
#pragma unroll
            for (int o = 1; o < 64; o <<= 1) cl += __shfl_xor(cl, o);
            cnt += cl;
            if (cnt >= TOPK) { thr = cand; if (cnt == TOPK) break; } } }
        int ngt = 0;
#pragma unroll
        for (int j = 0; j < 32; ++j) ngt += __popcll(__ballot(key[j] > thr));
        const int need = TOPK - ngt; int base = 0, eqt = 0;
#pragma unroll
        for (int j = 0; j < 32; ++j) {
            const unsigned long long mg = __ballot(key[j] > thr), me = __ballot(key[j] == thr);
            const int erank = __popcll(me & lt_mask) + eqt; const bool esel = (key[j] == thr) && (erank < need);
            const unsigned long long ms = mg | __ballot(esel);
            if ((ms >> lane) & 1ull) so[base + __popcll(ms & lt_mask)] = lane + 64 * j;
            base += __popcll(ms); eqt += __popcll(me);
        }
        if (lane == 0) CNT[t] = TOPK;
    }
}

__device__ __forceinline__ int t5_bucket(int rel) {
    const int n = rel < 0 ? -rel : rel; int bk;
    if (n < 8) bk = n; else bk = 8 + min(7, 31 - __clz((int)((unsigned)(n * n) >> 6)));
    return (rel > 0 ? 16 : 0) + bk;
}
__device__ __forceinline__ bf16x4 tr_read4(unsigned addr, int) { bf16x4 r; asm volatile("ds_read_b64_tr_b16 %0, %1\n\ts_waitcnt lgkmcnt(0)" : "=&v"(r) : "v"(addr) : "memory"); return r; }
#define TR_READ(dst, addr, OFF) asm volatile("ds_read_b64_tr_b16 %0, %1 offset:%2" : "=&v"(dst) : "v"(addr), "i"(OFF) : "memory")

constexpr int KV_PITCH = 1056;
constexpr int ATT_LDS_END = 8 * 16 * KV_PITCH + 64 + 2048;
__device__ __forceinline__ void ph_attn(const Params& p, const Ctx& c) {
    const bf16* CKV = (const bf16*)(p.ws + WS_CKV); const bf16* QL = (const bf16*)(p.ws + WS_QL); const int* SEL = (const int*)(p.ws + WS_SEL); const int* CNT = (const int*)(p.ws + WS_CNT);
    bf16* OL = (bf16*)(p.ws + WS_OLAT);
    const int lane = c.lane, fr = lane & 15, fq = lane >> 4;
    const int cw = c.wave & 3;
    LAS unsigned char* buf0 = c.lds + cw * (32 * KV_PITCH);
    const unsigned bufa = (unsigned)(size_t)buf0;
    const unsigned tr_base0 = bufa + (unsigned)((4 * fq + (fr >> 2)) * KV_PITCH + (fr & 3) * 8);
    const float t5b_scale = 0.08838834764831845f;
    LAS float* t5l = (LAS float*)(c.lds + 8 * 16 * KV_PITCH + 64);
    unsigned* ctl = (unsigned*)(p.ws + WS_CTL);
    LAS unsigned* xm = (LAS unsigned*)(c.lds + 8 * 16 * KV_PITCH);
    if (c.tid == 0) { const unsigned x = xb_xcc_id(); unsigned pre = 0, tot = 0;
        for (unsigned j = 0; j < 16; ++j) { const unsigned n = xb_ld(&ctl[XB_XCNT(j)]); pre += (j < x) ? n : 0u; tot += n; }
        const bool ok = (tot == (unsigned)c.nb) && (T % (c.nb * 4) == 0);
        unsigned rk = 0; if (ok) rk = xb_add(&ctl[XB_ATT_RANK + 64 * x], 1u);
        xm[0] = ok ? (pre + rk) : 0xffffffffu; }
    t5l[c.tid] = p.t5[c.tid];
    __syncthreads();
    const unsigned vbx = xm[0]; const bool xmap = (vbx != 0xffffffffu);
    const int naw = c.nb * 4;
    if (c.wave >= 4) { for (int it = c.bid * 4 + (c.wave - 4); it < 1024; it += naw) adaln_late(p, it, c.lane); convert_late_weights(p, (LAS float*)(c.lds + ATT_LDS_END + (c.wave - 4) * 4224), c.lane, c.bid * 4 + (c.wave - 4), naw); convert_expert_rows(p, c, c.bid * 4 + (c.wave - 4), naw); }
    if (c.wave < 4)
    for (int it = c.bid * 4 + cw; it < T; it += naw) {
        int t = it;
        if (xmap) { const int base = (int)vbx * 4 + cw;
            const int bsz = naw / NB, q = it / naw;
            t = (base / bsz) * SEQ + (base % bsz) + q * bsz; }
        const int b = t / SEQ, pos = t % SEQ;
        const int cnt = CNT[t];
        int s0 = 0, s1 = 0, s2 = 0, s3 = 0;
        if (lane < cnt) s0 = SEL[(size_t)t * TOPK + lane];
        if (lane + 64 < cnt) s1 = SEL[(size_t)t * TOPK + 64 + lane];
        if (lane + 128 < cnt) s2 = SEL[(size_t)t * TOPK + 128 + lane];
        if (lane + 192 < cnt) s3 = SEL[(size_t)t * TOPK + 192 + lane];
        const bf16* kvb = CKV + (size_t)(b * SEQ) * A_KVR + lane * 8;
        const int nch = cnt >> 4;
#define ATT_GATHER(ch_) do { const int _c = (ch_); const int _sj = (_c < 4) ? s0 : (_c < 8) ? s1 : (_c < 12) ? s2 : s3; const int _lb = (_c & 3) * 16; \
            LAS unsigned char* _b = buf0 + (_c & 1) * (16 * KV_PITCH); \
            _Pragma("unroll") for (int r = 0; r < 16; ++r) { const int idx = __builtin_amdgcn_readlane(_sj, _lb + r); \
                __builtin_amdgcn_global_load_lds((const unsigned*)(kvb + (size_t)idx * A_KVR), (LAS unsigned*)(_b + r * KV_PITCH), 16, 0, 0); } } while (0)
        ATT_GATHER(0);
        bf16x8 qf[16];
#pragma unroll
        for (int ks = 0; ks < 16; ++ks) qf[ks] = *(const bf16x8*)(QL + (size_t)t * 8192 + fr * 512 + ks * 32 + fq * 8);
        f32x4 acc[32];
#pragma unroll
        for (int mt = 0; mt < 32; ++mt) acc[mt] = (f32x4){0.f, 0.f, 0.f, 0.f};
        float m_run = -INFINITY, l_run = 0.f;
        float bias[4];
#define ATT_BIAS(ch_) do { const int _c = (ch_); const int _sj = (_c < 4) ? s0 : (_c < 8) ? s1 : (_c < 12) ? s2 : s3; const int _lb = (_c & 3) * 16; \
            _Pragma("unroll") for (int j = 0; j < 4; ++j) { const int kidx = __shfl(_sj, _lb + 4 * fq + j); bias[j] = t5l[t5_bucket(kidx - pos) * A_HEADS + fr]; } } while (0)
        for (int ch = 0; ch < nch; ++ch) {
            ATT_BIAS(ch);
            if (ch + 1 < nch) { ATT_GATHER(ch + 1); asm volatile("s_waitcnt vmcnt(16)" ::: "memory"); } else { asm volatile("s_waitcnt vmcnt(0)" ::: "memory"); }
            LAS unsigned char* buf = buf0 + (ch & 1) * (16 * KV_PITCH);
            const unsigned tr_base = tr_base0 + (unsigned)((ch & 1) * (16 * KV_PITCH));
            f32x4 sa = {0.f, 0.f, 0.f, 0.f}, sb = sa;
#pragma unroll
            for (int ks = 0; ks < 16; ks += 2) {
                const bf16x8 a0 = *(const LAS bf16x8*)(buf + fr * KV_PITCH + (ks + 0) * 64 + fq * 16), a1 = *(const LAS bf16x8*)(buf + fr * KV_PITCH + (ks + 1) * 64 + fq * 16);
                sa = __builtin_amdgcn_mfma_f32_16x16x32_bf16(a0, qf[ks + 0], sa, 0, 0, 0); sb = __builtin_amdgcn_mfma_f32_16x16x32_bf16(a1, qf[ks + 1], sb, 0, 0, 0); }
            const f32x4 s = sa + sb;
            float lg[4]; float mc = -INFINITY;
#pragma unroll
            for (int j = 0; j < 4; ++j) { lg[j] = s[j] * t5b_scale + bias[j]; mc = fmaxf(mc, lg[j]); }
            mc = fmaxf(mc, __shfl_xor(mc, 16)); mc = fmaxf(mc, __shfl_xor(mc, 32));
            if (__ballot(mc > m_run + 8.0f)) { const float m_new = fmaxf(m_run, mc); const float alpha = __expf(m_run - m_new); l_run *= alpha; m_run = m_new;
#pragma unroll
                for (int mt = 0; mt < 32; ++mt) acc[mt] *= alpha; }
            float pe[4]; float ps = 0.f;
#pragma unroll
            for (int j = 0; j < 4; ++j) { pe[j] = __expf(lg[j] - m_run); ps += pe[j]; }
            l_run += ps;
            v2u pw; pw.x = cvt_pk_bf16(pe[0], pe[1]); pw.y = cvt_pk_bf16(pe[2], pe[3]);
            const unsigned qx = (unsigned)__shfl_xor((int)pw.x, 32), qy = (unsigned)__shfl_xor((int)pw.y, 32);
            const bool lowg = fq < 2;
            const v4u pb4 = lowg ? (v4u){pw.x, pw.y, qx, qy} : (v4u){0u, 0u, 0u, 0u};
            const bf16x8 pb = __builtin_bit_cast(bf16x8, pb4);
            const unsigned tr2 = tr_base + (unsigned)((lowg ? 8 : -8) * KV_PITCH);
            bf16x4 ta[2], tb[2], ua[2], ub[2];
#define ATT_TR(d1, d2, g) do { _Pragma("unroll") for (int i = 0; i < 2; ++i) { TR_READ(d1[i], tr_base, ((g) * 2 + i) * 32); TR_READ(d2[i], tr2, ((g) * 2 + i) * 32); } } while (0)
#define ATT_MM(s1, s2, g) do { _Pragma("unroll") for (int i = 0; i < 2; ++i) acc[(g) * 2 + i] = __builtin_amdgcn_mfma_f32_16x16x32_bf16(__builtin_shufflevector(s1[i], s2[i], 0, 1, 2, 3, 4, 5, 6, 7), pb, acc[(g) * 2 + i], 0, 0, 0); } while (0)
            ATT_TR(ta, ua, 0);
#pragma unroll
            for (int g = 0; g < 16; g += 2) {
                ATT_TR(tb, ub, g + 1);
                asm volatile("s_waitcnt lgkmcnt(4)" : "+v"(ta[0]), "+v"(ta[1]), "+v"(ua[0]), "+v"(ua[1]) :: "memory");
                ATT_MM(ta, ua, g);
                if (g + 2 < 16) ATT_TR(ta, ua, g + 2);
                if (g + 2 < 16) asm volatile("s_waitcnt lgkmcnt(4)" : "+v"(tb[0]), "+v"(tb[1]), "+v"(ub[0]), "+v"(ub[1]) :: "memory");
                else asm volatile("s_waitcnt lgkmcnt(0)" : "+v"(tb[0]), "+v"(tb[1]), "+v"(ub[0]), "+v"(ub[1]) :: "memory");
                ATT_MM(tb, ub, g + 1);
            }
#undef ATT_TR
#undef ATT_MM
            asm volatile("" ::: "memory");
        }
#undef ATT_BIAS
#undef ATT_GATHER
        float lt = l_run; lt += __shfl_xor(lt, 16); lt += __shfl_xor(lt, 32);
        const float il = 1.0f / lt;
        bf16* orow = OL + (size_t)t * 8192 + fr * 512 + 4 * fq;
#pragma unroll
        for (int mt = 0; mt < 32; ++mt) { v2u w; w.x = cvt_pk_bf16(acc[mt][0] * il, acc[mt][1] * il); w.y = cvt_pk_bf16(acc[mt][2] * il, acc[mt][3] * il); *(v2u*)(orow + 16 * mt) = w; }
    }
    __syncthreads();
}

#define TR_PAIR(dst, addr, PITCH4) do { bf16x4 _lo, _hi; \
    asm volatile("ds_read_b64_tr_b16 %0, %2\n\tds_read_b64_tr_b16 %1, %2 offset:%3\n\ts_waitcnt lgkmcnt(0)" : "=&v"(_lo), "=&v"(_hi) : "v"(addr), "i"(PITCH4) : "memory"); \
    dst = __builtin_shufflevector(_lo, _hi, 0, 1, 2, 3, 4, 5, 6, 7); } while (0)

constexpr size_t WS_SN = 1464 * MiB;
__device__ __forceinline__ void ph_ret_state(const Params& p, const Ctx& c) {
    const bf16* P1 = (const bf16*)(p.ws + WS_P1); bf16* SN = (bf16*)(p.ws + WS_SN);
    constexpr int KPB = 272, VPB = 80;
    LAS unsigned char* ktb = c.lds; LAS unsigned char* vtb = c.lds + 2 * 64 * KPB;
    const int tid = c.tid, lane = c.lane, w = c.wave, fr = lane & 15, fq = lane >> 4;
    for (int u = c.bid; u < NB * R_HEADS * 8; u += c.nb) {
        const int b = u / 64, h = (u / 8) % 8, vsl = u % 8;
        const float gam = 1.0f - exp2f(-5.0f - (float)h), lgm = logf(gam), dec64 = __expf(64.0f * lgm);
        f32x4 acc[2] = {{0.f, 0.f, 0.f, 0.f}, {0.f, 0.f, 0.f, 0.f}};
        const int kr0 = tid >> 4, kc0 = tid & 15;
        const int vr = tid >> 2, vc = tid & 3;
        const bf16* kbase = P1 + (size_t)(b * SEQ) * N1 + C_RK + h * 128 + kc0 * 8;
        const bf16* vbase = P1 + (size_t)(b * SEQ) * N1 + C_RV + h * 256 + vsl * 32 + vc * 8;
        const float sc0 = __expf((float)(63 - kr0) * lgm), sc1 = __expf((float)(31 - kr0) * lgm);
        v4u ka, kb, va = {0u, 0u, 0u, 0u};
        ka = *(const v4u*)(kbase + (size_t)kr0 * N1); kb = *(const v4u*)(kbase + (size_t)(kr0 + 32) * N1); if (tid < 256) va = *(const v4u*)(vbase + (size_t)vr * N1);
        __syncthreads();
        for (int n = 0; n < SEQ / CHUNK; ++n) {
            LAS unsigned char* kt = ktb + (n & 1) * 64 * KPB; LAS unsigned char* vt = vtb + (n & 1) * 64 * VPB;
            { v4u o; o.x = cvt_pk_bf16(bflo(ka.x) * sc0, bfhi(ka.x) * sc0); o.y = cvt_pk_bf16(bflo(ka.y) * sc0, bfhi(ka.y) * sc0); o.z = cvt_pk_bf16(bflo(ka.z) * sc0, bfhi(ka.z) * sc0); o.w = cvt_pk_bf16(bflo(ka.w) * sc0, bfhi(ka.w) * sc0);
              *(LAS v4u*)(kt + kr0 * KPB + kc0 * 16) = o;
              o.x = cvt_pk_bf16(bflo(kb.x) * sc1, bfhi(kb.x) * sc1); o.y = cvt_pk_bf16(bflo(kb.y) * sc1, bfhi(kb.y) * sc1); o.z = cvt_pk_bf16(bflo(kb.z) * sc1, bfhi(kb.z) * sc1); o.w = cvt_pk_bf16(bflo(kb.w) * sc1, bfhi(kb.w) * sc1);
              *(LAS v4u*)(kt + (kr0 + 32) * KPB + kc0 * 16) = o;
              if (tid < 256) *(LAS v4u*)(vt + vr * VPB + vc * 16) = va; }
            if (n + 1 < SEQ / CHUNK) { const size_t ro = (size_t)((n + 1) * CHUNK) * N1;
                ka = *(const v4u*)(kbase + ro + (size_t)kr0 * N1); kb = *(const v4u*)(kbase + ro + (size_t)(kr0 + 32) * N1); if (tid < 256) va = *(const v4u*)(vbase + ro + (size_t)vr * N1); }
            { bf16* sp = SN + ((size_t)((b * R_HEADS + h) * 32 + n) * 256 + vsl * 32 + fr) * 128 + 16 * w + 4 * fq;
#pragma unroll
              for (int nt = 0; nt < 2; ++nt) { v2u o; o.x = cvt_pk_bf16(acc[nt][0], acc[nt][1]); o.y = cvt_pk_bf16(acc[nt][2], acc[nt][3]); *(v2u*)(sp + (size_t)(16 * nt) * 128) = o; acc[nt] *= dec64; } }
            LDS_WAIT(); __syncthreads();
            const unsigned ka_addr = (unsigned)(size_t)kt + (unsigned)((8 * fq + (fr >> 2)) * KPB + (16 * w + 4 * (fr & 3)) * 2);
            const unsigned va_addr = (unsigned)(size_t)vt + (unsigned)((8 * fq + (fr >> 2)) * VPB + (4 * (fr & 3)) * 2);
#pragma unroll
            for (int ks = 0; ks < 2; ++ks) { bf16x8 af, b0, b1;
                TR_PAIR(af, ka_addr + ks * 32 * KPB, 4 * KPB); TR_PAIR(b0, va_addr + ks * 32 * VPB, 4 * VPB); TR_PAIR(b1, va_addr + ks * 32 * VPB + 32, 4 * VPB);
                acc[0] = __builtin_amdgcn_mfma_f32_16x16x32_bf16(af, b0, acc[0], 0, 0, 0); acc[1] = __builtin_amdgcn_mfma_f32_16x16x32_bf16(af, b1, acc[1], 0, 0, 0); }
        }
        __syncthreads();
    }
}
__device__ __forceinline__ void ph_ret_out(const Params& p, const Ctx& c) {
    const bf16* P1 = (const bf16*)(p.ws + WS_P1); const bf16* SN = (const bf16*)(p.ws + WS_SN); unsigned char* Y8 = p.ws + WS_YCAT;
    constexpr int QPB = 272, VPB = 528, APB = 144;
    LAS unsigned char* qt = c.lds; LAS unsigned char* kt = qt + 64 * QPB; LAS unsigned char* vt = kt + 64 * QPB; LAS unsigned char* at = vt + 64 * VPB;
    LAS float* red = (LAS float*)(at + 64 * APB);
    const int tid = c.tid, lane = c.lane, w = c.wave, fr = lane & 15, fq = lane >> 4;
    for (int u = c.bid; u < NB * 32 * R_HEADS; u += c.nb) {
        const int b = u / 256, n = (u / 8) % 32, h = u % 8;
        const float gam = 1.0f - exp2f(-5.0f - (float)h), lgm = logf(gam);
        const size_t t0 = (size_t)b * SEQ + n * CHUNK;
        __syncthreads();
        for (int i = tid; i < 64 * 16; i += NTHR) { const int l = i >> 4, ch = i & 15;
            *(LAS v4u*)(qt + l * QPB + ch * 16) = *(const v4u*)(P1 + (t0 + l) * N1 + C_RQ + h * 128 + ch * 8);
            *(LAS v4u*)(kt + l * QPB + ch * 16) = *(const v4u*)(P1 + (t0 + l) * N1 + C_RK + h * 128 + ch * 8); }
        for (int i = tid; i < 64 * 32; i += NTHR) { const int l = i >> 5, ch = i & 31; *(LAS v4u*)(vt + l * VPB + ch * 16) = *(const v4u*)(P1 + (t0 + l) * N1 + C_RV + h * 256 + ch * 8); }
        __syncthreads();
        { const int pt = w & 3, lt0 = 2 * (w >> 2);
          f32x4 a0 = {0.f, 0.f, 0.f, 0.f}, a1 = a0;
#pragma unroll
          for (int ks = 0; ks < 4; ++ks) { const bf16x8 qf = *(const LAS bf16x8*)(qt + (16 * pt + fr) * QPB + ks * 64 + fq * 16);
              const bf16x8 k0 = *(const LAS bf16x8*)(kt + (16 * lt0 + fr) * QPB + ks * 64 + fq * 16), k1 = *(const LAS bf16x8*)(kt + (16 * lt0 + 16 + fr) * QPB + ks * 64 + fq * 16);
              a0 = __builtin_amdgcn_mfma_f32_16x16x32_bf16(k0, qf, a0, 0, 0, 0); a1 = __builtin_amdgcn_mfma_f32_16x16x32_bf16(k1, qf, a1, 0, 0, 0); }
          const int pos = 16 * pt + fr;
#pragma unroll
          for (int j = 0; j < 4; ++j) { const int l0 = 16 * lt0 + 4 * fq + j, l1 = l0 + 16;
              a0[j] = (pos >= l0) ? a0[j] * __expf((float)(pos - l0) * lgm) : 0.f; a1[j] = (pos >= l1) ? a1[j] * __expf((float)(pos - l1) * lgm) : 0.f; }
          v2u o; o.x = cvt_pk_bf16(a0[0], a0[1]); o.y = cvt_pk_bf16(a0[2], a0[3]); *(LAS v2u*)(at + pos * APB + (16 * lt0 + 4 * fq) * 2) = o;
          o.x = cvt_pk_bf16(a1[0], a1[1]); o.y = cvt_pk_bf16(a1[2], a1[3]); *(LAS v2u*)(at + pos * APB + (16 * lt0 + 16 + 4 * fq) * 2) = o; }
        f32x4 acc[2][4];
#pragma unroll
        for (int mi = 0; mi < 2; ++mi)
#pragma unroll
            for (int pt = 0; pt < 4; ++pt) acc[mi][pt] = (f32x4){0.f, 0.f, 0.f, 0.f};
        { const bf16* sp = SN + ((size_t)((b * R_HEADS + h) * 32 + n) * 256 + 32 * w + fr) * 128 + 8 * fq;
#pragma unroll
          for (int ks = 0; ks < 4; ++ks) { const bf16x8 s0 = *(const bf16x8*)(sp + ks * 32), s1 = *(const bf16x8*)(sp + 16 * 128 + ks * 32);
#pragma unroll
              for (int pt = 0; pt < 4; ++pt) { const bf16x8 qf = *(const LAS bf16x8*)(qt + (16 * pt + fr) * QPB + ks * 64 + fq * 16);
                  acc[0][pt] = __builtin_amdgcn_mfma_f32_16x16x32_bf16(s0, qf, acc[0][pt], 0, 0, 0); acc[1][pt] = __builtin_amdgcn_mfma_f32_16x16x32_bf16(s1, qf, acc[1][pt], 0, 0, 0); } } }
#pragma unroll
        for (int pt = 0; pt < 4; ++pt) { const float dq = __expf((float)(16 * pt + fr + 1) * lgm); acc[0][pt] *= dq; acc[1][pt] *= dq; }
        LDS_WAIT(); __syncthreads();
        { const unsigned v_addr = (unsigned)(size_t)vt + (unsigned)((8 * fq + (fr >> 2)) * VPB + (32 * w + 4 * (fr & 3)) * 2);
#pragma unroll
          for (int ks = 0; ks < 2; ++ks) { bf16x8 v0, v1; TR_PAIR(v0, v_addr + ks * 32 * VPB, 4 * VPB); TR_PAIR(v1, v_addr + ks * 32 * VPB + 32, 4 * VPB);
#pragma unroll
              for (int pt = 0; pt < 4; ++pt) { const bf16x8 af = *(const LAS bf16x8*)(at + (16 * pt + fr) * APB + ks * 64 + fq * 16);
                  acc[0][pt] = __builtin_amdgcn_mfma_f32_16x16x32_bf16(v0, af, acc[0][pt], 0, 0, 0); acc[1][pt] = __builtin_amdgcn_mfma_f32_16x16x32_bf16(v1, af, acc[1][pt], 0, 0, 0); } } }
#pragma unroll
        for (int pt = 0; pt < 4; ++pt) { float s = 0.f;
#pragma unroll
            for (int mi = 0; mi < 2; ++mi)
#pragma unroll
                for (int j = 0; j < 4; ++j) s += acc[mi][pt][j] * acc[mi][pt][j];
            s += __shfl_xor(s, 16); s += __shfl_xor(s, 32);
            if (lane < 16) red[w * 64 + 16 * pt + lane] = s; }
        LDS_WAIT(); __syncthreads();
#pragma unroll
        for (int pt = 0; pt < 4; ++pt) { const int pos = 16 * pt + fr; float ss = 0.f;
#pragma unroll
            for (int ww = 0; ww < 8; ++ww) ss += red[ww * 64 + pos];
            const float rstd = 1.0f / sqrtf(ss * (1.0f / R_V) + EPS);
#pragma unroll
            for (int mi = 0; mi < 2; ++mi) { const int dv = 32 * w + 16 * mi + 4 * fq;
                const f32x4 g = *(const f32x4*)(p.g_ret + h * 256 + dv);
                const v2u rg = *(const v2u*)(P1 + (t0 + pos) * N1 + C_RG + h * 256 + dv);
                const float r0 = bflo(rg.x), r1 = bfhi(rg.x), r2 = bflo(rg.y), r3 = bfhi(rg.y);
                const float rs = rstd * 16.0f; int q = 0;
                q = PK_FP8(r0 * sigmoidf_(r0) * acc[mi][pt][0] * rs * g.x, r1 * sigmoidf_(r1) * acc[mi][pt][1] * rs * g.y, q, false);
                q = PK_FP8(r2 * sigmoidf_(r2) * acc[mi][pt][2] * rs * g.z, r3 * sigmoidf_(r3) * acc[mi][pt][3] * rs * g.w, q, true);
                *(unsigned*)(Y8 + (t0 + pos) * D + A_WIDTH + h * 256 + dv) = (unsigned)q; } }
    }
    __syncthreads();
}

__device__ __forceinline__ unsigned fkey(float f) { const unsigned b = __float_as_uint(f); return (b & 0x80000000u) ? ~b : (b | 0x80000000u); }
typedef __bf16 bf16x2_r __attribute__((ext_vector_type(2)));
template <int NV> __device__ __forceinline__ unsigned tok_thr16(const unsigned (&k)[NV]) {
    unsigned t[16]; top16_of_32<NV>(k, 0, t);
    if (NV == 64) { unsigned t2[16]; top16_of_32<NV>(k, 32, t2);
#pragma unroll
        for (int i = 0; i < 16; ++i) t[i] = max(t[i], t2[15 - i]);
        bitonic_merge_desc<16>(t); }
    { unsigned q[16];
#pragma unroll
      for (int i = 0; i < 16; ++i) q[i] = (unsigned)__shfl_xor((int)t[15 - i], 16);
#pragma unroll
      for (int i = 0; i < 16; ++i) t[i] = max(t[i], q[i]);
      bitonic_merge_desc<16>(t); }
    unsigned thr = 0xffffffffu;
    { unsigned q[16];
#pragma unroll
      for (int i = 0; i < 16; ++i) q[i] = (unsigned)__shfl_xor((int)t[15 - i], 32);
#pragma unroll
      for (int i = 0; i < 16; ++i) thr = min(thr, max(t[i], q[i])); }
    return thr;
}
__device__ __forceinline__ void ph_peer_route(const Params& p, const Ctx& c) {
    const bf16* PQ = (const bf16*)(p.ws + WS_PQ); const bf16* SK = (const bf16*)(p.ws + WS_SK); int* EID = (int*)(p.ws + WS_EID); float* GATE = (float*)(p.ws + WS_GATE);
    constexpr int KP = 272;
    LAS unsigned char* sk = c.lds;
    LAS float* wl = (LAS float*)(c.lds + 2 * 128 * KP) + c.wave * 1536;
    LAS float* v1l = wl; LAS int* i1l = (LAS int*)(wl + 256); LAS float* v2l = wl + 512; LAS int* i2l = (LAS int*)(wl + 768); LAS float* tvl = wl + 1024; LAS int* tel = (LAS int*)(wl + 1280);
    const int lane = c.lane, fr = lane & 15, fq = lane >> 4;
    __syncthreads();
    for (int i = c.tid; i < 2 * 128 * 16; i += NTHR) { const int r = i >> 4, ch = i & 15; *(LAS v4u*)(sk + r * KP + ch * 16) = *(const v4u*)(SK + r * 128 + ch * 8); }
    __syncthreads();
    for (int u = c.gw; u < (T / 16) * P_HEADS; u += c.ngw) {
        const int tgp = u / P_HEADS, h = u % P_HEADS, t = tgp * 16 + fr;
        unsigned ka[32], kb[32]; float sva[32], svb[32];
#pragma unroll
        for (int half = 0; half < 2; ++half) {
            f32x4 acc[8];
#pragma unroll
            for (int mt = 0; mt < 8; ++mt) acc[mt] = (f32x4){0.f, 0.f, 0.f, 0.f};
#pragma unroll
            for (int ks = 0; ks < 4; ++ks) { const bf16x8 qf = *(const bf16x8*)(PQ + (size_t)t * 2048 + h * 256 + half * 128 + ks * 32 + fq * 8);
#pragma unroll
                for (int mt = 0; mt < 8; ++mt) { const bf16x8 kf = *(const LAS bf16x8*)(sk + (half * 128 + 16 * mt + fr) * KP + ks * 64 + fq * 16); acc[mt] = __builtin_amdgcn_mfma_f32_16x16x32_bf16(kf, qf, acc[mt], 0, 0, 0); } }
#pragma unroll
            for (int mt = 0; mt < 8; ++mt)
#pragma unroll
                for (int j = 0; j < 4; ++j) { if (half == 0) { sva[mt * 4 + j] = acc[mt][j]; ka[mt * 4 + j] = fkey(acc[mt][j]); } else { svb[mt * 4 + j] = acc[mt][j]; kb[mt * 4 + j] = fkey(acc[mt][j]); } }
        }
#define ROUTE_EMIT(K, V, NV, thr, VL, IL, IDX) do { int ngl = 0, nel = 0; \
            _Pragma("unroll") for (int i = 0; i < NV; ++i) { ngl += (K[i] > thr) ? 1 : 0; nel += (K[i] == thr) ? 1 : 0; } \
            int pg = 0, pe = 0, ngt = 0; \
            _Pragma("unroll") for (int q = 0; q < 4; ++q) { const int cg = __shfl(ngl, fr + 16 * q), ce = __shfl(nel, fr + 16 * q); pg += (q < fq) ? cg : 0; pe += (q < fq) ? ce : 0; ngt += cg; } \
            const int need = P_TOPK - ngt; \
            _Pragma("unroll") for (int i = 0; i < NV; ++i) { int slot = -1; \
                if (K[i] > thr) { slot = pg; ++pg; } else if (K[i] == thr) { if (pe < need) slot = ngt + pe; ++pe; } \
                if (slot >= 0) { VL[fr * 16 + slot] = V[i]; IL[fr * 16 + slot] = IDX(i); } } } while (0)
#define KEYIDX(i) (16 * ((i) >> 2) + 4 * fq + ((i) & 3))
        { const unsigned ta = tok_thr16<32>(ka); ROUTE_EMIT(ka, sva, 32, ta, v1l, i1l, KEYIDX);
          const unsigned tb = tok_thr16<32>(kb); ROUTE_EMIT(kb, svb, 32, tb, v2l, i2l, KEYIDX); }
        LDS_WAIT();
        float cd[64]; unsigned ck[64];
        { const f32x4 va = *(const LAS f32x4*)(v1l + fr * 16 + 4 * fq);
#pragma unroll
          for (int bq = 0; bq < 4; ++bq) { const f32x4 vb = *(const LAS f32x4*)(v2l + fr * 16 + 4 * bq);
#pragma unroll
              for (int ai = 0; ai < 4; ++ai)
#pragma unroll
                  for (int bj = 0; bj < 4; ++bj) { const float v = va[ai] + vb[bj]; cd[ai * 16 + bq * 4 + bj] = v; ck[ai * 16 + bq * 4 + bj] = fkey(v); } } }
#define CANDEID(i) (i1l[fr * 16 + 4 * fq + ((i) >> 4)] * P_NK + i2l[fr * 16 + ((i) & 15)])
        { const unsigned tc = tok_thr16<64>(ck); ROUTE_EMIT(ck, cd, 64, tc, tvl, tel, CANDEID); }
#undef ROUTE_EMIT
#undef KEYIDX
#undef CANDEID
        LDS_WAIT();
        { const f32x4 tv = *(const LAS f32x4*)(tvl + fr * 16 + 4 * fq); const v4u te = *(const LAS v4u*)(tel + fr * 16 + 4 * fq);
          float mx = fmaxf(fmaxf(tv[0], tv[1]), fmaxf(tv[2], tv[3])); mx = fmaxf(mx, __shfl_xor(mx, 16)); mx = fmaxf(mx, __shfl_xor(mx, 32));
          f32x4 e; float sm = 0.f;
#pragma unroll
          for (int j = 0; j < 4; ++j) { e[j] = __expf(tv[j] - mx); sm += e[j]; }
          sm += __shfl_xor(sm, 16); sm += __shfl_xor(sm, 32);
          const float inv = 1.0f / sm;
          *(v4u*)(EID + (size_t)t * 128 + h * 16 + 4 * fq) = te; *(f32x4*)(GATE + (size_t)t * 128 + h * 16 + 4 * fq) = e * inv; }
        LDS_WAIT();
    }
    __syncthreads();
}
typedef __bf16 bf16x2_t __attribute__((ext_vector_type(2)));
typedef float v32f_t __attribute__((ext_vector_type(32))); typedef unsigned v6u_t __attribute__((ext_vector_type(6))); typedef __bf16 v32bf_t __attribute__((ext_vector_type(32)));
typedef unsigned v16u_t __attribute__((ext_vector_type(16)));
__device__ __forceinline__ void ld48(const unsigned char* ptr, int lane8, v6u_t& w0, v6u_t& w1) { const v4u a = *(const v4u*)ptr, c = *(const v4u*)(ptr + 2048); const v2u_t b0 = *(const v2u_t*)(ptr + 1024 - (lane8)), b1 = *(const v2u_t*)(ptr + 1536 - (lane8));
    w0 = (v6u_t){a.x, a.y, a.z, a.w, b0.x, b0.y}; w1 = (v6u_t){b1.x, b1.y, c.x, c.y, c.z, c.w}; }
#ifndef PG
#define PG 2
#endif
constexpr size_t WS_X1B = WS_MERGED;
constexpr size_t WS_DP = WS_P1, WS_CF = WS_P1 + 64 * MiB, WS_SS = WS_P1 + 68 * MiB;
#define XB_PEER_RANK(k) (5120 + 1024 * (k))
struct PeerMap { int s0, ns, tw, tstride; };
__device__ __forceinline__ PeerMap peer_map(const Params& p, const Ctx& c, int k) {
    unsigned* ctl = (unsigned*)(p.ws + WS_CTL); LAS unsigned* xm = (LAS unsigned*)(c.lds + 16384);
    __syncthreads();
    if (c.tid == 0) { const unsigned x = xb_xcc_id(); unsigned pre = 0, tot = 0; bool eq = true;
        for (unsigned j = 0; j < 16; ++j) { const unsigned n = xb_ld(&ctl[XB_XCNT(j)]); pre += (j < x) ? n : 0u; tot += n; eq = eq && (j < 8 ? n == 32u : n == 0u); }
        const bool ok = eq && (tot == (unsigned)c.nb) && (c.nb == 256) && (x < 8);
        unsigned rk = 0; if (ok) rk = xb_add(&ctl[XB_PEER_RANK(k) + 64 * x], 1u);
        xm[0] = (ok && rk < 32u) ? (x * 32u + rk) : 0xffffffffu; }
    __syncthreads();
    const unsigned v = xm[0]; PeerMap m;
    if (v != 0xffffffffu) { m.s0 = 2 * (int)(v >> 5); m.ns = 2; m.tw = (int)(v & 31u) * NWAVES + c.wave; m.tstride = 32 * NWAVES; }
    else { m.s0 = 0; m.ns = 16; m.tw = c.gw; m.tstride = c.ngw; }
    return m;
}
__device__ __forceinline__ v6u_t ld24o(const unsigned char* tab, unsigned e, unsigned ca, unsigned cb) { const unsigned oa = e * 192u + ca, ob = e * 192u + cb;
    const v4u a = *(const v4u*)(tab + (size_t)oa); const v2u_t b = *(const v2u_t*)(tab + (size_t)ob); return (v6u_t){a.x, a.y, a.z, a.w, b.x, b.y}; }
__device__ __forceinline__ v6u_t ld24(const unsigned char* row, int ch8) { const v4u a = *(const v4u*)(row + ch8 * 16); const v2u_t b = *(const v2u_t*)(row + 128 + ch8 * 8); return (v6u_t){a.x, a.y, a.z, a.w, b.x, b.y}; }
__device__ __forceinline__ void ph_peer_u(const Params& p, const Ctx& c) {
    const bf16* H = (const bf16*)(p.ws + WS_H); const int* EID = (const int*)(p.ws + WS_EID);
#ifdef PEER_PROBE
    const int emask = p.dummy ? (PEER_PROBE) : -1; float* DP = (float*)(p.ws + WS_DP + (p.dummy ? 128 * MiB : 0));
#else
    constexpr int emask = -1; float* DP = (float*)(p.ws + WS_DP);
#endif
    const PeerMap m = peer_map(p, c, 0);
    const int lane = c.lane, ch8 = lane & 7, grp = lane >> 3; const bool b2 = lane & 4, b1 = lane & 2, b0 = lane & 1;
    const int ntok = (m.tw < T) ? (T - m.tw + m.tstride - 1) / m.tstride : 0, nitems = m.ns * ntok;
    if (nitems == 0) return;
#define IT_S(k) (m.s0 + (k) / ntok)
#define IT_T(k) (m.tw + ((k) % ntok) * m.tstride)
    int ev[16], evn[16]; unsigned xpn[16]; f32x2 xf[16]; v6u_t A[4], B[4];
#define SU_IDX(EV, XP, s_, t_) do { _Pragma("unroll") for (int i = 0; i < 16; ++i) EV[i] = EID[(size_t)(t_) * 128 + 8 * i + grp] & emask; \
        _Pragma("unroll") for (int k = 0; k < 4; ++k) { const v4u a = *(const v4u*)(H + (size_t)(t_) * D + (s_) * 256 + ch8 * 32 + k * 8); XP[k * 4 + 0] = a.x; XP[k * 4 + 1] = a.y; XP[k * 4 + 2] = a.z; XP[k * 4 + 3] = a.w; } } while (0)
#define SU_LD(R, EV, TAB, i0) do { _Pragma("unroll") for (int j = 0; j < 4; ++j) R[j] = ld24o((TAB), (unsigned)EV[(i0) + j], ca, cb); } while (0)
#define SU_USE(R, i0) do { _Pragma("unroll") for (int j = 0; j < 4; ++j) { const v32f_t uf = __builtin_amdgcn_cvt_scalef32_pk32_f32_fp6(R[j], 1.0f); \
                f32x2 a0 = {0.f, 0.f}, a1 = {0.f, 0.f}, a2 = {0.f, 0.f}, a3 = {0.f, 0.f}; \
                _Pragma("unroll") for (int q = 0; q < 16; q += 4) { \
                    a0 = __builtin_elementwise_fma((f32x2){uf[2 * q], uf[2 * q + 1]}, xf[q], a0); \
                    a1 = __builtin_elementwise_fma((f32x2){uf[2 * q + 2], uf[2 * q + 3]}, xf[q + 1], a1); \
                    a2 = __builtin_elementwise_fma((f32x2){uf[2 * q + 4], uf[2 * q + 5]}, xf[q + 2], a2); \
                    a3 = __builtin_elementwise_fma((f32x2){uf[2 * q + 6], uf[2 * q + 7]}, xf[q + 3], a3); } \
                const f32x2 sm = (a0 + a1) + (a2 + a3); part[(i0) + j] = sm.x + sm.y; __builtin_amdgcn_sched_barrier(0); } } while (0)
    SU_IDX(ev, xpn, IT_S(0), IT_T(0));
#pragma unroll
    for (int i = 0; i < 16; ++i) xf[i] = (f32x2){__uint_as_float(xpn[i] << 16), __uint_as_float(xpn[i] & 0xffff0000u)};
    const unsigned ca = ch8 * 16, cb = 128 + ch8 * 8;
    { const unsigned char* tab0 = p.ws + WS_U8 + (size_t)__builtin_amdgcn_readfirstlane(IT_S(0)) * SLB; SU_LD(A, ev, tab0, 0); SU_LD(B, ev, tab0, 4); }
    for (int k = 0; k < nitems; ++k) {
        const int kn = (k + 1 < nitems) ? k + 1 : k, s = __builtin_amdgcn_readfirstlane(IT_S(k)), sn = __builtin_amdgcn_readfirstlane(IT_S(kn)), t = IT_T(k), tn = IT_T(kn);
        const unsigned char* tab = p.ws + WS_U8 + (size_t)s * SLB; const unsigned char* tabn = p.ws + WS_U8 + (size_t)sn * SLB;
        SU_IDX(evn, xpn, sn, tn); __builtin_amdgcn_sched_barrier(0);
        float part[16];
        SU_USE(A, 0); SU_LD(A, ev, tab, 8);
        SU_USE(B, 4); SU_LD(B, ev, tab, 12);
        SU_USE(A, 8); SU_LD(A, evn, tabn, 0);
        SU_USE(B, 12); SU_LD(B, evn, tabn, 4);
        float p8[8], p4[4], p2[2];
#pragma unroll
        for (int q = 0; q < 8; ++q) { const float keep = b2 ? part[q + 8] : part[q], send = b2 ? part[q] : part[q + 8]; p8[q] = keep + __shfl_xor(send, 4); }
#pragma unroll
        for (int q = 0; q < 4; ++q) { const float keep = b1 ? p8[q + 4] : p8[q], send = b1 ? p8[q] : p8[q + 4]; p4[q] = keep + __shfl_xor(send, 2); }
#pragma unroll
        for (int q = 0; q < 2; ++q) { const float keep = b0 ? p4[q + 2] : p4[q], send = b0 ? p4[q] : p4[q + 2]; p2[q] = keep + __shfl_xor(send, 1); }
        const int st0 = (b2 ? 8 : 0) + (b1 ? 4 : 0) + (b0 ? 2 : 0);
        float* dp = DP + ((size_t)s * T + t) * 128 + grp;
        dp[8 * st0] = p2[0]; dp[8 * (st0 + 1)] = p2[1];
#pragma unroll
        for (int i = 0; i < 16; ++i) { ev[i] = evn[i]; xf[i] = (f32x2){__uint_as_float(xpn[i] << 16), __uint_as_float(xpn[i] & 0xffff0000u)}; }
    }
#undef SU_IDX
#undef SU_LD
#undef SU_USE
}
__device__ __forceinline__ void ph_peer_coef(const Params& p, const Ctx& c) {
    const float* DP = (const float*)(p.ws + WS_DP); const int* EID = (const int*)(p.ws + WS_EID); const float* GATE = (const float*)(p.ws + WS_GATE);
    const float* SU = (const float*)(p.ws + WS_SU); const float* SV = (const float*)(p.ws + WS_SV); float* CF = (float*)(p.ws + WS_CF);
    for (int i = c.bid * NTHR + c.tid; i < T * 128; i += c.nb * NTHR) { float d = 0.f;
#pragma unroll
        for (int s = 0; s < 16; ++s) d += DP[(size_t)s * T * 128 + i];
        const int e = EID[i]; d *= SU[e];
        CF[i] = GATE[i] * 0.5f * d * (1.0f + erff(d * 0.70710678118654752f)) * SV[e]; }
}
__device__ __forceinline__ void ph_peer_v(const Params& p, const Ctx& c) {
    const int* EID = (const int*)(p.ws + WS_EID); const float* CF = (const float*)(p.ws + WS_CF); float* SS = (float*)(p.ws + WS_SS); const float* mod = (const float*)(p.ws + WS_MOD);
    bf16* YB = (bf16*)(p.ws + WS_H);
    const PeerMap m = peer_map(p, c, 1);
    const int lane = c.lane, ch8 = lane & 7, grp = lane >> 3; const bool b5 = lane & 32, b4 = lane & 16, b3 = lane & 8;
    const int ntok = (m.tw < T) ? (T - m.tw + m.tstride - 1) / m.tstride : 0, nitems = m.ns * ntok;
    if (nitems == 0) return;
    const int cofs = ch8 * 32 + (b5 ? 16 : 0) + (b4 ? 8 : 0) + (b3 ? 4 : 0);
    int ev[16], evn[16]; float cv[16], cvn[16]; v6u_t A[4], B[4];
#define SV_IDX(EV, CV, t_) do { _Pragma("unroll") for (int i = 0; i < 16; ++i) { EV[i] = EID[(size_t)(t_) * 128 + 8 * i + grp]; CV[i] = CF[(size_t)(t_) * 128 + 8 * i + grp]; } } while (0)
#define SV_LD(R, EV, TAB, i0) do { _Pragma("unroll") for (int j = 0; j < 4; ++j) R[j] = ld24o((TAB), (unsigned)EV[(i0) + j], ca, cb); } while (0)
#define SV_USE(R, i0) do { _Pragma("unroll") for (int j = 0; j < 4; ++j) { const f32x2 c2 = {cv[(i0) + j], cv[(i0) + j]}; const v32f_t vf = __builtin_amdgcn_cvt_scalef32_pk32_f32_fp6(R[j], 1.0f); \
                _Pragma("unroll") for (int q = 0; q < 16; ++q) acc[q] = __builtin_elementwise_fma((f32x2){vf[2 * q], vf[2 * q + 1]}, c2, acc[q]); } } while (0)
    SV_IDX(ev, cv, IT_T(0));
    const unsigned ca = ch8 * 16, cb = 128 + ch8 * 8;
    { const unsigned char* tab0 = p.ws + WS_V8 + (size_t)__builtin_amdgcn_readfirstlane(IT_S(0)) * SLB; SV_LD(A, ev, tab0, 0); SV_LD(B, ev, tab0, 4); }
    for (int k = 0; k < nitems; ++k) {
        const int kn = (k + 1 < nitems) ? k + 1 : k, s = __builtin_amdgcn_readfirstlane(IT_S(k)), sn = __builtin_amdgcn_readfirstlane(IT_S(kn)), t = IT_T(k), tn = IT_T(kn);
        const unsigned char* tab = p.ws + WS_V8 + (size_t)s * SLB; const unsigned char* tabn = p.ws + WS_V8 + (size_t)sn * SLB;
        SV_IDX(evn, cvn, tn);
        const int col = s * 256 + cofs;
        float* orow = p.out + (size_t)t * D + col;
        const v2u xw = *(const v2u*)((const bf16*)(p.ws + WS_X1B) + (size_t)t * D + col); const f32x4 ga = *(const f32x4*)(mod + (size_t)(t / SEQ) * 6 * D + 5 * D + col);
        const f32x4 xa = {__uint_as_float(xw.x << 16), __uint_as_float(xw.x & 0xffff0000u), __uint_as_float(xw.y << 16), __uint_as_float(xw.y & 0xffff0000u)};
        __builtin_amdgcn_sched_barrier(0);
        f32x2 acc[16];
#pragma unroll
        for (int q = 0; q < 16; ++q) acc[q] = (f32x2){0.f, 0.f};
        SV_USE(A, 0); SV_LD(A, ev, tab, 8);
        SV_USE(B, 4); SV_LD(B, ev, tab, 12);
        SV_USE(A, 8); SV_LD(A, evn, tabn, 0);
        SV_USE(B, 12); SV_LD(B, evn, tabn, 4);
        f32x2 q8[8], q4[4], q2[2];
#pragma unroll
        for (int q = 0; q < 8; ++q) { const f32x2 keep = b5 ? acc[q + 8] : acc[q], send = b5 ? acc[q] : acc[q + 8]; q8[q] = (f32x2){keep.x + __shfl_xor(send.x, 32), keep.y + __shfl_xor(send.y, 32)}; }
#pragma unroll
        for (int q = 0; q < 4; ++q) { const f32x2 keep = b4 ? q8[q + 4] : q8[q], send = b4 ? q8[q] : q8[q + 4]; q4[q] = (f32x2){keep.x + __shfl_xor(send.x, 16), keep.y + __shfl_xor(send.y, 16)}; }
#pragma unroll
        for (int q = 0; q < 2; ++q) { const f32x2 keep = b3 ? q4[q + 2] : q4[q], send = b3 ? q4[q] : q4[q + 2]; q2[q] = (f32x2){keep.x + __shfl_xor(send.x, 8), keep.y + __shfl_xor(send.y, 8)}; }
        const f32x4 y = {xa.x + ga.x * q2[0].x, xa.y + ga.y * q2[0].y, xa.z + ga.z * q2[1].x, xa.w + ga.w * q2[1].y};
        { v2u yw; yw.x = cvt_pk_bf16(y.x, y.y); yw.y = cvt_pk_bf16(y.z, y.w); *(v2u*)(YB + (size_t)t * D + col) = yw; }
        const float ss = wave_sum((y.x * y.x + y.y * y.y) + (y.z * y.z + y.w * y.w));
        if (lane == 0) SS[(size_t)s * T + t] = ss;
#pragma unroll
        for (int i = 0; i < 16; ++i) { ev[i] = evn[i]; cv[i] = cvn[i]; }
    }
#undef SV_IDX
#undef SV_LD
#undef SV_USE
#undef IT_S
#undef IT_T
}
__device__ __forceinline__ void ph_peer_norm(const Params& p, const Ctx& c) {
    const float* SS = (const float*)(p.ws + WS_SS); const bf16* YB = (const bf16*)(p.ws + WS_H); const int lane = c.lane;
    for (int t = c.gw; t < T; t += c.ngw) {
        const float tot = wave_sum(lane < 16 ? SS[(size_t)lane * T + t] : 0.f);
        const float rstd = 1.0f / sqrtf(tot * (1.0f / D) + EPS);
        float* orow = p.out + (size_t)t * D;
#pragma unroll
        for (int k = 0; k < 16; ++k) { const int col = k * 256 + lane * 4; const v2u yw = *(const v2u*)(YB + (size_t)t * D + col); const f32x4 ga = *(const f32x4*)(p.g_final + col);
            const f32x4 y = {__uint_as_float(yw.x << 16), __uint_as_float(yw.x & 0xffff0000u), __uint_as_float(yw.y << 16), __uint_as_float(yw.y & 0xffff0000u)};
            *(f32x4*)(orow + col) = (f32x4){y.x * rstd * ga.x, y.y * rstd * ga.y, y.z * rstd * ga.z, y.w * rstd * ga.w}; }
    }
}


constexpr int N_PHASES = 22;
__global__ void __launch_bounds__(NTHR, 2) fwd_kernel(Params p) {
    extern __shared__ __attribute__((aligned(16))) unsigned char lds_raw[];
    Ctx c; c.lds = (LAS unsigned char*)lds_raw; c.tid = threadIdx.x; c.lane = c.tid & 63; c.wave = __builtin_amdgcn_readfirstlane(c.tid >> 6);
    c.bid = blockIdx.x; c.nb = gridDim.x; c.gw = c.bid * NWAVES + c.wave; c.ngw = c.nb * NWAVES;
    volatile LAS unsigned* MISC = (volatile LAS unsigned*)(c.lds + MISC_OFF);
    if (c.tid < 64) MISC[c.tid] = 0u;
    __syncthreads();
    const int lo = p.ph_lo, hi = p.ph_hi;
    XcdBarrier bar; bar.bar = (unsigned*)(p.ws + WS_CTL); bar.x = 0; bar.st = nullptr;
    if (hi - lo > 1) bar = xcd_barrier_post((unsigned*)(p.ws + WS_CTL), MISC + 8);
#define IN(k) (lo <= (k) && (k) < hi)
#ifdef PH_TIME
#define TS(k) do { if (c.bid == 0 && c.tid == 0) ((unsigned long long*)(p.ws + WS_CTL))[4000 + (k)] = __builtin_amdgcn_s_memrealtime(); } while (0)
#else
#define TS(k) do { } while (0)
#endif
#define SEAM(k) do { if (IN(k) && IN((k) + 1)) xcd_barrier(bar); TS((k) + 1); } while (0)
    unsigned char* ws = p.ws;
    const float* mod = (const float*)(ws + WS_MOD);
    TS(0);
    if (IN(0)) { ph_prologue(p, c); } SEAM(0);
    if (IN(1)) { ph_modulate(p.x, p.g_mix, mod, 0 * D, 1 * D, (bf16*)(ws + WS_H), ws + WS_H8, c); } SEAM(1);
    if (IN(2)) {
        { pg8::Gemm g{(const bf16*)(ws + WS_H), (const bf16*)(ws + WS_BT1), T, IN_BF, D, D, D}; pg8::StaticOrder S; S.init(T, IN_BF, c.nb, c.bid);
          pg8::EpiB<0> E{(bf16*)(ws + WS_P1), nullptr, nullptr, nullptr, N1, 0, 1.0f, 0.f};
          pg8::gemm_phase<pg8::EpiB<0>, pg8::StaticOrder, true, true>(c.lds, g, S, E); }
        { pg8::Gemm g{(const bf16*)(ws + WS_H8), (const bf16*)(ws + WS_W8IN), T, IN_PAD - IN_BF, D / 2, D / 2, D / 2}; pg8::StaticOrder S; S.init(T, IN_PAD - IN_BF, c.nb, c.bid);
          pg8::EpiB<0> E{(bf16*)(ws + WS_P1) + IN_BF, nullptr, nullptr, nullptr, N1, 0, 1.0f / 16384.0f, 0.f};
          pg8::gemm_phase<pg8::EpiB<0>, pg8::StaticOrder, true, true, true>(c.lds, g, S, E); }
        { pg8::Gemm g{(const bf16*)(ws + WS_H8), (const bf16*)(ws + WS_G8), T, 2 * D, D / 2, D / 2, D / 2}; pg8::StaticOrder S; S.init(T, 2 * D, c.nb, c.bid);
          pg8::EpiGate E{(bf16*)(ws + WS_P1) + C_GA, N1, p.b_gate, 1.0f / 16384.0f};
          pg8::gemm_phase<pg8::EpiGate, pg8::StaticOrder, true, true, true>(c.lds, g, S, E); }
    } SEAM(2);
    if (IN(3)) { ph_postproc(p, c); } SEAM(3);
    if (IN(4)) { pg8::Gemm g{(const bf16*)(ws + WS_P1) + C_CQ, (const bf16*)(ws + WS_BT2), T, N2, A_QR, N1, A_QR}; pg8::StaticOrder S; S.init(T, N2, c.nb, c.bid);
        pg8::EpiB<0> E{(bf16*)(ws + WS_Q2), nullptr, nullptr, nullptr, N2, 0, 1.0f, 0.f};
        pg8::gemm_phase<pg8::EpiB<0>, pg8::StaticOrder, true, true>(c.lds, g, S, E); } SEAM(4);
    if (IN(5)) { ph_ret_state(p, c); ph_qlat(p, c); } SEAM(5);
    if (IN(6)) { ph_scores(p, c); } SEAM(6);
    if (IN(7)) { ph_topk(p, c); } SEAM(7);
    if (IN(8)) { ph_attn(p, c); } SEAM(8);
    if (IN(9)) { adaln_late_reduce(p, c); ph_oproj(p, c); ph_ret_out(p, c); } SEAM(9);
    if (IN(12)) { pg8::Gemm g{(const bf16*)(ws + WS_YCAT), (const bf16*)(ws + WS_BTUP), T, D, A_WIDTH / 2, D / 2, D / 2}; pg8::StaticOrder S; S.init(T, D, c.nb, c.bid);
        pg8::EpiB<2> E{(bf16*)(ws + WS_MERGED), nullptr, nullptr, (const bf16*)(ws + WS_P1) + C_GA, D, N1, 1.0f / 16384.0f, 0.f};
        pg8::gemm_phase<pg8::EpiB<2>, pg8::StaticOrder, true, true, true>(c.lds, g, S, E); }
    if (IN(12) && IN(13)) { VM_WAIT(); __syncthreads(); }
    if (IN(13)) { pg8::Gemm g{(const bf16*)(ws + WS_YCAT + A_WIDTH), (const bf16*)(ws + WS_BTUP + A_WIDTH), T, D, R_W / 2, D / 2, D / 2}; pg8::StaticOrder S; S.init(T, D, c.nb, c.bid);
        pg8::EpiB<3> E{(bf16*)(ws + WS_MERGED), ws + WS_MERGED8, nullptr, (const bf16*)(ws + WS_P1) + C_GR, D, N1, 1.0f / 16384.0f, 64.0f};
        pg8::gemm_phase<pg8::EpiB<3>, pg8::StaticOrder, true, true, true>(c.lds, g, S, E); } SEAM(13);
    if (IN(14)) { pg8::Gemm g{(const bf16*)(ws + WS_MERGED8), (const bf16*)(ws + WS_BTOUT), T, D, D / 2, D / 2, D / 2}; pg8::StaticOrder S; S.init(T, D, c.nb, c.bid);
        pg8::EpiRes E{p.x, (bf16*)(ws + WS_X1B), D, mod + 2 * D, 6 * D, 1.0f / 65536.0f};
        pg8::gemm_phase<pg8::EpiRes, pg8::StaticOrder, true, true, true>(c.lds, g, S, E); } SEAM(14);
    if (IN(15)) { ph_modulate<true>((const float*)(ws + WS_X1B), p.g_ffn, mod, 3 * D, 4 * D, (bf16*)(ws + WS_H), nullptr, c); } SEAM(15);
    if (IN(16)) { pg8::Gemm g{(const bf16*)(ws + WS_H), (const bf16*)(ws + WS_BTPQ), T, 2048, D, D, D}; pg8::StaticOrder S; S.init(T, 2048, c.nb, c.bid);
        pg8::EpiB<0> E{(bf16*)(ws + WS_PQ), nullptr, nullptr, nullptr, 2048, 0, 1.0f, 0.f};
        pg8::gemm_phase<pg8::EpiB<0>, pg8::StaticOrder, true, true>(c.lds, g, S, E); } SEAM(16);
    if (IN(17)) { ph_peer_route(p, c); } SEAM(17);
    if (IN(18)) { ph_peer_u(p, c); } SEAM(18);
    if (IN(19)) { ph_peer_coef(p, c); } SEAM(19);
    if (IN(20)) { ph_peer_v(p, c); } SEAM(20);
    if (IN(21)) { ph_peer_norm(p, c); }
#ifdef PH_TIME
    xcd_barrier(bar); TS(22);
    if (c.bid == 0 && c.tid == 0) { __threadfence(); const volatile unsigned long long* ts = (const volatile unsigned long long*)(p.ws + WS_CTL) + 4000; p.out[0] += (float)(long long)(ts[PH_B] - ts[PH_A]) * 0.01f - (float)(PH_OFF); }
#endif
#undef IN
#undef SEAM
}

#ifdef DBG_STOP
__device__ __forceinline__ float dsan(float v) { return (v - v == 0.0f) ? v : 777.0f; }
__global__ void dump_kernel(Params p, int k) {
    unsigned char* ws = p.ws; const size_t n = (size_t)T * D;
    for (size_t i = (size_t)blockIdx.x * blockDim.x + threadIdx.x; i < n; i += (size_t)gridDim.x * blockDim.x) {
        float v = 0.f;
        if (k == 0) { v = ((const float*)(ws + WS_MOD))[i % 98304] + bf2f(((const bf16*)(ws + WS_BT1))[i] ) + bf2f(((const bf16*)(ws + WS_BT1))[(i + n) % 66060288])
                + bf2f(((const bf16*)(ws + WS_BT2))[i % 10485760]) + bf2f(((const bf16*)(ws + WS_WUK))[i % 1048576]) + bf2f(((const bf16*)(ws + WS_BTUV))[i % 1048576])
                + bf2f(((const bf16*)(ws + WS_BTUP))[i % 16777216]) + bf2f(((const bf16*)(ws + WS_BTOUT))[i % 16777216]) + bf2f(((const bf16*)(ws + WS_BTPQ))[i % 8388608])
                + bf2f(((const bf16*)(ws + WS_SK))[i % 32768]) + (float)(ws + WS_U8)[i] + (float)(ws + WS_V8)[i]; }
        else if (k == 1 || k == 15) v = bf2f(((const bf16*)(ws + WS_H))[i]);
        else if (k == 2 || k == 3) { const bf16* P = (const bf16*)(ws + WS_P1); v = bf2f(P[i]) + bf2f(P[i + n]) + bf2f(P[i + 2 * n]) + bf2f(P[(i + 3 * n) % 132120576]) + ((const float*)(ws + WS_WIDX))[i % 524288] * (k == 3 ? 1.f : 0.f); }
        else if (k == 4) { const bf16* P = (const bf16*)(ws + WS_Q2); v = bf2f(P[i]) + bf2f(P[i + n]) + bf2f(P[(i + 2 * n) % 83886080]); }
        else if (k == 5) { const bf16* P = (const bf16*)(ws + WS_QL); v = bf2f(P[i]) + bf2f(P[i + n]); }
        else if (k == 6) { const size_t j = i % ((size_t)T * SEQ); const int t = (int)(j / SEQ), s = (int)(j % SEQ); v = (s < (((t % SEQ) / 64) + 1) * 64) ? ((const float*)(ws + WS_SC))[j] : 0.f; }
        else if (k == 7) { const size_t j = i % ((size_t)T * TOPK); const int t = (int)(j / TOPK), s = (int)(j % TOPK); const int cnt = ((const int*)(ws + WS_CNT))[t]; v = (s < cnt) ? (float)((const int*)(ws + WS_SEL))[j] : (float)cnt; }
        else if (k == 8) { const bf16* P = (const bf16*)(ws + WS_OLAT); v = bf2f(P[i]) + bf2f(P[i + n]); }
        else if (k == 9) { v = (float)(ws + WS_YCAT)[(i / 2048) * 4096 + (i % 2048)]; }
        else if (k == 10) { v = ((const float*)(ws + WS_SC))[i % ((size_t)T * 2048)]; }
        else if (k == 11) { v = (float)(ws + WS_YCAT)[i]; }
        else if (k == 12 || k == 13) { v = bf2f(((const bf16*)(ws + WS_MERGED))[i]); }
        else if (k == 14 || k == 18) { v = p.out[i]; }
        else if (k == 16) { v = bf2f(((const bf16*)(ws + WS_PQ))[i % ((size_t)T * 2048)]); }
        else if (k == 17) { v = (float)((const int*)(ws + WS_EID))[i % ((size_t)T * 128)] + ((const float*)(ws + WS_GATE))[i % ((size_t)T * 128)]; }
        p.out[i] = dsan(v);
    }
}
#endif

#ifndef MK_SINGLE
#define MK_SINGLE 1
#endif
extern "C" void kernel_launch(void* const* d_in, const int* in_sizes, int n_in, void* d_out, int out_size, void* d_ws, size_t ws_size, hipStream_t stream) {
    static int grid = 0;
    if (grid == 0) {
        if (n_in != 26 || in_sizes[0] != T * D || out_size != T * D || ws_size < WS_END) { fprintf(stderr, "kernel_launch: unexpected shapes (n_in %d, in0 %d, out %d, ws %zu < %zu)\n", n_in, n_in > 0 ? in_sizes[0] : -1, out_size, ws_size, (size_t)WS_END); grid = -1; return; }
        int dev = 0, cus = 0, per_cu = 0;
        if (hipGetDevice(&dev) != hipSuccess || hipDeviceGetAttribute(&cus, hipDeviceAttributeMultiprocessorCount, dev) != hipSuccess) { grid = -1; return; }
        if (hipFuncSetAttribute((const void*)fwd_kernel, hipFuncAttributeMaxDynamicSharedMemorySize, LDS_BYTES) != hipSuccess) { fprintf(stderr, "kernel_launch: hipFuncSetAttribute failed\n"); grid = -1; return; }
        if (hipOccupancyMaxActiveBlocksPerMultiprocessor(&per_cu, (const void*)fwd_kernel, NTHR, LDS_BYTES) != hipSuccess || per_cu < 1) { fprintf(stderr, "kernel_launch: occupancy query reports %d blocks per CU\n", per_cu); }
        (void)hipGetLastError();
        grid = cus;
    }
    if (grid < 0) return;
    (void)hipMemsetAsync((char*)d_ws + WS_CTL, 0, CTL_ZERO_BYTES, stream);
    Params p{};
    const float** pf = (const float**)&p;
    for (int i = 0; i < 26; ++i) pf[i] = (const float*)d_in[i];
    p.out = (float*)d_out; p.ws = (unsigned char*)d_ws;
#ifdef DBG_STOP
    for (int ph = 0; ph <= DBG_STOP; ++ph) { p.ph_lo = ph; p.ph_hi = ph + 1; hipLaunchKernelGGL(fwd_kernel, dim3(grid), dim3(NTHR), LDS_BYTES, stream, p); }
    p.ph_lo = 0; p.ph_hi = 0;
    hipLaunchKernelGGL(dump_kernel, dim3(2048), dim3(256), 0, stream, p, (int)DBG_STOP);
#elif MK_SINGLE
    p.ph_lo = 0; p.ph_hi = N_PHASES;
    hipLaunchKernelGGL(fwd_kernel, dim3(grid), dim3(NTHR), LDS_BYTES, stream, p);
#else
    for (int ph = 0; ph < N_PHASES; ++ph) { p.ph_lo = ph; p.ph_hi = ph + 1;
#ifdef PEER_PROBE
        if (ph == 18) { p.dummy = 1; for (int rep = 0; rep < PEER_DUMMY; ++rep) hipLaunchKernelGGL(fwd_kernel, dim3(grid), dim3(NTHR), LDS_BYTES, stream, p); p.dummy = 0; }
#endif
        hipLaunchKernelGGL(fwd_kernel, dim3(grid), dim3(NTHR), LDS_BYTES, stream, p);
#ifdef REP_MASK
        if ((REP_MASK >> ph) & 1) for (int rep = 0; rep < REP_N; ++rep) hipLaunchKernelGGL(fwd_kernel, dim3(grid), dim3(NTHR), LDS_BYTES, stream, p);
#endif
    }
#endif
}
```
